# Optimizing an MI355X kernel written in HIP

```python
import math
import jax, jax.numpy as jnp
from jax import lax
import numpy as np

D_MODEL = 2048
BATCH = 4
SEQ = 4096
DEPTH = 4

GRID_W = 64
ROPE_THETA = 10000.0
Q_BLOCK = 128
LN_EPS = 1e-5
RMS_EPS = 1e-6

DEEPNORM_ALPHA = (2.0 * DEPTH) ** 0.25
DEEPNORM_BETA = (8.0 * DEPTH) ** -0.25

MLA_HEADS = 8
MLA_Q_RANK = 512
MLA_KV_RANK = 256
MLA_NOPE_DIM = 128
MLA_ROPE_DIM = 64
MLA_V_DIM = 128

GLA_HEADS = 4
GLA_DK = 128
GLA_DV = 256
GLA_GATE_RANK = 16
GLA_GATE_TAU = 16.0
GLA_CHUNK = 64

IN_SIZES = (
    MLA_Q_RANK,
    MLA_KV_RANK,
    MLA_ROPE_DIM,
    GLA_HEADS * GLA_DK,
    GLA_HEADS * GLA_DK,
    GLA_HEADS * GLA_DV,
    GLA_HEADS * GLA_DV,
    2 * GLA_GATE_RANK,
)
IN_WIDTH = sum(IN_SIZES)
MIX_WIDTH = MLA_HEADS * MLA_V_DIM + GLA_HEADS * GLA_DV

GQA_HEADS = 16
GQA_KV_HEADS = 4
GQA_HEAD_DIM = 128

N_EXPERTS = 16
EXPERT_FF = 1536
CAPACITY_FACTOR = 2

kernel_name = "hybrid_mla_gla_gqa_ecmoe_deepnorm"


def rms_norm(x, g):
    xf = x.astype(jnp.float32)
    y = xf * lax.rsqrt(jnp.mean(xf * xf, axis=-1, keepdims=True) + RMS_EPS)
    return (y * g.astype(jnp.float32)).astype(x.dtype)


def layer_norm(x, g, b):
    xf = x.astype(jnp.float32)
    mu = jnp.mean(xf, axis=-1, keepdims=True)
    var = jnp.mean(jnp.square(xf - mu), axis=-1, keepdims=True)
    y = (xf - mu) * lax.rsqrt(var + LN_EPS) * g.astype(jnp.float32) + b.astype(jnp.float32)
    return y.astype(x.dtype)


def axial_rope_tables(seq_len, rot_dim):
    rows = seq_len // GRID_W
    row = jnp.repeat(jnp.arange(rows, dtype=jnp.int32), GRID_W).astype(jnp.float32)
    col = jnp.tile(jnp.arange(GRID_W, dtype=jnp.int32), rows).astype(jnp.float32)
    half = rot_dim // 2
    inv_freq = ROPE_THETA ** (-jnp.arange(0, half, 2, dtype=jnp.float32) / half)
    ang = jnp.concatenate([row[:, None] * inv_freq, col[:, None] * inv_freq], axis=-1)
    return jnp.cos(ang), jnp.sin(ang)


def apply_rope(x, cos, sin):
    B, S, H, R = x.shape
    xf = x.astype(jnp.float32).reshape(B, S, H, R // 2, 2)
    c, s = cos[None, :, None, :], sin[None, :, None, :]
    x1, x2 = xf[..., 0], xf[..., 1]
    out = jnp.stack([x1 * c - x2 * s, x1 * s + x2 * c], axis=-1)
    return out.reshape(B, S, H, R).astype(x.dtype)


def block_attention(q, k, v, scale):
    B, S, KVH, G, Dq = q.shape
    Dv = v.shape[-1]
    nb = S // Q_BLOCK
    qb = q.reshape(B, nb, Q_BLOCK, KVH, G, Dq).transpose(1, 0, 2, 3, 4, 5)

    def one_block(q_blk):
        s = jnp.einsum('bqhgd,bkhd->bhgqk', q_blk, k,
                       preferred_element_type=jnp.float32) * scale
        p = jax.nn.softmax(s, axis=-1)
        return jnp.einsum('bhgqk,bkhd->bqhgd', p.astype(v.dtype), v)

    o = lax.map(one_block, qb)
    return o.transpose(1, 0, 2, 3, 4, 5).reshape(B, S, KVH, G, Dv)


def gla_chunked(q, k, v, log_a):
    B, S, H, Dk = q.shape
    Dv = v.shape[-1]
    C = GLA_CHUNK
    N = S // C
    q = q.reshape(B, N, C, H, Dk)
    k = k.reshape(B, N, C, H, Dk)
    v = v.reshape(B, N, C, H, Dv)
    b = jnp.cumsum(log_a.reshape(B, N, C, H, Dk), axis=2)
    b_last = b[:, :, -1]
    q_in = q * jnp.exp(b)
    k_in = k * jnp.exp(-b)
    k_st = k * jnp.exp(b_last[:, :, None] - b)
    mask = jnp.tril(jnp.ones((C, C), dtype=bool))
    att = jnp.einsum('bnihd,bnjhd->bnhij', q_in, k_in)
    att = jnp.where(mask, att, 0.0)
    o_intra = jnp.einsum('bnhij,bnjhv->bnihv', att, v)
    dS = jnp.einsum('bnjhd,bnjhv->bnhdv', k_st, v)
    decay = jnp.exp(b_last)

    def step(s_prev, inp):
        ds_n, dec_n = inp
        return dec_n[..., None] * s_prev + ds_n, s_prev

    s0 = jnp.zeros((B, H, Dk, Dv), jnp.float32)
    _, s_before = lax.scan(step, s0, (dS.transpose(1, 0, 2, 3, 4), decay.transpose(1, 0, 2, 3)))
    s_before = s_before.transpose(1, 0, 2, 3, 4)
    o_inter = jnp.einsum('bnihd,bnhdv->bnihv', q_in, s_before)
    return (o_intra + o_inter).reshape(B, S, H, Dv)


def mla_gla_mixer(x, w_in, q_norm, w_uq, kv_norm, w_ukv, gate_w2, gate_b, gla_norm, w_out,
                  cos_r, sin_r):
    B, S, _ = x.shape
    h = x @ w_in
    offsets = np.cumsum(IN_SIZES)[:-1].tolist()
    c_q, c_kv, k_rope, g_q, g_k, g_v, g_r, g_lat = jnp.split(h, offsets, axis=-1)

    q = (rms_norm(c_q, q_norm) @ w_uq).reshape(B, S, MLA_HEADS, MLA_NOPE_DIM + MLA_ROPE_DIM)
    q_nope, q_pe = q[..., :MLA_NOPE_DIM], q[..., MLA_NOPE_DIM:]
    q_pe = apply_rope(q_pe, cos_r, sin_r)
    kv = (rms_norm(c_kv, kv_norm) @ w_ukv).reshape(B, S, MLA_HEADS, MLA_NOPE_DIM + MLA_V_DIM)
    k_nope, v_mla = kv[..., :MLA_NOPE_DIM], kv[..., MLA_NOPE_DIM:]
    k_pe = apply_rope(k_rope[:, :, None, :], cos_r, sin_r)
    k_pe = jnp.broadcast_to(k_pe, (B, S, MLA_HEADS, MLA_ROPE_DIM))
    q_full = jnp.concatenate([q_nope, q_pe], axis=-1)[:, :, :, None, :]
    k_full = jnp.concatenate([k_nope, k_pe], axis=-1)
    o_mla = block_attention(q_full, k_full, v_mla, (MLA_NOPE_DIM + MLA_ROPE_DIM) ** -0.5)
    o_mla = o_mla.reshape(B, S, MLA_HEADS * MLA_V_DIM)

    f32 = jnp.float32
    gq = g_q.astype(f32).reshape(B, S, GLA_HEADS, GLA_DK) * (GLA_DK ** -0.5)
    gk = g_k.astype(f32).reshape(B, S, GLA_HEADS, GLA_DK)
    gv = g_v.astype(f32).reshape(B, S, GLA_HEADS, GLA_DV)
    lat_f, lat_b = g_lat[..., :GLA_GATE_RANK], g_lat[..., GLA_GATE_RANK:]
    la_f = jax.nn.log_sigmoid((lat_f @ gate_w2[0] + gate_b[0]).astype(f32)) / GLA_GATE_TAU
    la_b = jax.nn.log_sigmoid((lat_b @ gate_w2[1] + gate_b[1]).astype(f32)) / GLA_GATE_TAU
    la_f = la_f.reshape(B, S, GLA_HEADS, GLA_DK)
    la_b = la_b.reshape(B, S, GLA_HEADS, GLA_DK)
    o_fwd = gla_chunked(gq, gk, gv, la_f)
    flip = lambda a: jnp.flip(a, axis=1)
    o_bwd = flip(gla_chunked(flip(gq), flip(gk), flip(gv), flip(la_b)))
    o_gla = rms_norm(o_fwd + o_bwd, gla_norm.reshape(GLA_HEADS, GLA_DV))
    o_gla = o_gla.reshape(B, S, GLA_HEADS * GLA_DV).astype(x.dtype) * jax.nn.silu(g_r)

    return jnp.concatenate([o_mla, o_gla], axis=-1) @ w_out


def gqa_axial_mixer(x, w_qkv, q_norm, k_norm, w_out, cos_g, sin_g):
    B, S, _ = x.shape
    h = x @ w_qkv
    nq = GQA_HEADS * GQA_HEAD_DIM
    nk = GQA_KV_HEADS * GQA_HEAD_DIM
    q = h[..., :nq].reshape(B, S, GQA_HEADS, GQA_HEAD_DIM)
    k = h[..., nq:nq + nk].reshape(B, S, GQA_KV_HEADS, GQA_HEAD_DIM)
    v = h[..., nq + nk:].reshape(B, S, GQA_KV_HEADS, GQA_HEAD_DIM)
    q = apply_rope(rms_norm(q, q_norm), cos_g, sin_g)
    k = apply_rope(rms_norm(k, k_norm), cos_g, sin_g)
    q = q.reshape(B, S, GQA_KV_HEADS, GQA_HEADS // GQA_KV_HEADS, GQA_HEAD_DIM)
    o = block_attention(q, k, v, GQA_HEAD_DIM ** -0.5).reshape(B, S, nq)
    return o @ w_out


def expert_choice_moe(x, w_router, w1, w3, w2):
    B, T, D = x.shape
    cap = CAPACITY_FACTOR * T // N_EXPERTS
    logits = jnp.einsum('btd,de->bte', x, w_router, preferred_element_type=jnp.float32)
    aff = jax.nn.softmax(logits, axis=-1)
    gate, idx = lax.top_k(aff.transpose(0, 2, 1), cap)
    xs = jax.vmap(lambda xb, ib: xb[ib])(x, idx)
    hdn = jax.nn.silu(jnp.einsum('becd,edf->becf', xs, w1)) * jnp.einsum('becd,edf->becf', xs, w3)
    y = jnp.einsum('becf,efd->becd', hdn, w2) * gate[..., None].astype(x.dtype)
    return jax.vmap(
        lambda yb, ib: jnp.zeros((T, D), yb.dtype).at[ib.reshape(-1)].add(yb.reshape(-1, D))
    )(y, idx)


def setup_inputs(seed: int = 0) -> dict:
    key = jax.random.key(seed)
    ks = jax.random.split(key, 24)
    n_even = (DEPTH + 1) // 2
    n_odd = DEPTH // 2
    D = D_MODEL
    nrm = lambda k, shape, fan_in, s=1.0: jax.random.normal(k, shape, jnp.float32) * (s * fan_in ** -0.5)
    gain = lambda k, shape: 1.0 + 0.02 * jax.random.normal(k, shape, jnp.float32)
    small = lambda k, shape: 0.01 * jax.random.normal(k, shape, jnp.float32)
    return {
        "x": jax.random.normal(ks[0], (BATCH, SEQ, D), jnp.float32),
        "mix_w_in": nrm(ks[1], (n_even, D, IN_WIDTH), D),
        "mla_q_norm": gain(ks[2], (n_even, MLA_Q_RANK)),
        "mla_w_uq": nrm(ks[3], (n_even, MLA_Q_RANK, MLA_HEADS * (MLA_NOPE_DIM + MLA_ROPE_DIM)), MLA_Q_RANK),
        "mla_kv_norm": gain(ks[4], (n_even, MLA_KV_RANK)),
        "mla_w_ukv": nrm(ks[5], (n_even, MLA_KV_RANK, MLA_HEADS * (MLA_NOPE_DIM + MLA_V_DIM)), MLA_KV_RANK),
        "gla_gate_w2": nrm(ks[6], (n_even, 2, GLA_GATE_RANK, GLA_HEADS * GLA_DK), GLA_GATE_RANK),
        "gla_gate_b": small(ks[7], (n_even, 2, GLA_HEADS * GLA_DK)),
        "gla_out_norm": gain(ks[8], (n_even, GLA_HEADS * GLA_DV)),
        "mix_w_out": nrm(ks[9], (n_even, MIX_WIDTH, D), MIX_WIDTH, DEEPNORM_BETA),
        "gqa_w_qkv": nrm(ks[10], (n_odd, D, (GQA_HEADS + 2 * GQA_KV_HEADS) * GQA_HEAD_DIM), D),
        "gqa_q_norm": gain(ks[11], (n_odd, GQA_HEAD_DIM)),
        "gqa_k_norm": gain(ks[12], (n_odd, GQA_HEAD_DIM)),
        "gqa_w_out": nrm(ks[13], (n_odd, GQA_HEADS * GQA_HEAD_DIM, D), GQA_HEADS * GQA_HEAD_DIM, DEEPNORM_BETA),
        "moe_router": nrm(ks[14], (DEPTH, D, N_EXPERTS), D),
        "moe_w1": nrm(ks[15], (DEPTH, N_EXPERTS, D, EXPERT_FF), D),
        "moe_w3": nrm(ks[16], (DEPTH, N_EXPERTS, D, EXPERT_FF), D),
        "moe_w2": nrm(ks[17], (DEPTH, N_EXPERTS, EXPERT_FF, D), EXPERT_FF, DEEPNORM_BETA),
        "ln_mix_g": gain(ks[18], (DEPTH, D)),
        "ln_mix_b": small(ks[19], (DEPTH, D)),
        "ln_ffn_g": gain(ks[20], (DEPTH, D)),
        "ln_ffn_b": small(ks[21], (DEPTH, D)),
    }


def reference(x, mix_w_in, mla_q_norm, mla_w_uq, mla_kv_norm, mla_w_ukv, gla_gate_w2, gla_gate_b,
              gla_out_norm, mix_w_out, gqa_w_qkv, gqa_q_norm, gqa_k_norm, gqa_w_out,
              moe_router, moe_w1, moe_w3, moe_w2, ln_mix_g, ln_mix_b, ln_ffn_g, ln_ffn_b):
    S = x.shape[1]
    cos_r, sin_r = axial_rope_tables(S, MLA_ROPE_DIM)
    cos_g, sin_g = axial_rope_tables(S, GQA_HEAD_DIM)
    for layer in range(DEPTH):
        i = layer // 2
        if layer % 2 == 0:
            m = mla_gla_mixer(x, mix_w_in[i], mla_q_norm[i], mla_w_uq[i], mla_kv_norm[i],
                              mla_w_ukv[i], gla_gate_w2[i], gla_gate_b[i], gla_out_norm[i],
                              mix_w_out[i], cos_r, sin_r)
        else:
            m = gqa_axial_mixer(x, gqa_w_qkv[i], gqa_q_norm[i], gqa_k_norm[i], gqa_w_out[i],
                                cos_g, sin_g)
        x = layer_norm(DEEPNORM_ALPHA * x + m, ln_mix_g[layer], ln_mix_b[layer])
        f = expert_choice_moe(x, moe_router[layer], moe_w1[layer], moe_w3[layer], moe_w2[layer])
        x = layer_norm(DEEPNORM_ALPHA * x + f, ln_ffn_g[layer], ln_ffn_b[layer])
    return x
```

```cpp
#include <hip/hip_runtime.h>
#include <hip/hip_bf16.h>
#include <cstdio>
#include <cstdint>
#include <cmath>

#define GAS __attribute__((address_space(1)))
#define LAS __attribute__((address_space(3)))
typedef unsigned short bf16_t;
typedef short bf16x8 __attribute__((ext_vector_type(8)));
typedef short s16x4 __attribute__((ext_vector_type(4)));
typedef float f32x4 __attribute__((ext_vector_type(4)));
typedef float f32x2 __attribute__((ext_vector_type(2)));
typedef float f32x16 __attribute__((ext_vector_type(16)));
typedef unsigned u32x4 __attribute__((ext_vector_type(4)));
typedef unsigned u32x2 __attribute__((ext_vector_type(2)));
typedef GAS unsigned gu32;

__device__ __forceinline__ unsigned cvt_pk_bf16(float lo, float hi) { unsigned r; asm volatile("v_cvt_pk_bf16_f32 %0, %1, %2" : "=v"(r) : "v"(lo), "v"(hi)); return r; }
__device__ __forceinline__ float bf_lo(unsigned w) { return __uint_as_float(w << 16); }
__device__ __forceinline__ float bf_hi(unsigned w) { return __uint_as_float(w & 0xffff0000u); }
__device__ __forceinline__ float bf2f(bf16_t h) { return __uint_as_float(((unsigned)h) << 16); }
__device__ __forceinline__ bf16_t f2bf(float f) { return (bf16_t)(cvt_pk_bf16(f, 0.f) & 0xffffu); }

namespace pg8 {
constexpr int BM = 256, BK = 64, HALF = 128, HTB = HALF * BK * 2, STAGE_BYTES = 8 * HTB, NXCD = 8, WGM = 8;
__host__ __device__ __forceinline__ int lds_byte(int r, int c) { const int st = (r >> 4) * 2 + (c >> 5), rr = r & 15, cc = c & 31, ob = rr * 64 + cc * 2; return st * 1024 + (ob ^ (((ob >> 9) & 1) << 5)); }
__host__ __device__ __forceinline__ void stage_rc(int b, int& R, int& C) { const int st = b / 1024, sb = b % 1024, swz = sb ^ (((sb >> 9) & 1) << 5); R = (st >> 1) * 16 + swz / 64; C = (st & 1) * 32 + (swz % 64) / 2; }
__host__ __device__ __forceinline__ int perm32(int rho) { const int n = rho >> 4, i = rho & 15; return 8 * (i >> 2) + 4 * n + (i & 3); }

struct Unit { int pm, pn; };
struct Gemm { const bf16_t* A; const bf16_t* Bt; int lda, ldb, K, bshift; size_t bstride; const int* gather; };

struct StaticOrder {
    int nM, nN, nwg, G, c;
    __device__ void init(int M, int N, int G_, int c_) { nM = M / BM; nN = N / BM; nwg = nM * nN; G = G_; c = c_; }
    __device__ bool next(int i, Unit& u) const {
        const long L = (long)i * G + c; if (L >= nwg) return false;
        int wgid = (int)L; { const int q = nwg / NXCD, r = nwg % NXCD, xcd = wgid % NXCD, off = wgid / NXCD; wgid = (xcd < r ? xcd * (q + 1) : r * (q + 1) + (xcd - r) * q) + off; }
        const int nig = WGM * nN, gid = wgid / nig, fm = gid * WGM, gsz = (nM - fm) < WGM ? (nM - fm) : WGM;
        u.pm = fm + ((wgid % nig) % gsz); u.pn = (wgid % nig) / gsz; return true;
    }
};

template <class Epi, bool GATHER>
__device__ __forceinline__ void gemm_phase(LAS unsigned char* lds, const Gemm g, const StaticOrder& S, const Epi& E) {
    int tid_ = threadIdx.x; asm volatile("" : "+v"(tid_));
    const int tid = tid_, wid = __builtin_amdgcn_readfirstlane(tid >> 6), lane = tid & 63, wr = wid >> 2, wc = wid & 3, fr = lane & 15, fq = lane >> 4;
    const int K = g.K, nt = K / BK;
    unsigned voffA[2], voffB[2]; int RA[2], CA[2];
#pragma unroll
    for (int i = 0; i < 2; ++i) { int R, C; stage_rc(tid * 16 + i * 8192, R, C); const int Rb = Epi::PERM ? ((R & ~31) + perm32(R & 31)) : R;
        RA[i] = R; CA[i] = C; voffA[i] = (unsigned)(R * g.lda + C) * 2u; voffB[i] = (unsigned)(Rb * g.ldb + C) * 2u; }
    const size_t kstep = (size_t)(BK * 2);
    const size_t hstepA = (size_t)HALF * g.lda * 2, hstepB = (size_t)HALF * g.ldb * 2;
    const size_t tstepA = 2 * hstepA, tstepB = 2 * hstepB;
    const unsigned ldsw = (unsigned)wid * 1024u;
    const int aoff = lds_byte(wr * 64 + fr, fq * 8), boff = lds_byte(wc * 32 + fr, fq * 8);
#define PG8_SA(b, h) (((b) * 2 + (h)) * HTB)
#define PG8_SB(b, h) ((4 + (b) * 2 + (h)) * HTB)
#define PG8_STAGE(bufoff, gbase, voff) do { _Pragma("unroll") for (int _i = 0; _i < 2; ++_i) \
        __builtin_amdgcn_global_load_lds((const unsigned*)((const char*)(gbase) + (voff)[_i]), (LAS unsigned*)(lds + (bufoff) + ldsw + _i * 8192), 16, 0, 0); } while (0)
#define PG8_STAGE_A(bufoff, gptr, h, vg) do { if constexpr (GATHER) { PG8_STAGE(bufoff, gptr, vg[h]); } else { PG8_STAGE(bufoff, (gptr) + (h) * hstepA, voffA); } } while (0)
#define PG8_LDA(dst, b, h) do { _Pragma("unroll") for (int m = 0; m < 4; ++m) _Pragma("unroll") for (int k = 0; k < 2; ++k) dst[m][k] = *(const LAS bf16x8*)(lds + PG8_SA(b, h) + aoff + m * 2048 + k * 1024); } while (0)
#define PG8_LDB(dst, b, h) do { _Pragma("unroll") for (int n = 0; n < 2; ++n) _Pragma("unroll") for (int k = 0; k < 2; ++k) dst[n][k] = *(const LAS bf16x8*)(lds + PG8_SB(b, h) + boff + n * 2048 + k * 1024); } while (0)
#define PG8_MMA(ai, bj, At, Bt) do { __builtin_amdgcn_s_setprio(1); _Pragma("unroll") for (int m = 0; m < 4; ++m) _Pragma("unroll") for (int n = 0; n < 2; ++n) _Pragma("unroll") for (int k = 0; k < 2; ++k) \
        acc[ai][bj][m][n] = __builtin_amdgcn_mfma_f32_16x16x32_bf16(Bt[n][k], At[m][k], acc[ai][bj][m][n], 0, 0, 0); __builtin_amdgcn_s_setprio(0); } while (0)
#define PG8_WAIT_V(n) asm volatile("s_waitcnt vmcnt(" #n ")" ::: "memory")
#define PG8_WAIT_L(n) asm volatile("s_waitcnt lgkmcnt(" #n ")" ::: "memory")
#define PG8_BAR __builtin_amdgcn_s_barrier()
#define PG8_SCHED __builtin_amdgcn_sched_barrier(0)
    Unit cur, nxt; int ui = 0;
    if (!S.next(0, cur)) return;
    f32x4 acc[2][2][4][2];
#pragma unroll
    for (int a = 0; a < 2; ++a)
#pragma unroll
        for (int b = 0; b < 2; ++b)
#pragma unroll
            for (int m = 0; m < 4; ++m)
#pragma unroll
                for (int n = 0; n < 2; ++n) acc[a][b][m][n] = (f32x4){0.f, 0.f, 0.f, 0.f};
    bf16x8 At[4][2], B0[2][2], B1[2][2];
    unsigned vgc[2][2], vgn[2][2];
    if constexpr (GATHER) {
#pragma unroll
        for (int h = 0; h < 2; ++h)
#pragma unroll
            for (int i = 0; i < 2; ++i) { const int gr = g.gather[cur.pm * BM + h * HALF + RA[i]]; vgc[h][i] = (unsigned)(gr * g.lda + CA[i]) * 2u; vgn[h][i] = vgc[h][i]; }
    }
    const char* cA = GATHER ? (const char*)g.A : (const char*)g.A + (size_t)cur.pm * tstepA;
    const char* cB = (const char*)g.Bt + (size_t)(cur.pm >> g.bshift) * g.bstride * 2 + (size_t)cur.pn * tstepB;
    PG8_STAGE(PG8_SB(0, 0), cB, voffB); PG8_STAGE(PG8_SB(0, 1), cB + hstepB, voffB); PG8_STAGE_A(PG8_SA(0, 0), cA, 0, vgc); PG8_STAGE_A(PG8_SA(0, 1), cA, 1, vgc);
    if (wr == 1) PG8_BAR;
    PG8_WAIT_V(2); PG8_BAR;
    PG8_STAGE(PG8_SB(1, 0), cB + kstep, voffB); PG8_STAGE_A(PG8_SA(1, 0), cA + kstep, 0, vgc); PG8_STAGE(PG8_SB(1, 1), cB + hstepB + kstep, voffB);
    PG8_WAIT_V(6); PG8_BAR;
    for (;;) {
        const bool has_next = S.next(ui + 1, nxt);
        if constexpr (GATHER) {
            if (has_next) {
#pragma unroll
                for (int h = 0; h < 2; ++h)
#pragma unroll
                    for (int i = 0; i < 2; ++i) { const int gr = g.gather[nxt.pm * BM + h * HALF + RA[i]]; vgn[h][i] = (unsigned)(gr * g.lda + CA[i]) * 2u; }
            }
        }
        const char* nA = has_next ? (GATHER ? (const char*)g.A : (const char*)g.A + (size_t)nxt.pm * tstepA) : cA;
        const char* nB = has_next ? (const char*)g.Bt + (size_t)(nxt.pm >> g.bshift) * g.bstride * 2 + (size_t)nxt.pn * tstepB : cB;
#pragma nounroll
        for (int t = 0; t < nt; t += 2) {
            const bool last = (t == nt - 2);
            const char* a1 = cA + (size_t)(t + 1) * kstep;
            const char* a2 = last ? nA : cA + (size_t)(t + 2) * kstep; const char* b2 = last ? nB : cB + (size_t)(t + 2) * kstep;
            const char* a3 = a2 + kstep; const char* b3 = b2 + kstep;
            unsigned vg2[2][2];
            if constexpr (GATHER) {
#pragma unroll
                for (int h = 0; h < 2; ++h)
#pragma unroll
                    for (int i = 0; i < 2; ++i) vg2[h][i] = (last && has_next) ? vgn[h][i] : vgc[h][i];
            }
            PG8_LDB(B0, 0, 0); PG8_LDB(B1, 0, 1); PG8_SCHED; PG8_LDA(At, 0, 0); PG8_STAGE_A(PG8_SA(1, 1), a1, 1, vgc);
            PG8_WAIT_V(8); PG8_WAIT_L(0); PG8_BAR; PG8_MMA(0, 0, At, B0); PG8_MMA(0, 1, At, B1); PG8_BAR; PG8_SCHED;
            PG8_LDA(At, 0, 1); PG8_STAGE(PG8_SB(0, 0), b2, voffB); PG8_STAGE(PG8_SB(0, 1), b2 + hstepB, voffB); PG8_STAGE_A(PG8_SA(0, 0), a2, 0, vg2);
            PG8_WAIT_V(8); PG8_WAIT_L(0); PG8_BAR; PG8_MMA(1, 0, At, B0); PG8_MMA(1, 1, At, B1); PG8_BAR; PG8_SCHED;
            PG8_LDB(B0, 1, 0); PG8_LDB(B1, 1, 1); PG8_SCHED; PG8_LDA(At, 1, 0); PG8_STAGE_A(PG8_SA(0, 1), a2, 1, vg2);
            PG8_WAIT_V(8); PG8_WAIT_L(0); PG8_BAR; PG8_MMA(0, 0, At, B0); PG8_MMA(0, 1, At, B1); PG8_BAR; PG8_SCHED;
            PG8_LDA(At, 1, 1); PG8_STAGE(PG8_SB(1, 0), b3, voffB); PG8_STAGE(PG8_SB(1, 1), b3 + hstepB, voffB); PG8_STAGE_A(PG8_SA(1, 0), a3, 0, vg2);
            PG8_WAIT_V(8); PG8_WAIT_L(0); PG8_BAR; PG8_MMA(1, 0, At, B0); PG8_MMA(1, 1, At, B1); PG8_BAR; PG8_SCHED;
        }
        if (wr == 0) PG8_BAR;
        E(acc, cur, wr, wc, fr, fq);
        if (!has_next) break;
#pragma unroll
        for (int a = 0; a < 2; ++a)
#pragma unroll
            for (int b = 0; b < 2; ++b)
#pragma unroll
                for (int m = 0; m < 4; ++m)
#pragma unroll
                    for (int n = 0; n < 2; ++n) acc[a][b][m][n] = (f32x4){0.f, 0.f, 0.f, 0.f};
        cur = nxt; cA = nA; cB = nB; ++ui;
        if constexpr (GATHER) {
#pragma unroll
            for (int h = 0; h < 2; ++h)
#pragma unroll
                for (int i = 0; i < 2; ++i) vgc[h][i] = vgn[h][i];
        }
        if (wr == 1) PG8_BAR;
    }
    PG8_WAIT_V(0);
    PG8_BAR;
#undef PG8_SA
#undef PG8_SB
#undef PG8_STAGE
#undef PG8_STAGE_A
#undef PG8_LDA
#undef PG8_LDB
#undef PG8_MMA
#undef PG8_WAIT_V
#undef PG8_WAIT_L
#undef PG8_BAR
#undef PG8_SCHED
}
}
namespace pg8 {
struct EpiStoreBf16 {
    static constexpr bool PERM = true;
    bf16_t* O; int ldc;
    __device__ __forceinline__ void operator()(const f32x4 (&acc)[2][2][4][2], const Unit& u, int wr, int wc, int fr, int fq) const {
        const int row0 = u.pm * BM + wr * 64 + fr, col0 = u.pn * BM + wc * 32 + 8 * fq;
#pragma unroll
        for (int ai = 0; ai < 2; ++ai)
#pragma unroll
            for (int m = 0; m < 4; ++m) { bf16_t* rowp = O + (size_t)(row0 + ai * HALF + m * 16) * ldc + col0;
#pragma unroll
                for (int bj = 0; bj < 2; ++bj) { const f32x4 v0 = acc[ai][bj][m][0], v1 = acc[ai][bj][m][1];
                    u32x4 w; w.x = cvt_pk_bf16(v0[0], v0[1]); w.y = cvt_pk_bf16(v0[2], v0[3]); w.z = cvt_pk_bf16(v1[0], v1[1]); w.w = cvt_pk_bf16(v1[2], v1[3]);
                    *(u32x4*)(rowp + bj * HALF) = w; } }
    }
};
struct EpiQRope {
    static constexpr bool PERM = true;
    bf16_t* O; const f32x2* tab;
    __device__ __forceinline__ void operator()(const f32x4 (&acc)[2][2][4][2], const Unit& u, int wr, int wc, int fr, int fq) const {
        const int row0 = u.pm * BM + wr * 64 + fr, col0 = u.pn * BM + wc * 32 + 8 * fq;
#pragma unroll
        for (int bj = 0; bj < 2; ++bj) {
            const int col = col0 + bj * HALF, within = col % 192;
            const bool pe = within >= 128; const int p0 = (within - 128) >> 1;
#pragma unroll
            for (int ai = 0; ai < 2; ++ai)
#pragma unroll
                for (int m = 0; m < 4; ++m) { const int row = row0 + ai * HALF + m * 16;
                    f32x4 v0 = acc[ai][bj][m][0], v1 = acc[ai][bj][m][1];
                    if (pe) { const f32x2* tp = tab + (size_t)(row & 4095) * 32 + p0; const f32x4 t01 = *(const f32x4*)tp, t23 = *(const f32x4*)(tp + 2);
                        const f32x4 a = v0, b = v1;
                        v0[0] = a[0] * t01[0] - a[1] * t01[1]; v0[1] = a[0] * t01[1] + a[1] * t01[0]; v0[2] = a[2] * t01[2] - a[3] * t01[3]; v0[3] = a[2] * t01[3] + a[3] * t01[2];
                        v1[0] = b[0] * t23[0] - b[1] * t23[1]; v1[1] = b[0] * t23[1] + b[1] * t23[0]; v1[2] = b[2] * t23[2] - b[3] * t23[3]; v1[3] = b[2] * t23[3] + b[3] * t23[2]; }
                    u32x4 w; w.x = cvt_pk_bf16(v0[0], v0[1]); w.y = cvt_pk_bf16(v0[2], v0[3]); w.z = cvt_pk_bf16(v1[0], v1[1]); w.w = cvt_pk_bf16(v1[2], v1[3]);
                    *(u32x4*)(O + (size_t)row * 1536 + col) = w; asm volatile("" ::: "memory"); }
        }
    }
};
struct EpiKV {
    static constexpr bool PERM = true;
    bf16_t* Km; bf16_t* Vm;
    __device__ __forceinline__ void operator()(const f32x4 (&acc)[2][2][4][2], const Unit& u, int wr, int wc, int fr, int fq) const {
        const int row0 = u.pm * BM + wr * 64 + fr, c = wc * 32 + 8 * fq;
#pragma unroll
        for (int ai = 0; ai < 2; ++ai)
#pragma unroll
            for (int m = 0; m < 4; ++m) { const size_t row = (size_t)(row0 + ai * HALF + m * 16);
#pragma unroll
                for (int bj = 0; bj < 2; ++bj) { const f32x4 v0 = acc[ai][bj][m][0], v1 = acc[ai][bj][m][1];
                    u32x4 w; w.x = cvt_pk_bf16(v0[0], v0[1]); w.y = cvt_pk_bf16(v0[2], v0[3]); w.z = cvt_pk_bf16(v1[0], v1[1]); w.w = cvt_pk_bf16(v1[2], v1[3]);
                    if (bj == 0) *(u32x4*)(Km + row * 1536 + u.pn * 192 + c) = w; else *(u32x4*)(Vm + row * 1024 + u.pn * 128 + c) = w; }
                asm volatile("" ::: "memory"); }
    }
};
struct EpiResid {
    static constexpr bool PERM = false;
    const float* X; float* Y; float alpha;
    __device__ __forceinline__ void operator()(const f32x4 (&acc)[2][2][4][2], const Unit& u, int wr, int wc, int fr, int fq) const {
        const int row0 = u.pm * BM + wr * 64 + fr, col0 = u.pn * BM + wc * 32 + 4 * fq;
#pragma unroll
        for (int ai = 0; ai < 2; ++ai)
#pragma unroll
            for (int m = 0; m < 4; ++m) { const size_t off = (size_t)(row0 + ai * HALF + m * 16) * 2048 + col0;
#pragma unroll
                for (int bj = 0; bj < 2; ++bj)
#pragma unroll
                    for (int n = 0; n < 2; ++n) { const f32x4 xv = *(const f32x4*)(X + off + bj * HALF + n * 16); *(f32x4*)(Y + off + bj * HALF + n * 16) = xv * alpha + acc[ai][bj][m][n]; }
                if (m & 1) asm volatile("" ::: "memory"); }
    }
};
struct EpiSwiglu {
    static constexpr bool PERM = true;
    bf16_t* O;
    __device__ __forceinline__ void operator()(const f32x4 (&acc)[2][2][4][2], const Unit& u, int wr, int wc, int fr, int fq) const {
        const int row0 = u.pm * BM + wr * 64 + fr, col0 = u.pn * HALF + wc * 32 + 8 * fq;
#pragma unroll
        for (int ai = 0; ai < 2; ++ai)
#pragma unroll
            for (int m = 0; m < 4; ++m) { float h[8];
#pragma unroll
                for (int n = 0; n < 2; ++n)
#pragma unroll
                    for (int j = 0; j < 4; ++j) { const float a = acc[ai][0][m][n][j], b = acc[ai][1][m][n][j]; h[n * 4 + j] = a * __builtin_amdgcn_rcpf(1.f + __expf(-a)) * b; }
                u32x4 w; w.x = cvt_pk_bf16(h[0], h[1]); w.y = cvt_pk_bf16(h[2], h[3]); w.z = cvt_pk_bf16(h[4], h[5]); w.w = cvt_pk_bf16(h[6], h[7]);
                *(u32x4*)(O + (size_t)(row0 + ai * HALF + m * 16) * 1536 + col0) = w; }
    }
};
struct EpiGate {
    static constexpr bool PERM = true;
    bf16_t* O; const float* gate;
    __device__ __forceinline__ void operator()(const f32x4 (&acc)[2][2][4][2], const Unit& u, int wr, int wc, int fr, int fq) const {
        const int row0 = u.pm * BM + wr * 64 + fr, col0 = u.pn * BM + wc * 32 + 8 * fq;
#pragma unroll
        for (int ai = 0; ai < 2; ++ai)
#pragma unroll
            for (int m = 0; m < 4; ++m) { const int row = row0 + ai * HALF + m * 16; const float gt = gate[row]; bf16_t* rowp = O + (size_t)row * 2048 + col0;
#pragma unroll
                for (int bj = 0; bj < 2; ++bj) { const f32x4 v0 = acc[ai][bj][m][0] * gt, v1 = acc[ai][bj][m][1] * gt;
                    u32x4 w; w.x = cvt_pk_bf16(v0[0], v0[1]); w.y = cvt_pk_bf16(v0[2], v0[3]); w.z = cvt_pk_bf16(v1[0], v1[1]); w.w = cvt_pk_bf16(v1[2], v1[3]);
                    *(u32x4*)(rowp + bj * HALF) = w; } }
    }
};
}
namespace attn {
constexpr int NW = 8, QBLK = 32, KVBLK = 64, DV = 128;
#define SBAR() __builtin_amdgcn_sched_barrier(0)
__device__ __forceinline__ int crow(int r, int hi) { return (r & 3) + 8 * (r >> 2) + 4 * hi; }
template <int DQK> __device__ __forceinline__ int kswz(int row, int colB) {
    if constexpr (DQK == 128) return row * 256 + (colB ^ ((row & 7) << 4));
    else return row * (DQK * 2) + (colB ^ (((row >> 1) & 7) << 4));
}
template <int DQK> struct Shm { static constexpr int V = KVBLK * DV * 2, K = KVBLK * DQK * 2, TOTAL = 3 * V + 3 * K + NW * 64 * 4; };

template <float const& CREF> struct Dummy {};
__device__ __forceinline__ void partialSM(f32x16& p0, f32x16& p1, float& m_reg, float& mn, float& alpha, const float C, const float thr) {
  float pmax = p0[0];
#pragma unroll
  for (int r = 1; r < 16; ++r) pmax = fmaxf(pmax, p0[r]);
#pragma unroll
  for (int r = 0; r < 16; ++r) pmax = fmaxf(pmax, p1[r]);
  { auto rr = __builtin_amdgcn_permlane32_swap(__float_as_uint(pmax), __float_as_uint(pmax), false, false);
    pmax = fmaxf(__uint_as_float(rr[0]), __uint_as_float(rr[1])); }
  if (__builtin_expect(__all(pmax - m_reg <= thr), 1)) { mn = m_reg; alpha = 1.f; }
  else { mn = fmaxf(m_reg, pmax); alpha = __builtin_amdgcn_exp2f((m_reg - mn) * C); m_reg = mn; }
  float mnC = -mn * C;
#pragma unroll
  for (int r = 0; r < 16; ++r) p0[r] = fmaf(p0[r], C, mnC);
#pragma unroll
  for (int r = 0; r < 16; ++r) p1[r] = fmaf(p1[r], C, mnC);
#pragma unroll
  for (int r = 0; r < 16; ++r) p0[r] = __builtin_amdgcn_exp2f(p0[r]);
}
__device__ __forceinline__ void finishSM(f32x16& p0, f32x16& p1, float alpha, float& l_reg, bf16x8& pa0, bf16x8& pa1, bf16x8& pa2, bf16x8& pa3) {
#pragma unroll
  for (int r = 0; r < 16; ++r) p1[r] = __builtin_amdgcn_exp2f(p1[r]);
  float ps = 0;
#pragma unroll
  for (int r = 0; r < 16; ++r) ps += p0[r];
#pragma unroll
  for (int r = 0; r < 16; ++r) ps += p1[r];
  { auto rr = __builtin_amdgcn_permlane32_swap(__float_as_uint(ps), __float_as_uint(ps), false, false);
    ps = __uint_as_float(rr[0]) + __uint_as_float(rr[1]); }
  l_reg = l_reg * alpha + ps;
#define PK4(P, BASE, OUT) do { unsigned a0 = cvt_pk_bf16(P[BASE + 0], P[BASE + 1]), a1 = cvt_pk_bf16(P[BASE + 2], P[BASE + 3]);   \
    unsigned b0 = cvt_pk_bf16(P[BASE + 4], P[BASE + 5]), b1 = cvt_pk_bf16(P[BASE + 6], P[BASE + 7]);                              \
    auto r0 = __builtin_amdgcn_permlane32_swap(a0, b0, false, false); auto r1 = __builtin_amdgcn_permlane32_swap(a1, b1, false, false); \
    u32x4 w = {r0[0], r1[0], r0[1], r1[1]}; OUT = *reinterpret_cast<bf16x8*>(&w); } while (0)
  PK4(p0, 0, pa0); PK4(p0, 8, pa1); PK4(p1, 0, pa2); PK4(p1, 8, pa3);
#undef PK4
}
template <int DQK>
__device__ __forceinline__ void qkt(f32x16& p0, f32x16& p1, const char* Ks, const bf16x8* qr, int r32, int hi) {
  p0 = f32x16{}; p1 = f32x16{};
#pragma unroll
  for (int d0 = 0; d0 < DQK / 16; ++d0) { int cb = (d0 * 16 + hi * 8) * 2;
    bf16x8 b0 = *reinterpret_cast<const bf16x8*>(Ks + kswz<DQK>(r32, cb));
    bf16x8 b1 = *reinterpret_cast<const bf16x8*>(Ks + kswz<DQK>(32 + r32, cb));
    p0 = __builtin_amdgcn_mfma_f32_32x32x16_bf16(b0, qr[d0], p0, 0, 0, 0);
    p1 = __builtin_amdgcn_mfma_f32_32x32x16_bf16(b1, qr[d0], p1, 0, 0, 0); }
}
__device__ __forceinline__ int v_st(int k, int c) { const int kk = (k & ~0xC) | ((k & 4) << 1) | ((k & 8) >> 1); return ((kk >> 3) * 4 + (c >> 5)) * 512 + ((kk & 7) * 32 + (c & 31)) * 2; }
__device__ __forceinline__ int v_rd_base(int lane) { return ((lane & 3) << 3) | (((lane >> 2) & 3) << 6) | (((lane >> 4) & 1) << 5) | (((lane >> 5) & 1) << 8); }
constexpr int v_rd_off(int d0, int ks, int half) { return d0 * 512 + ks * 4096 + half * 2048; }
template <int OFF> __device__ __forceinline__ s16x4 tr_read(int vb) {
  s16x4 r; asm volatile("ds_read_b64_tr_b16 %0, %1 offset:%2" : "=&v"(r) : "v"(vb), "i"(OFF) : "memory"); return r;
}
template <int D0> __device__ __forceinline__ void pv_one(f32x16& od, int vb, bf16x8 pa0, bf16x8 pa1, bf16x8 pa2, bf16x8 pa3) {
  const s16x4 l0 = tr_read<v_rd_off(D0, 0, 0)>(vb), h0 = tr_read<v_rd_off(D0, 0, 1)>(vb), l1 = tr_read<v_rd_off(D0, 1, 0)>(vb), h1 = tr_read<v_rd_off(D0, 1, 1)>(vb);
  const s16x4 l2 = tr_read<v_rd_off(D0, 2, 0)>(vb), h2 = tr_read<v_rd_off(D0, 2, 1)>(vb), l3 = tr_read<v_rd_off(D0, 3, 0)>(vb), h3 = tr_read<v_rd_off(D0, 3, 1)>(vb);
  asm volatile("s_waitcnt lgkmcnt(0)" ::: "memory"); SBAR();
#define PK(L, H) (bf16x8){L[0], L[1], L[2], L[3], H[0], H[1], H[2], H[3]}
  od = __builtin_amdgcn_mfma_f32_32x32x16_bf16(pa0, PK(l0, h0), od, 0, 0, 0);
  od = __builtin_amdgcn_mfma_f32_32x32x16_bf16(pa1, PK(l1, h1), od, 0, 0, 0);
  od = __builtin_amdgcn_mfma_f32_32x32x16_bf16(pa2, PK(l2, h2), od, 0, 0, 0);
  od = __builtin_amdgcn_mfma_f32_32x32x16_bf16(pa3, PK(l3, h3), od, 0, 0, 0);
#undef PK
}
__device__ __forceinline__ void pv_d0(f32x16* o, int vb, bf16x8 pa0, bf16x8 pa1, bf16x8 pa2, bf16x8 pa3) {
  pv_one<0>(o[0], vb, pa0, pa1, pa2, pa3); pv_one<1>(o[1], vb, pa0, pa1, pa2, pa3); pv_one<2>(o[2], vb, pa0, pa1, pa2, pa3); pv_one<3>(o[3], vb, pa0, pa1, pa2, pa3);
}

__device__ __forceinline__ void glds16(const void* gsrc, unsigned lds_dst) { unsigned keep;
  asm volatile("s_mov_b32 %0, m0\n\ts_mov_b32 m0, %2\n\ts_nop 0\n\tglobal_load_lds_dwordx4 %1, off\n\ts_mov_b32 m0, %0" : "=&s"(keep) : "v"(gsrc), "s"(lds_dst) : "memory"); }
#define ATT_WAIT_BAR(N) asm volatile("s_waitcnt vmcnt(" #N ") lgkmcnt(0)\n\ts_barrier" ::: "memory")
__device__ __forceinline__ int nx3(int s) { return s == 2 ? 0 : s + 1; }
template <int DQK, int LDQ, int LDK, int LDV, int LDO>
__device__ __forceinline__ void attn_unit(const bf16_t* __restrict__ Qb, const bf16_t* __restrict__ Kh, const bf16_t* __restrict__ Vh, bf16_t* __restrict__ Ob, int seq, char* lds) {
  constexpr float scale = (DQK == 128) ? 0.08838834764831845f : 0.07216878364870323f;
  constexpr int SHM_V = KVBLK * DV * 2, SHM_K = KVBLK * DQK * 2, NQ = DQK / 16, NKP = SHM_K / 8192;
  constexpr int KRING = 0, VRING = 3 * SHM_K, WSOFF = 3 * SHM_K + 3 * SHM_V;
  constexpr float C = scale * 1.4426950408889634f, thr = 8.f / scale;
  int tid_ = threadIdx.x; asm volatile("" : "+v"(tid_));
  const int tid = tid_, lane = tid & 63, r32 = lane & 31, hi = lane >> 5; const int wid = __builtin_amdgcn_readfirstlane(tid >> 6);
  const unsigned lds0 = (unsigned)(uintptr_t)lds;
  float* ws = (float*)(lds + WSOFF) + wid * 64; float* li_l = ws; float* al_l = ws + 32;
  float m_reg = -1e30f, l_reg = 0; f32x16 o[4] = {}; bf16x8 qr[NQ];
  const bf16_t* Qw = Qb + (long)(wid * QBLK + r32) * LDQ + hi * 8;
#pragma unroll
  for (int d0 = 0; d0 < NQ; ++d0) qr[d0] = *reinterpret_cast<const bf16x8*>(Qw + d0 * 16);
  int koff[NKP], voff[2];
#pragma unroll
  for (int p = 0; p < NKP; ++p) { const int P = (p * 8 + wid) * 1024 + lane * 16, row = P / (DQK * 2), cs = P % (DQK * 2);
    const int colB = (DQK == 128) ? (cs ^ ((row & 7) << 4)) : (cs ^ (((row >> 1) & 7) << 4)); koff[p] = row * LDK + (colB >> 1); }
#pragma unroll
  for (int p = 0; p < 2; ++p) { const int P = (p * 8 + wid) * 1024 + lane * 16, sub = P >> 9, w5 = P & 511, kk = (sub >> 2) * 8 + (w5 >> 6), c = (sub & 3) * 32 + ((w5 & 63) >> 1);
    const int k = (kk & ~0xC) | ((kk & 4) << 1) | ((kk & 8) >> 1); voff[p] = k * LDV + c; }
#define DMA_K(t, slot) do { _Pragma("unroll") for (int p = 0; p < NKP; ++p) glds16(Kh + (long)(t) * KVBLK * LDK + koff[p], (unsigned)__builtin_amdgcn_readfirstlane((int)(lds0 + KRING + (slot) * SHM_K + (p * 8 + wid) * 1024))); } while (0)
#define DMA_V(t, slot) do { _Pragma("unroll") for (int p = 0; p < 2; ++p) glds16(Vh + (long)(t) * KVBLK * LDV + voff[p], (unsigned)__builtin_amdgcn_readfirstlane((int)(lds0 + VRING + (slot) * SHM_V + (p * 8 + wid) * 1024))); } while (0)
#define RESC(a) do { if (__any((a) < 1.f)) { if (hi == 0) al_l[r32] = (a); asm volatile("s_waitcnt lgkmcnt(0)" ::: "memory"); \
    _Pragma("unroll") for (int d = 0; d < 4; ++d) _Pragma("unroll") for (int r = 0; r < 16; ++r) o[d][r] *= al_l[crow(r, hi)]; } } while (0)
#define CLOSE(t) do { if ((t) + 2 < NT) { if constexpr (NKP == 2) ATT_WAIT_BAR(4); else ATT_WAIT_BAR(5); } else ATT_WAIT_BAR(0); } while (0)
  const int vb0 = (int)(lds0 + VRING) + v_rd_base(lane);
  const char* Kr = lds + KRING;
  f32x16 pA0, pA1, pB0, pB1; float mnA, mnB, alA, alB; bf16x8 pa0, pa1, pa2, pa3; const int NT = seq / KVBLK;
  DMA_K(0, 0); DMA_V(0, 0); DMA_K(1, 1);
  if constexpr (NKP == 2) ATT_WAIT_BAR(2); else ATT_WAIT_BAR(3);
  DMA_K(2, 2); DMA_V(1, 1);
  qkt<DQK>(pA0, pA1, Kr, qr, r32, hi); partialSM(pA0, pA1, m_reg, mnA, alA, C, thr);
  CLOSE(0);
  int sk = 1;
  for (int j = 1; j + 1 < NT; j += 2) {
    { const int s1 = nx3(sk), s2 = nx3(s1);
      if (j + 2 < NT) DMA_K(j + 2, s2); DMA_V(j + 1, s1);
      SBAR(); qkt<DQK>(pB0, pB1, Kr + sk * SHM_K, qr, r32, hi);
      finishSM(pA0, pA1, alA, l_reg, pa0, pa1, pa2, pa3); SBAR();
      pv_d0(o, vb0 + s2 * SHM_V, pa0, pa1, pa2, pa3); partialSM(pB0, pB1, m_reg, mnB, alB, C, thr);
      RESC(alB); CLOSE(j); sk = s1; }
    { const int s1 = nx3(sk), s2 = nx3(s1);
      if (j + 3 < NT) DMA_K(j + 3, s2); if (j + 2 < NT) DMA_V(j + 2, s1);
      SBAR(); qkt<DQK>(pA0, pA1, Kr + sk * SHM_K, qr, r32, hi);
      finishSM(pB0, pB1, alB, l_reg, pa0, pa1, pa2, pa3); SBAR();
      pv_d0(o, vb0 + s2 * SHM_V, pa0, pa1, pa2, pa3); partialSM(pA0, pA1, m_reg, mnA, alA, C, thr);
      RESC(alA); CLOSE(j + 1); sk = s1; }
  }
  { const int s1 = nx3(sk), s2 = nx3(s1);
    SBAR(); qkt<DQK>(pB0, pB1, Kr + sk * SHM_K, qr, r32, hi);
    finishSM(pA0, pA1, alA, l_reg, pa0, pa1, pa2, pa3); SBAR();
    pv_d0(o, vb0 + s2 * SHM_V, pa0, pa1, pa2, pa3); partialSM(pB0, pB1, m_reg, mnB, alB, C, thr);
    RESC(alB);
    finishSM(pB0, pB1, alB, l_reg, pa0, pa1, pa2, pa3); SBAR();
    pv_d0(o, vb0 + sk * SHM_V, pa0, pa1, pa2, pa3); (void)s1; }
  if (hi == 0) li_l[r32] = l_reg; asm volatile("s_waitcnt lgkmcnt(0)" ::: "memory");
  float rli[16];
#pragma unroll
  for (int r = 0; r < 16; ++r) rli[r] = __builtin_amdgcn_rcpf(li_l[crow(r, hi)]);
  bf16_t* Ow = Ob + (long)(wid * QBLK) * LDO;
#pragma unroll
  for (int r = 0; r < 16; ++r) { int orow = crow(r, hi);
#pragma unroll
    for (int d0 = 0; d0 < 4; ++d0) Ow[(long)orow * LDO + d0 * 32 + r32] = f2bf(o[d0][r] * rli[r]); }
  ATT_WAIT_BAR(0);
#undef DMA_K
#undef DMA_V
#undef RESC
#undef CLOSE
}
}
constexpr int BATCH = 4, SEQ = 4096, DM = 2048, M = BATCH * SEQ, DEPTH = 4;
constexpr int NEXP = 16, FF = 1536, CAP = 512, MX = NEXP * BATCH * CAP;
constexpr int HW = 4096;
constexpr int C_CQ = 0, C_CKV = 512, C_GQ = 768, C_GK = 1280, C_GV = 1792, C_GR = 2816, C_KR = 3840, C_LAT = 3904;
constexpr float LN_EPS = 1e-5f, RMS_EPS = 1e-6f;
constexpr float DN_ALPHA = 1.681792830507429f;
constexpr float MLA_SCALE = 0.07216878364870323f;
constexpr float GQA_SCALE = 0.08838834764831845f;

constexpr size_t MiB = 1u << 20;
constexpr size_t WS_CTL = 0, CTL_ZERO_BYTES = 1 * MiB;
constexpr size_t WS_ROPER = 1 * MiB, WS_ROPEG = 2 * MiB, WS_AFF = 4 * MiB, WS_IDX = 5 * MiB, WS_GATE = 5 * MiB + 512 * 1024, WS_SLOT = 6 * MiB, WS_DECAY = 7 * MiB;
constexpr size_t WS_WIN = 8 * MiB, WS_WUQ = 40 * MiB, WS_WUKV = 43 * MiB, WS_WMO = 48 * MiB, WS_WQKV = 64 * MiB, WS_WGO = 88 * MiB, WS_W13 = 104 * MiB, WS_W2 = 872 * MiB;
constexpr size_t WS_XB = 1256 * MiB, WS_X1 = 1320 * MiB, WS_X1B = 1448 * MiB, WS_H = 1512 * MiB, WS_QM = 1640 * MiB, WS_KM = 1688 * MiB, WS_VM = 1736 * MiB, WS_OCAT = 1768 * MiB;
constexpr size_t WS_QIN = 1832 * MiB, WS_KIN = 1864 * MiB, WS_KST = 1896 * MiB, WS_VT = 1928 * MiB, WS_OF = 1960 * MiB, WS_OB = 2024 * MiB, WS_HDN = 2088 * MiB, WS_Y = 2184 * MiB, WS_END = 2312 * MiB;
constexpr int CW_TMO = 0, CW_DBG = 2, CW_BAR = 4096;

constexpr int RING_BYTES = 131072, MISC_OFF = RING_BYTES + 320, LDS_BYTES = 147456;
constexpr int NWAVES = 8, NTHR = 512;

#define RLX_AGENT __ATOMIC_RELAXED, __HIP_MEMORY_SCOPE_AGENT
#define LDS_WAIT() asm volatile("s_waitcnt lgkmcnt(0)" ::: "memory")
#define VM_WAIT() asm volatile("s_waitcnt vmcnt(0)" ::: "memory")

#define XB_TMO      128
#define XB_XCNT(j)  (256  + 64 * (j))
#define XB_XSUB(j)  (1280 + 64 * (j))
#define XB_XGEN(j)  (2304 + 64 * (j))
#define XB_TOP      3328
#define XB_TOPGEN   3392
#define XCD_BAR_WORDS 3456
#define XB_SPIN_CAP (1u << 22)
__device__ __forceinline__ unsigned xb_ld(unsigned* p)              { return __hip_atomic_load(p, __ATOMIC_RELAXED, __HIP_MEMORY_SCOPE_AGENT); }
__device__ __forceinline__ unsigned xb_add(unsigned* p, unsigned v) { return __hip_atomic_fetch_add(p, v, __ATOMIC_RELAXED, __HIP_MEMORY_SCOPE_AGENT); }
__device__ __forceinline__ unsigned xb_xcc_id() { return (unsigned)__builtin_amdgcn_s_getreg((3 << 11) | 20) & 0xFu; }
#define XB_SPIN(cond, bar) do { unsigned _sp = 0; while (cond) { __builtin_amdgcn_s_sleep(1); \
    if ((++_sp & 255u) == 0u) { if (xb_ld(&(bar)[XB_TMO])) break; if (_sp > XB_SPIN_CAP) { atomicAdd(&(bar)[XB_TMO], 1u); break; } } } } while (0)
struct XcdBarrier { unsigned* bar; unsigned x; volatile LAS unsigned* st; };
__device__ __forceinline__ XcdBarrier xcd_barrier_post(unsigned* bar, volatile LAS unsigned* st) {
    XcdBarrier b; b.bar = bar; b.x = xb_xcc_id(); b.st = st;
    if (threadIdx.x == 0) (void)xb_add(&bar[XB_XCNT(b.x)], 1u);
    return b;
}
__device__ __forceinline__ void xcd_barrier_complete(unsigned* bar, unsigned x, unsigned& nloc, unsigned& nx) {
    const unsigned G = gridDim.x * gridDim.y * gridDim.z;
    unsigned sum, cnt, mine, sp = 0u;
    for (;;) {
        sum = 0u; cnt = 0u; mine = 0u;
#pragma unroll
        for (unsigned j = 0; j < 16; ++j) { const unsigned c = xb_ld(&bar[XB_XCNT(j)]); sum += c; cnt += (c > 0u) ? 1u : 0u; mine = (j == x) ? c : mine; }
        if (sum == G) break;
        __builtin_amdgcn_s_sleep(1);
        if ((++sp & 255u) == 0u) { if (xb_ld(&bar[XB_TMO])) break; if (sp > XB_SPIN_CAP) { atomicAdd(&bar[XB_TMO], 1u); break; } }
    }
    nloc = mine > 0u ? mine : 1u; nx = cnt > 0u ? cnt : 1u;
}
__device__ __forceinline__ void xcd_barrier(const XcdBarrier& b) {
    asm volatile("s_waitcnt vmcnt(0)" ::: "memory");
    __syncthreads();
    if (threadIdx.x == 0) {
        unsigned* bar = b.bar;
        __builtin_amdgcn_s_waitcnt(0);
        unsigned nloc = b.st[0], nx = b.st[1];
        if (nloc == 0u) { xcd_barrier_complete(bar, b.x, nloc, nx); b.st[0] = nloc; b.st[1] = nx; }
        const unsigned old = xb_add(&bar[XB_XSUB(b.x)], 1u);
        const unsigned gen = old / nloc;
        if (old + 1u == (gen + 1u) * nloc) {
            __builtin_amdgcn_fence(__ATOMIC_RELEASE, "agent");
            asm volatile("s_waitcnt vmcnt(0)" ::: "memory");
            const unsigned og = xb_add(&bar[XB_TOP], 1u);
            const unsigned tg = og / nx;
            if (og + 1u == (tg + 1u) * nx) xb_add(&bar[XB_TOPGEN], 1u);
            else XB_SPIN(xb_ld(&bar[XB_TOPGEN]) == tg, bar);
            __builtin_amdgcn_fence(__ATOMIC_ACQUIRE, "agent");
            xb_add(&bar[XB_XGEN(b.x)], 1u);
            asm volatile("s_waitcnt vmcnt(0)" ::: "memory");
        } else {
            XB_SPIN(xb_ld(&bar[XB_XGEN(b.x)]) == gen, bar);
            __builtin_amdgcn_fence(__ATOMIC_ACQUIRE, "agent");
            asm volatile("s_waitcnt vmcnt(0)" ::: "memory");
        }
    }
    __syncthreads();
}

__device__ __forceinline__ float wave_sum(float v) {
#pragma unroll
    for (int o = 1; o < 64; o <<= 1) v += __shfl_xor(v, o);
    return v;
}
__device__ __forceinline__ int wave_sum_i(int v) {
#pragma unroll
    for (int o = 1; o < 64; o <<= 1) v += __shfl_xor(v, o);
    return v;
}
#define WG_BAR() do { asm volatile("s_waitcnt lgkmcnt(0)" ::: "memory"); __builtin_amdgcn_s_barrier(); asm volatile("" ::: "memory"); } while (0)

struct Ctx { LAS unsigned char* lds; int tid, lane, wave, vcu, G; };
__device__ __forceinline__ Ctx opaque_ctx(const Ctx& c) { Ctx d = c; asm volatile("" : "+v"(d.tid)); d.lane = d.tid & 63; d.wave = __builtin_amdgcn_readfirstlane(d.tid >> 6); return d; }

__device__ __forceinline__ void transpose_item(const float* W, int K, int N, bf16_t* WT, int dst_row0, int k0, int n0, LAS float* scr, int lane) {
#pragma unroll 8
    for (int i = 0; i < 32; ++i) { const int kk = 2 * i + (lane >> 5); scr[kk * 33 + (lane & 31)] = W[(size_t)(k0 + kk) * N + n0 + (lane & 31)]; }
    LDS_WAIT(); asm volatile("" ::: "memory");
    const int c = lane & 7;
#pragma unroll
    for (int j = 0; j < 4; ++j) { const int n = (lane >> 3) + 8 * j; const LAS float* s = scr + (8 * c) * 33 + n;
        u32x4 o; o.x = cvt_pk_bf16(s[0 * 33], s[1 * 33]); o.y = cvt_pk_bf16(s[2 * 33], s[3 * 33]); o.z = cvt_pk_bf16(s[4 * 33], s[5 * 33]); o.w = cvt_pk_bf16(s[6 * 33], s[7 * 33]);
        *(u32x4*)(WT + (size_t)(dst_row0 + n) * K + k0 + 8 * c) = o; }
    LDS_WAIT(); asm volatile("" ::: "memory");
}
__device__ __forceinline__ int map_row(int map, int n0) {
    if (map == 1) return (n0 < 768) ? n0 : (n0 < 832 ? n0 + 3072 : (n0 < 3904 ? n0 - 64 : n0));
    if (map == 2) return (n0 >> 7) * 256 + (n0 & 127);
    if (map == 3) return (n0 >> 7) * 256 + 128 + (n0 & 127);
    return n0;
}
__device__ __forceinline__ void transpose_batch(const Ctx& c, const float* src, bf16_t* dst, int K, int N, int nmat, size_t src_ms, size_t dst_ms, int map) {
    LAS float* scr = (LAS float*)(c.lds + c.wave * 16384);
    const int gw = c.vcu * NWAVES + c.wave, NGW = c.G * NWAVES;
    const int nblk = N / 32, per = (K / 64) * nblk; const long total = (long)per * nmat;
    for (long it = gw; it < total; it += NGW) {
        const int mat = (int)(it / per), r = (int)(it % per), kb = r / nblk, nb = r % nblk;
        transpose_item(src + (size_t)mat * src_ms, K, N, dst + (size_t)mat * dst_ms, map_row(map, nb * 32), kb * 64, nb * 32, scr, c.lane);
    }
}

__device__ __forceinline__ void fill_rope(const Ctx& c, f32x2* tabR, f32x2* tabG) {
    const int gt = (c.vcu * NTHR + c.tid), NT = c.G * NTHR;
    for (int i = gt; i < SEQ * 32; i += NT) { const int t = i >> 5, p = i & 31, j = p & 15; const float inv = exp2f(-(float)(2 * j) * (13.287712379549449f / 32.f));
        const float pos = (float)(p < 16 ? (t >> 6) : (t & 63)); const float a = pos * inv; tabR[i] = (f32x2){cosf(a), sinf(a)}; }
    for (int i = gt; i < SEQ * 64; i += NT) { const int t = i >> 6, p = i & 63, j = p & 31; const float inv = exp2f(-(float)(2 * j) * (13.287712379549449f / 64.f));
        const float pos = (float)(p < 32 ? (t >> 6) : (t & 63)); const float a = pos * inv; tabG[i] = (f32x2){cosf(a), sinf(a)}; }
}
__device__ __forceinline__ void cvt_rows_bf16(const Ctx& c, const float* x, bf16_t* xb) {
    const long gt = (long)c.vcu * NTHR + c.tid, NT = (long)c.G * NTHR, n8 = (long)M * DM / 8;
    for (long i = gt; i < n8; i += NT) { const f32x4 a = *(const f32x4*)(x + i * 8), b = *(const f32x4*)(x + i * 8 + 4);
        u32x4 w; w.x = cvt_pk_bf16(a[0], a[1]); w.y = cvt_pk_bf16(a[2], a[3]); w.z = cvt_pk_bf16(b[0], b[1]); w.w = cvt_pk_bf16(b[2], b[3]); *(u32x4*)(xb + i * 8) = w; }
}

__device__ __forceinline__ void mla_prep_rows(const Ctx& c, bf16_t* H, bf16_t* Km, const float* qn, const float* kvn, const f32x2* tabR) {
    const int gw = c.vcu * NWAVES + c.wave, NGW = c.G * NWAVES, lane = c.lane;
    for (int r = gw; r < M; r += NGW) {
        bf16_t* h = H + (size_t)r * HW;
        { u32x4 w = *(const u32x4*)(h + C_CQ + lane * 8); float f[8] = {bf_lo(w.x), bf_hi(w.x), bf_lo(w.y), bf_hi(w.y), bf_lo(w.z), bf_hi(w.z), bf_lo(w.w), bf_hi(w.w)};
          float s = 0.f;
#pragma unroll
          for (int i = 0; i < 8; ++i) s += f[i] * f[i];
          const float rs = rsqrtf(wave_sum(s) * (1.f / 512.f) + RMS_EPS);
          const f32x4 g0 = *(const f32x4*)(qn + lane * 8), g1 = *(const f32x4*)(qn + lane * 8 + 4);
          u32x4 o; o.x = cvt_pk_bf16(f[0] * rs * g0[0], f[1] * rs * g0[1]); o.y = cvt_pk_bf16(f[2] * rs * g0[2], f[3] * rs * g0[3]);
          o.z = cvt_pk_bf16(f[4] * rs * g1[0], f[5] * rs * g1[1]); o.w = cvt_pk_bf16(f[6] * rs * g1[2], f[7] * rs * g1[3]);
          *(u32x4*)(h + C_CQ + lane * 8) = o; }
        { u32x2 w = *(const u32x2*)(h + C_CKV + lane * 4); float f[4] = {bf_lo(w.x), bf_hi(w.x), bf_lo(w.y), bf_hi(w.y)};
          const float s = f[0] * f[0] + f[1] * f[1] + f[2] * f[2] + f[3] * f[3];
          const float rs = rsqrtf(wave_sum(s) * (1.f / 256.f) + RMS_EPS);
          const f32x4 g0 = *(const f32x4*)(kvn + lane * 4);
          u32x2 o; o.x = cvt_pk_bf16(f[0] * rs * g0[0], f[1] * rs * g0[1]); o.y = cvt_pk_bf16(f[2] * rs * g0[2], f[3] * rs * g0[3]);
          *(u32x2*)(h + C_CKV + lane * 4) = o; }
        if (lane < 32) { const unsigned w = *(const unsigned*)(h + C_KR + 2 * lane); const float x1 = bf_lo(w), x2 = bf_hi(w); const f32x2 cs = tabR[(size_t)(r & (SEQ - 1)) * 32 + lane];
          const unsigned o = cvt_pk_bf16(x1 * cs.x - x2 * cs.y, x1 * cs.y + x2 * cs.x);
#pragma unroll
          for (int hh = 0; hh < 8; ++hh) *(unsigned*)(Km + (size_t)r * 1536 + hh * 192 + 128 + 2 * lane) = o; }
    }
}

__device__ __forceinline__ float log_sigmoid(float z) { const float e = __expf(-fabsf(z)); return fminf(z, 0.f) - __logf(1.f + e); }
__device__ __forceinline__ void gla_prep(const Ctx& c, const bf16_t* H, const float* w2  , const float* gb  , bf16_t* qin, bf16_t* kin, bf16_t* kstT, bf16_t* vT, float* decay) {
    constexpr int TP = 66;
    LAS float* cum = (LAS float*)c.lds;
    LAS bf16_t* vt_l = (LAS bf16_t*)c.lds;
    LAS bf16_t* kst_l = (LAS bf16_t*)(c.lds + 65536);
    LAS float* tot = (LAS float*)(c.lds + 65536 + 256 * TP * 2);
    const int tid = c.tid, half = tid >> 8, dir = (tid >> 7) & 1, dk = tid & 127;
    for (int item = c.vcu; item < BATCH * 64 * 4; item += c.G) {
        const int hh = item & 3, bc = item >> 2;
        const size_t row0 = (size_t)bc * 64;
        const int col = hh * 128 + dk;
        float wv[16];
#pragma unroll
        for (int j = 0; j < 16; ++j) wv[j] = w2[(dir * 16 + j) * 512 + col];
        const float bias = gb[dir * 512 + col];
        float run = 0.f;
#pragma unroll 2
        for (int i = 0; i < 32; ++i) { const int t = half * 32 + (dir ? 31 - i : i); const bf16_t* lp = H + (row0 + t) * HW + C_LAT + dir * 16;
            const u32x4 a = *(const u32x4*)lp, b = *(const u32x4*)(lp + 8);
            float z = bias;
            z += bf_lo(a.x) * wv[0] + bf_hi(a.x) * wv[1] + bf_lo(a.y) * wv[2] + bf_hi(a.y) * wv[3] + bf_lo(a.z) * wv[4] + bf_hi(a.z) * wv[5] + bf_lo(a.w) * wv[6] + bf_hi(a.w) * wv[7];
            z += bf_lo(b.x) * wv[8] + bf_hi(b.x) * wv[9] + bf_lo(b.y) * wv[10] + bf_hi(b.y) * wv[11] + bf_lo(b.z) * wv[12] + bf_hi(b.z) * wv[13] + bf_lo(b.w) * wv[14] + bf_hi(b.w) * wv[15];
            run += log_sigmoid(z) * (1.f / 16.f); cum[(dir * 64 + t) * 128 + dk] = run; }
        tot[(dir * 128 + dk) * 2 + half] = run;
        WG_BAR();
        const float other = tot[(dir * 128 + dk) * 2 + (half ^ 1)];
        const float blast = run + other;
        const float off = (dir == 0) ? (half == 1 ? other : 0.f) : (half == 0 ? other : 0.f);
#pragma unroll 2
        for (int i = 0; i < 32; ++i) { const int t = half * 32 + i; const size_t r = row0 + t;
            const float bcum = cum[(dir * 64 + t) * 128 + dk] + off;
            const float q = bf2f(H[r * HW + C_GQ + col]) * 0.08838834764831845f, k = bf2f(H[r * HW + C_GK + col]);
            qin[((size_t)dir * M + r) * 512 + col] = f2bf(q * __expf(bcum));
            kin[((size_t)dir * M + r) * 512 + col] = f2bf(k * __expf(-bcum));
            kst_l[(dir * 128 + dk) * TP + t] = f2bf(k * __expf(blast - bcum)); }
        if (half == 0) decay[(((size_t)dir * 256 + bc) * 4 + hh) * 128 + dk] = __expf(blast);
        WG_BAR();
#pragma unroll
        for (int q4 = 0; q4 < 4; ++q4) { const int ci = tid + 512 * q4, rowid = ci >> 3, ch = ci & 7; const LAS unsigned* sp = (const LAS unsigned*)(kst_l + rowid * TP + ch * 8);
            const u32x4 w = {sp[0], sp[1], sp[2], sp[3]};
            *(u32x4*)(kstT + (((((size_t)(rowid >> 7) * 256 + bc) * 4 + hh) * 128 + (rowid & 127)) * 64 + ch * 8)) = w; }
        { const int dv = tid & 255;
#pragma unroll 4
          for (int i = 0; i < 32; ++i) { const int t = half * 32 + i; vt_l[dv * TP + t] = H[(row0 + t) * HW + C_GV + hh * 256 + dv]; } }
        WG_BAR();
#pragma unroll
        for (int q4 = 0; q4 < 4; ++q4) { const int ci = tid + 512 * q4, rowid = ci >> 3, ch = ci & 7; const LAS unsigned* sp = (const LAS unsigned*)(vt_l + rowid * TP + ch * 8);
            const u32x4 w = {sp[0], sp[1], sp[2], sp[3]};
            *(u32x4*)(vT + ((((size_t)bc * 4 + hh) * 256 + rowid) * 64 + ch * 8)) = w; }
        WG_BAR();
    }
}

__device__ __forceinline__ void gla_out_rows(const Ctx& c, const float* of, const float* ob, const bf16_t* H, const float* gn, bf16_t* Ocat) {
    const int gw = c.vcu * NWAVES + c.wave, NGW = c.G * NWAVES, lane = c.lane;
    for (int r = gw; r < M; r += NGW) {
#pragma unroll
        for (int hh = 0; hh < 4; ++hh) { const int j0 = hh * 256 + lane * 4;
            const f32x4 a = *(const f32x4*)(of + (size_t)r * 1024 + j0), b = *(const f32x4*)(ob + (size_t)r * 1024 + j0); const f32x4 s = a + b;
            const float ss = s[0] * s[0] + s[1] * s[1] + s[2] * s[2] + s[3] * s[3];
            const float rs = rsqrtf(wave_sum(ss) * (1.f / 256.f) + RMS_EPS);
            const f32x4 g = *(const f32x4*)(gn + j0); const u32x2 gw2 = *(const u32x2*)(H + (size_t)r * HW + C_GR + j0);
            const float gr[4] = {bf_lo(gw2.x), bf_hi(gw2.x), bf_lo(gw2.y), bf_hi(gw2.y)}; float o[4];
#pragma unroll
            for (int i = 0; i < 4; ++i) { const float sg = gr[i] * __builtin_amdgcn_rcpf(1.f + __expf(-gr[i])); o[i] = s[i] * rs * g[i] * sg; }
            u32x2 w; w.x = cvt_pk_bf16(o[0], o[1]); w.y = cvt_pk_bf16(o[2], o[3]);
            *(u32x2*)(Ocat + (size_t)r * 2048 + 1024 + j0) = w; }
    }
}

__device__ __forceinline__ void gqa_qknorm_rows(const Ctx& c, bf16_t* H, const float* qn, const float* kn, const f32x2* tabG) {
    const int gw = c.vcu * NWAVES + c.wave, NGW = c.G * NWAVES, lane = c.lane;
    const float q1 = qn[2 * lane], q2 = qn[2 * lane + 1], k1 = kn[2 * lane], k2 = kn[2 * lane + 1];
    for (int r = gw; r < M; r += NGW) {
        bf16_t* h = H + (size_t)r * 3072; const f32x2 cs = tabG[(size_t)(r & (SEQ - 1)) * 64 + lane];
#pragma unroll 4
        for (int hh = 0; hh < 20; ++hh) { unsigned* p = (unsigned*)(h + hh * 128 + 2 * lane); const unsigned w = *p; const float x1 = bf_lo(w), x2 = bf_hi(w);
            const float rs = rsqrtf(wave_sum(x1 * x1 + x2 * x2) * (1.f / 128.f) + RMS_EPS);
            const float y1 = x1 * rs * (hh < 16 ? q1 : k1), y2 = x2 * rs * (hh < 16 ? q2 : k2);
            *p = cvt_pk_bf16(y1 * cs.x - y2 * cs.y, y1 * cs.y + y2 * cs.x); }
    }
}

__device__ __forceinline__ void ln_router_rows(const Ctx& c, float* X1, bf16_t* X1b, const float* g, const float* bb, const float* wr  , float* aff) {
    LAS float* Wl = (LAS float*)c.lds;
    for (int i = c.tid; i < 2048 * 16 / 4; i += NTHR) { const f32x4 w = *(const f32x4*)(wr + (size_t)i * 4); const int k = i >> 2, e0 = (i & 3) * 4;
        Wl[(e0 + 0) * 2048 + k] = w[0]; Wl[(e0 + 1) * 2048 + k] = w[1]; Wl[(e0 + 2) * 2048 + k] = w[2]; Wl[(e0 + 3) * 2048 + k] = w[3]; }
    WG_BAR();
    const int gw = c.vcu * NWAVES + c.wave, NGW = c.G * NWAVES, lane = c.lane;
    for (int r = gw; r < M; r += NGW) {
        float* xr = X1 + (size_t)r * DM; f32x4 v[8]; float s = 0.f;
#pragma unroll
        for (int j = 0; j < 8; ++j) { v[j] = *(const f32x4*)(xr + j * 256 + lane * 4); s += (v[j][0] + v[j][1]) + (v[j][2] + v[j][3]); }
        const float mean = wave_sum(s) * (1.f / DM); float s2 = 0.f;
#pragma unroll
        for (int j = 0; j < 8; ++j) { v[j] = v[j] - mean; s2 += (v[j][0] * v[j][0] + v[j][1] * v[j][1]) + (v[j][2] * v[j][2] + v[j][3] * v[j][3]); }
        const float rstd = rsqrtf(wave_sum(s2) * (1.f / DM) + LN_EPS);
#pragma unroll
        for (int j = 0; j < 8; ++j) { const f32x4 gg = *(const f32x4*)(g + j * 256 + lane * 4), b4 = *(const f32x4*)(bb + j * 256 + lane * 4);
            v[j] = v[j] * rstd * gg + b4; *(f32x4*)(xr + j * 256 + lane * 4) = v[j];
            u32x2 w; w.x = cvt_pk_bf16(v[j][0], v[j][1]); w.y = cvt_pk_bf16(v[j][2], v[j][3]); *(u32x2*)(X1b + (size_t)r * DM + j * 256 + lane * 4) = w; }
        float lg[16];
#pragma unroll
        for (int e = 0; e < 16; ++e) { float a = 0.f;
#pragma unroll
            for (int j = 0; j < 8; ++j) { const f32x4 w = *(const LAS f32x4*)(Wl + e * 2048 + j * 256 + lane * 4); a += (v[j][0] * w[0] + v[j][1] * w[1]) + (v[j][2] * w[2] + v[j][3] * w[3]); }
            lg[e] = wave_sum(a); }
        float mx = lg[0];
#pragma unroll
        for (int e = 1; e < 16; ++e) mx = fmaxf(mx, lg[e]);
        float den = 0.f;
#pragma unroll
        for (int e = 0; e < 16; ++e) { lg[e] = __expf(lg[e] - mx); den += lg[e]; }
        const float inv = 1.f / den; float mine = 0.f;
#pragma unroll
        for (int e = 0; e < 16; ++e) mine = (lane == e) ? lg[e] * inv : mine;
        if (lane < 16) aff[((size_t)(r >> 12) * 16 + lane) * SEQ + (r & (SEQ - 1))] = mine;
    }
    WG_BAR();
}

__device__ __forceinline__ void topk_units(const Ctx& c, const float* aff, int* idx, float* gate, unsigned short* slotmap) {
    LAS unsigned* sm = (LAS unsigned*)c.lds;
    const int tid = c.tid, lane = c.lane, wid = c.wave;
    for (int be = c.vcu; be < BATCH * NEXP; be += c.G) {
        const int b = be >> 4, e = be & 15;
        const float* a = aff + (size_t)be * SEQ + tid * 8;
        const u32x4 k0 = *(const u32x4*)a, k1 = *(const u32x4*)(a + 4);
        const unsigned key[8] = {k0.x, k0.y, k0.z, k0.w, k1.x, k1.y, k1.z, k1.w};
        unsigned prefix = 0u; int par = 0;
        for (int bit = 30; bit >= 0; --bit) {
            const unsigned cand = prefix | (1u << bit); int cnt = 0;
#pragma unroll
            for (int i = 0; i < 8; ++i) cnt += (key[i] >= cand) ? 1 : 0;
            cnt = wave_sum_i(cnt);
            if (lane == 0) sm[par * 8 + wid] = (unsigned)cnt;
            WG_BAR();
            unsigned total = 0u;
#pragma unroll
            for (int w = 0; w < 8; ++w) total += sm[par * 8 + w];
            if (total >= (unsigned)CAP) prefix = cand;
            par ^= 1;
        }
        const unsigned T = prefix;
        int cgt = 0, ceq = 0;
#pragma unroll
        for (int i = 0; i < 8; ++i) { cgt += (key[i] > T) ? 1 : 0; ceq += (key[i] == T) ? 1 : 0; }
        unsigned pk = (unsigned)cgt | ((unsigned)ceq << 16), inc = pk;
#pragma unroll
        for (int o = 1; o < 64; o <<= 1) { const unsigned nb = __shfl_up(inc, o); if (lane >= o) inc += nb; }
        if (lane == 63) sm[32 + wid] = inc;
        WG_BAR();
        unsigned wpre = 0u, gtot = 0u;
#pragma unroll
        for (int w = 0; w < 8; ++w) { const unsigned v = sm[32 + w]; if (w < wid) wpre += v; gtot += v; }
        const unsigned ex = wpre + inc - pk;
        int pre_gt = (int)(ex & 0xffffu), pre_eq = (int)(ex >> 16);
        const int need_eq = CAP - (int)(gtot & 0xffffu);
        const size_t obase = ((size_t)e * BATCH + b) * CAP;
#pragma unroll
        for (int i = 0; i < 8; ++i) { const int t = tid * 8 + i; const bool gt = key[i] > T, eq = key[i] == T; const bool sel = gt || (eq && pre_eq < need_eq);
            const int slot = pre_gt + (pre_eq < need_eq ? pre_eq : need_eq);
            if (sel) { idx[obase + slot] = b * SEQ + t; gate[obase + slot] = __uint_as_float(key[i]); }
            slotmap[((size_t)b * SEQ + t) * 16 + e] = sel ? (unsigned short)slot : (unsigned short)0xFFFF;
            pre_gt += gt ? 1 : 0; pre_eq += eq ? 1 : 0; }
        WG_BAR();
    }
}

__device__ __forceinline__ void combine_ln_rows(const Ctx& c, const float* X1, const bf16_t* Y, const unsigned short* slotmap, const float* g, const float* bb, float* X2, bf16_t* Xb) {
    const int gw = c.vcu * NWAVES + c.wave, NGW = c.G * NWAVES, lane = c.lane;
    for (int r = gw; r < M; r += NGW) {
        const float* xr = X1 + (size_t)r * DM; f32x4 v[8];
#pragma unroll
        for (int j = 0; j < 8; ++j) v[j] = *(const f32x4*)(xr + j * 256 + lane * 4) * DN_ALPHA;
        const u32x4 s0 = *(const u32x4*)(slotmap + (size_t)r * 16), s1 = *(const u32x4*)(slotmap + (size_t)r * 16 + 8);
        const unsigned sw[8] = {s0.x, s0.y, s0.z, s0.w, s1.x, s1.y, s1.z, s1.w};
        const int b = r >> 12;
#pragma unroll
        for (int e = 0; e < 16; ++e) { const unsigned sl = (unsigned)__builtin_amdgcn_readfirstlane((int)((sw[e >> 1] >> ((e & 1) * 16)) & 0xffffu));
            if (sl != 0xffffu) { const bf16_t* yr = Y + (((size_t)e * BATCH + b) * CAP + sl) * DM;
#pragma unroll
                for (int j = 0; j < 8; ++j) { const u32x2 w = *(const u32x2*)(yr + j * 256 + lane * 4); v[j][0] += bf_lo(w.x); v[j][1] += bf_hi(w.x); v[j][2] += bf_lo(w.y); v[j][3] += bf_hi(w.y); } } }
        float s = 0.f;
#pragma unroll
        for (int j = 0; j < 8; ++j) s += (v[j][0] + v[j][1]) + (v[j][2] + v[j][3]);
        const float mean = wave_sum(s) * (1.f / DM); float s2 = 0.f;
#pragma unroll
        for (int j = 0; j < 8; ++j) { v[j] = v[j] - mean; s2 += (v[j][0] * v[j][0] + v[j][1] * v[j][1]) + (v[j][2] * v[j][2] + v[j][3] * v[j][3]); }
        const float rstd = rsqrtf(wave_sum(s2) * (1.f / DM) + LN_EPS);
#pragma unroll
        for (int j = 0; j < 8; ++j) { const f32x4 gg = *(const f32x4*)(g + j * 256 + lane * 4), b4 = *(const f32x4*)(bb + j * 256 + lane * 4);
            v[j] = v[j] * rstd * gg + b4; *(f32x4*)(X2 + (size_t)r * DM + j * 256 + lane * 4) = v[j];
            u32x2 w; w.x = cvt_pk_bf16(v[j][0], v[j][1]); w.y = cvt_pk_bf16(v[j][2], v[j][3]); *(u32x2*)(Xb + (size_t)r * DM + j * 256 + lane * 4) = w; }
    }
}
namespace gla {
constexpr int SP = 272, AP = 144;
constexpr int S_OFF = 0, A_OFF = 32 * SP, LDS_USED = A_OFF + 64 * AP;
__device__ __forceinline__ unsigned long long pack4(const f32x4 v) { return (unsigned long long)cvt_pk_bf16(v[0], v[1]) | ((unsigned long long)cvt_pk_bf16(v[2], v[3]) << 32); }

__device__ __forceinline__ void unit(const Ctx& c, int u, const bf16_t* qin, const bf16_t* kin, const bf16_t* kstT, const bf16_t* vT, const float* decay, float* of, float* ob) {
    const int vs = u & 7, dir = (u >> 3) & 1, hh = (u >> 4) & 3, b = u >> 6;
    int tid_ = c.tid; asm volatile("" : "+v"(tid_));
    const int w = __builtin_amdgcn_readfirstlane(tid_ >> 6), lane = tid_ & 63, fr = lane & 15, fq = lane >> 4, ib = w >> 1, par = w & 1;
    LAS unsigned char* Sl = c.lds + S_OFF; LAS unsigned char* Al = c.lds + A_OFF;
    const bf16_t* qd = qin + (size_t)dir * M * 512; const bf16_t* kd = kin + (size_t)dir * M * 512;
    float* outp = dir ? ob : of;
    for (int i = tid_; i < 32 * SP / 4; i += NTHR) ((LAS unsigned*)Sl)[i] = 0u;
    f32x4 accS0 = {0.f, 0.f, 0.f, 0.f}, accS1 = {0.f, 0.f, 0.f, 0.f};
#define GLA_LOAD(AQ, BK, VT, KS, DEC, ch) do { const int bc_ = b * 64 + (ch); const size_t rb_ = (size_t)bc_ * 64; \
    const bf16_t* qp_ = qd + (rb_ + ib * 16 + fr) * 512 + hh * 128 + 8 * fq; \
    AQ##0 = *(const bf16x8*)(qp_); AQ##1 = *(const bf16x8*)(qp_ + 32); AQ##2 = *(const bf16x8*)(qp_ + 64); AQ##3 = *(const bf16x8*)(qp_ + 96); \
    const bf16_t* kp0_ = kd + (rb_ + (2 * par) * 16 + fr) * 512 + hh * 128 + 8 * fq; const bf16_t* kp1_ = kp0_ + 16 * 512; \
    BK##00 = *(const bf16x8*)(kp0_); BK##01 = *(const bf16x8*)(kp0_ + 32); BK##02 = *(const bf16x8*)(kp0_ + 64); BK##03 = *(const bf16x8*)(kp0_ + 96); \
    BK##10 = *(const bf16x8*)(kp1_); BK##11 = *(const bf16x8*)(kp1_ + 32); BK##12 = *(const bf16x8*)(kp1_ + 64); BK##13 = *(const bf16x8*)(kp1_ + 96); \
    const bf16_t* vp_ = vT + (((size_t)bc_ * 4 + hh) * 256 + vs * 32 + fr) * 64 + 8 * fq; \
    VT##00 = *(const bf16x8*)(vp_); VT##01 = *(const bf16x8*)(vp_ + 32); VT##10 = *(const bf16x8*)(vp_ + 16 * 64); VT##11 = *(const bf16x8*)(vp_ + 16 * 64 + 32); \
    const bf16_t* sp_ = kstT + ((((size_t)dir * 256 + bc_) * 4 + hh) * 128 + w * 16 + fr) * 64 + 8 * fq; \
    KS##0 = *(const bf16x8*)(sp_); KS##1 = *(const bf16x8*)(sp_ + 32); \
    DEC = *(const f32x4*)(decay + (((size_t)dir * 256 + bc_) * 4 + hh) * 128 + w * 16 + 4 * fq); } while (0)
    bf16x8 caq0, caq1, caq2, caq3, cbk00, cbk01, cbk02, cbk03, cbk10, cbk11, cbk12, cbk13, cvt00, cvt01, cvt10, cvt11, cks0, cks1; f32x4 cdec;
    bf16x8 naq0, naq1, naq2, naq3, nbk00, nbk01, nbk02, nbk03, nbk10, nbk11, nbk12, nbk13, nvt00, nvt01, nvt10, nvt11, nks0, nks1; f32x4 ndec;
    GLA_LOAD(caq, cbk, cvt, cks, cdec, dir ? 63 : 0);
    WG_BAR();
    for (int n = 0; n < 64; ++n) {
        const int ch = dir ? 63 - n : n;
        { const int nn = (n + 1 < 64) ? n + 1 : n; GLA_LOAD(naq, nbk, nvt, nks, ndec, dir ? 63 - nn : nn); }
        { f32x4 a = {0.f, 0.f, 0.f, 0.f};
          a = __builtin_amdgcn_mfma_f32_16x16x32_bf16(cbk00, caq0, a, 0, 0, 0); a = __builtin_amdgcn_mfma_f32_16x16x32_bf16(cbk01, caq1, a, 0, 0, 0);
          a = __builtin_amdgcn_mfma_f32_16x16x32_bf16(cbk02, caq2, a, 0, 0, 0); a = __builtin_amdgcn_mfma_f32_16x16x32_bf16(cbk03, caq3, a, 0, 0, 0);
          f32x4 a2 = {0.f, 0.f, 0.f, 0.f};
          a2 = __builtin_amdgcn_mfma_f32_16x16x32_bf16(cbk10, caq0, a2, 0, 0, 0); a2 = __builtin_amdgcn_mfma_f32_16x16x32_bf16(cbk11, caq1, a2, 0, 0, 0);
          a2 = __builtin_amdgcn_mfma_f32_16x16x32_bf16(cbk12, caq2, a2, 0, 0, 0); a2 = __builtin_amdgcn_mfma_f32_16x16x32_bf16(cbk13, caq3, a2, 0, 0, 0);
          const int i = ib * 16 + fr, j0 = (2 * par) * 16 + 4 * fq;
#pragma unroll
          for (int r = 0; r < 4; ++r) { const int j = j0 + r; const bool keep = dir ? (j >= i) : (j <= i); a[r] = keep ? a[r] : 0.f; const bool keep2 = dir ? (j + 16 >= i) : (j + 16 <= i); a2[r] = keep2 ? a2[r] : 0.f; }
          *(LAS unsigned long long*)(Al + i * AP + j0 * 2) = pack4(a); *(LAS unsigned long long*)(Al + i * AP + (j0 + 16) * 2) = pack4(a2); }
        f32x4 o = {0.f, 0.f, 0.f, 0.f};
        { const LAS unsigned char* sp = Sl + (par * 16 + fr) * SP + (8 * fq) * 2;
          o = __builtin_amdgcn_mfma_f32_16x16x32_bf16(*(const LAS bf16x8*)(sp), caq0, o, 0, 0, 0); o = __builtin_amdgcn_mfma_f32_16x16x32_bf16(*(const LAS bf16x8*)(sp + 64), caq1, o, 0, 0, 0);
          o = __builtin_amdgcn_mfma_f32_16x16x32_bf16(*(const LAS bf16x8*)(sp + 128), caq2, o, 0, 0, 0); o = __builtin_amdgcn_mfma_f32_16x16x32_bf16(*(const LAS bf16x8*)(sp + 192), caq3, o, 0, 0, 0); }
        WG_BAR();
        { const LAS unsigned char* ap = Al + (ib * 16 + fr) * AP + (8 * fq) * 2; const bf16x8 af0 = *(const LAS bf16x8*)(ap), af1 = *(const LAS bf16x8*)(ap + 64);
          o = __builtin_amdgcn_mfma_f32_16x16x32_bf16(par ? cvt10 : cvt00, af0, o, 0, 0, 0); o = __builtin_amdgcn_mfma_f32_16x16x32_bf16(par ? cvt11 : cvt01, af1, o, 0, 0, 0); }
        *(f32x4*)(outp + ((size_t)(b * 64 + ch) * 64 + ib * 16 + fr) * 1024 + hh * 256 + vs * 32 + par * 16 + 4 * fq) = o;
        accS0 = accS0 * cdec; accS1 = accS1 * cdec;
        accS0 = __builtin_amdgcn_mfma_f32_16x16x32_bf16(cks0, cvt00, accS0, 0, 0, 0); accS0 = __builtin_amdgcn_mfma_f32_16x16x32_bf16(cks1, cvt01, accS0, 0, 0, 0);
        accS1 = __builtin_amdgcn_mfma_f32_16x16x32_bf16(cks0, cvt10, accS1, 0, 0, 0); accS1 = __builtin_amdgcn_mfma_f32_16x16x32_bf16(cks1, cvt11, accS1, 0, 0, 0);
        *(LAS unsigned long long*)(Sl + (fr) * SP + (w * 16 + 4 * fq) * 2) = pack4(accS0);
        *(LAS unsigned long long*)(Sl + (16 + fr) * SP + (w * 16 + 4 * fq) * 2) = pack4(accS1);
        WG_BAR();
        caq0 = naq0; caq1 = naq1; caq2 = naq2; caq3 = naq3; cbk00 = nbk00; cbk01 = nbk01; cbk02 = nbk02; cbk03 = nbk03; cbk10 = nbk10; cbk11 = nbk11; cbk12 = nbk12; cbk13 = nbk13;
        cvt00 = nvt00; cvt01 = nvt01; cvt10 = nvt10; cvt11 = nvt11; cks0 = nks0; cks1 = nks1; cdec = ndec;
    }
#undef GLA_LOAD
}
}
#ifndef MK_SPLIT
#define MK_SPLIT 0
#endif
constexpr int NPH_LAYER = 11, NPHASE = 1 + DEPTH * NPH_LAYER;
struct Args { const float* in[22]; float* out; unsigned char* ws; int ph_lo, ph_hi, li, pad; };

__global__ void __launch_bounds__(NTHR, 2) hybrid_fwd(Args args) {
    extern __shared__ __attribute__((aligned(16))) unsigned char lds_raw[];
    Ctx c; c.lds = (LAS unsigned char*)lds_raw; c.tid = threadIdx.x; c.lane = c.tid & 63; c.wave = __builtin_amdgcn_readfirstlane(c.tid >> 6);
    c.G = gridDim.x; { const int bx = blockIdx.x; c.vcu = (c.G % 8 == 0) ? (bx % 8) * (c.G / 8) + bx / 8 : bx; }
    unsigned char* ws = args.ws;
    gu32* ctl = (gu32*)(ws + WS_CTL);
    volatile LAS unsigned* MISC = (volatile LAS unsigned*)(c.lds + MISC_OFF);
    for (int u = c.tid; u < (LDS_BYTES - RING_BYTES) / 4; u += NTHR) ((LAS unsigned*)(c.lds + RING_BYTES))[u] = 0u;
    __syncthreads();
    const int lo = args.ph_lo, hi = args.ph_hi;
    XcdBarrier bar; bar.bar = (unsigned*)(ctl + CW_BAR); bar.x = 0; bar.st = nullptr;
    if (hi - lo > 1) bar = xcd_barrier_post((unsigned*)(ctl + CW_BAR), MISC + 8);
#ifndef PHASE_MASK
#define PHASE_MASK 0xFFF
#endif
#define PHM(j) (((PHASE_MASK) >> (j)) & 1)
#define IN(k) (lo <= (k) && (k) < hi)
#define SEAM(k) do { if (hi > (k) + 1) xcd_barrier(bar); } while (0)

    f32x2* tabR = (f32x2*)(ws + WS_ROPER); f32x2* tabG = (f32x2*)(ws + WS_ROPEG);
    float* aff = (float*)(ws + WS_AFF); int* idx = (int*)(ws + WS_IDX); float* gate = (float*)(ws + WS_GATE); unsigned short* slotmap = (unsigned short*)(ws + WS_SLOT); float* decay = (float*)(ws + WS_DECAY);
    bf16_t* Win_t = (bf16_t*)(ws + WS_WIN); bf16_t* Wuq_t = (bf16_t*)(ws + WS_WUQ); bf16_t* Wukv_t = (bf16_t*)(ws + WS_WUKV); bf16_t* Wmo_t = (bf16_t*)(ws + WS_WMO);
    bf16_t* Wqkv_t = (bf16_t*)(ws + WS_WQKV); bf16_t* Wgo_t = (bf16_t*)(ws + WS_WGO); bf16_t* W13_t = (bf16_t*)(ws + WS_W13); bf16_t* W2_t = (bf16_t*)(ws + WS_W2);
    bf16_t* Xb = (bf16_t*)(ws + WS_XB); float* X1 = (float*)(ws + WS_X1); bf16_t* X1b = (bf16_t*)(ws + WS_X1B); bf16_t* H = (bf16_t*)(ws + WS_H);
    bf16_t* Qm = (bf16_t*)(ws + WS_QM); bf16_t* Km = (bf16_t*)(ws + WS_KM); bf16_t* Vm = (bf16_t*)(ws + WS_VM); bf16_t* Ocat = (bf16_t*)(ws + WS_OCAT);
    bf16_t* qin = (bf16_t*)(ws + WS_QIN); bf16_t* kin = (bf16_t*)(ws + WS_KIN); bf16_t* kstT = (bf16_t*)(ws + WS_KST); bf16_t* vT = (bf16_t*)(ws + WS_VT);
    float* of = (float*)(ws + WS_OF); float* ob = (float*)(ws + WS_OB); bf16_t* hdn = (bf16_t*)(ws + WS_HDN); bf16_t* Yb = (bf16_t*)(ws + WS_Y);
    float* X2 = args.out;

    if (PHM(11) && IN(0)) {
        fill_rope(c, tabR, tabG);
        cvt_rows_bf16(c, args.in[0], Xb);
        transpose_batch(c, args.in[15], W13_t, DM, FF, DEPTH * NEXP, (size_t)DM * FF, (size_t)2 * FF * DM, 2);
        transpose_batch(c, args.in[16], W13_t, DM, FF, DEPTH * NEXP, (size_t)DM * FF, (size_t)2 * FF * DM, 3);
        transpose_batch(c, args.in[17], W2_t, FF, DM, DEPTH * NEXP, (size_t)FF * DM, (size_t)DM * FF, 0);
        transpose_batch(c, args.in[1], Win_t, DM, 3936, 2, (size_t)DM * 3936, (size_t)4096 * DM, 1);
        transpose_batch(c, args.in[10], Wqkv_t, DM, 3072, 2, (size_t)DM * 3072, (size_t)3072 * DM, 0);
        transpose_batch(c, args.in[9], Wmo_t, DM, DM, 2, (size_t)DM * DM, (size_t)DM * DM, 0);
        transpose_batch(c, args.in[13], Wgo_t, DM, DM, 2, (size_t)DM * DM, (size_t)DM * DM, 0);
        transpose_batch(c, args.in[3], Wuq_t, 512, 1536, 2, (size_t)512 * 1536, (size_t)1536 * 512, 0);
        transpose_batch(c, args.in[5], Wukv_t, 256, 2048, 2, (size_t)256 * 2048, (size_t)2048 * 256, 0);
        { const long gt = (long)c.vcu * NTHR + c.tid, NT = (long)c.G * NTHR;
          for (long i = gt; i < 2L * 160 * DM / 8; i += NT) { const long l2 = i / (160 * DM / 8), rr = i % (160 * DM / 8); *(u32x4*)(Win_t + (size_t)l2 * 4096 * DM + (size_t)3936 * DM + rr * 8) = (u32x4){0u, 0u, 0u, 0u}; } }
        SEAM(0);
    }

    const Ctx c0 = c;
    for (int layer = 0; layer < DEPTH; ++layer) {
        const int pb = 1 + layer * NPH_LAYER, i2 = layer >> 1; const bool even = (layer & 1) == 0;
        const float* Xres = (layer == 0) ? args.in[0] : (const float*)X2;
        if (PHM(0) && IN(pb + 0)) { const Ctx c = opaque_ctx(c0);
            const int N = even ? 4096 : 3072;
            pg8::Gemm g{Xb, even ? Win_t + (size_t)i2 * 4096 * DM : Wqkv_t + (size_t)i2 * 3072 * DM, DM, DM, DM, 0, 0, nullptr};
            pg8::StaticOrder S; S.init(M, N, c.G, (int)blockIdx.x);
            pg8::EpiStoreBf16 E{H, N};
            pg8::gemm_phase<pg8::EpiStoreBf16, false>(c.lds, g, S, E);
            SEAM(pb + 0);
        }
        if (PHM(1) && IN(pb + 1)) { const Ctx c = opaque_ctx(c0);
            if (even) { mla_prep_rows(c, H, Km, args.in[2] + i2 * 512, args.in[4] + i2 * 256, tabR);
                        gla_prep(c, H, args.in[6] + (size_t)i2 * 2 * 16 * 512, args.in[7] + i2 * 2 * 512, qin, kin, kstT, vT, decay); }
            else gqa_qknorm_rows(c, H, args.in[11] + i2 * 128, args.in[12] + i2 * 128, tabG);
            SEAM(pb + 1);
        }
        if (PHM(2) && IN(pb + 2) && even) { const Ctx c = opaque_ctx(c0);
#ifndef SUBM
#define SUBM 0x1F
#endif
            if (SUBM & 1) { pg8::Gemm g{H + C_CQ, Wuq_t + (size_t)i2 * 1536 * 512, HW, 512, 512, 0, 0, nullptr}; pg8::StaticOrder S; S.init(M, 1536, c.G, (int)blockIdx.x);
              pg8::EpiQRope E{Qm, tabR}; pg8::gemm_phase<pg8::EpiQRope, false>(c.lds, g, S, E); }
            if (SUBM & 2) { pg8::Gemm g{H + C_CKV, Wukv_t + (size_t)i2 * 2048 * 256, HW, 256, 256, 0, 0, nullptr}; pg8::StaticOrder S; S.init(M, 2048, c.G, (int)blockIdx.x);
              pg8::EpiKV E{Km, Vm}; pg8::gemm_phase<pg8::EpiKV, false>(c.lds, g, S, E); }
            SEAM(pb + 2);
        }
        if (PHM(3) && IN(pb + 3)) { const Ctx c = opaque_ctx(c0);
            if (even) {
                if (SUBM & 4) for (int u = c.vcu; u < 256; u += c.G) gla::unit(c, u, qin, kin, kstT, vT, decay, of, ob);
                if (SUBM & 8) for (int uid = c.vcu; uid < 512; uid += c.G) { const int b = uid >> 7, h = (uid >> 4) & 7, qb = uid & 15; const size_t r0 = (size_t)b * SEQ;
                    attn::attn_unit<192, 1536, 1536, 1024, 2048>(Qm + (r0 + qb * 256) * 1536 + h * 192, Km + r0 * 1536 + h * 192, Vm + r0 * 1024 + h * 128, Ocat + (r0 + qb * 256) * 2048 + h * 128, SEQ, (char*)lds_raw); }
            } else {
                if (SUBM & 16) for (int uid = c.vcu; uid < 1024; uid += c.G) { const int b = uid >> 8, kvh = (uid >> 6) & 3, gq = (uid >> 4) & 3, qb = uid & 15, h = kvh * 4 + gq; const size_t r0 = (size_t)b * SEQ;
                    attn::attn_unit<128, 3072, 3072, 3072, 2048>(H + (r0 + qb * 256) * 3072 + h * 128, H + r0 * 3072 + 2048 + kvh * 128, H + r0 * 3072 + 2560 + kvh * 128, Ocat + (r0 + qb * 256) * 2048 + h * 128, SEQ, (char*)lds_raw); }
            }
            SEAM(pb + 3);
        }
        if (PHM(4) && IN(pb + 4) && even) { const Ctx c = opaque_ctx(c0); gla_out_rows(c, of, ob, H, args.in[8] + i2 * 1024, Ocat); SEAM(pb + 4); }
        if (PHM(5) && IN(pb + 5)) { const Ctx c = opaque_ctx(c0);
            pg8::Gemm g{Ocat, even ? Wmo_t + (size_t)i2 * DM * DM : Wgo_t + (size_t)i2 * DM * DM, DM, DM, DM, 0, 0, nullptr};
            pg8::StaticOrder S; S.init(M, DM, c.G, (int)blockIdx.x);
            pg8::EpiResid E{Xres, X1, DN_ALPHA};
            pg8::gemm_phase<pg8::EpiResid, false>(c.lds, g, S, E);
            SEAM(pb + 5);
        }
        if (PHM(6) && IN(pb + 6)) { const Ctx c = opaque_ctx(c0); ln_router_rows(c, X1, X1b, args.in[18] + layer * DM, args.in[19] + layer * DM, args.in[14] + (size_t)layer * DM * NEXP, aff); SEAM(pb + 6); }
        if (PHM(7) && IN(pb + 7)) { const Ctx c = opaque_ctx(c0); topk_units(c, aff, idx, gate, slotmap); SEAM(pb + 7); }
        if (PHM(8) && IN(pb + 8)) { const Ctx c = opaque_ctx(c0);
            pg8::Gemm g{X1b, W13_t + (size_t)layer * NEXP * 2 * FF * DM, DM, DM, DM, 3, (size_t)2 * FF * DM, idx};
            pg8::StaticOrder S; S.init(MX, 2 * FF, c.G, (int)blockIdx.x);
            pg8::EpiSwiglu E{hdn};
            pg8::gemm_phase<pg8::EpiSwiglu, true>(c.lds, g, S, E);
            SEAM(pb + 8);
        }
        if (PHM(9) && IN(pb + 9)) { const Ctx c = opaque_ctx(c0);
            pg8::Gemm g{hdn, W2_t + (size_t)layer * NEXP * DM * FF, FF, FF, FF, 3, (size_t)DM * FF, nullptr};
            pg8::StaticOrder S; S.init(MX, DM, c.G, (int)blockIdx.x);
            pg8::EpiGate E{Yb, gate};
            pg8::gemm_phase<pg8::EpiGate, false>(c.lds, g, S, E);
            SEAM(pb + 9);
        }
        if (PHM(10) && IN(pb + 10)) { const Ctx c = opaque_ctx(c0); combine_ln_rows(c, X1, Yb, slotmap, args.in[20] + layer * DM, args.in[21] + layer * DM, X2, Xb); SEAM(pb + 10); }
    }
#undef IN
#undef SEAM
}

extern "C" void kernel_launch(void* const* d_in, const int* in_sizes, int n_in, void* d_out, int out_size, void* d_ws, size_t ws_size, hipStream_t stream) {
    static int grid = 0;
    if (grid == 0) {
        if (n_in != 22 || in_sizes[0] != M * DM || out_size != M * DM || ws_size < WS_END) { fprintf(stderr, "kernel_launch: unexpected shapes (n_in %d, in0 %d, out %d, ws %zu < %zu); nothing launched\n", n_in, n_in > 0 ? in_sizes[0] : -1, out_size, ws_size, (size_t)WS_END); grid = -1; return; }
        int dev = 0, cus = 0, per_cu = 0;
        if (hipGetDevice(&dev) != hipSuccess || hipDeviceGetAttribute(&cus, hipDeviceAttributeMultiprocessorCount, dev) != hipSuccess) { grid = -1; return; }
        if (hipFuncSetAttribute((const void*)hybrid_fwd, hipFuncAttributeMaxDynamicSharedMemorySize, LDS_BYTES) != hipSuccess) { fprintf(stderr, "kernel_launch: hipFuncSetAttribute failed\n"); grid = -1; return; }
        if (hipOccupancyMaxActiveBlocksPerMultiprocessor(&per_cu, (const void*)hybrid_fwd, NTHR, LDS_BYTES) != hipSuccess || per_cu < 1) fprintf(stderr, "kernel_launch: occupancy query reports %d\n", per_cu);
        (void)hipGetLastError();
        grid = cus;
    }
    if (grid < 0) return;
    if (hipMemsetAsync((char*)d_ws + WS_CTL, 0, CTL_ZERO_BYTES, stream) != hipSuccess) return;
    Args a{};
    for (int i = 0; i < 22; ++i) a.in[i] = (const float*)d_in[i];
    a.out = (float*)d_out; a.ws = (unsigned char*)d_ws; a.pad = 0;
#if MK_SPLIT
    for (int p = 0; p < NPHASE; ++p) {
        if (p > 0) { const int layer = (p - 1) / NPH_LAYER, k = (p - 1) % NPH_LAYER; if ((layer & 1) && (k == 2 || k == 4)) continue; }
        a.ph_lo = p; a.ph_hi = p + 1; a.li = 0;
        hipLaunchKernelGGL(hybrid_fwd, dim3(grid), dim3(NTHR), LDS_BYTES, stream, a);
    }
#else
    a.ph_lo = 0; a.ph_hi = NPHASE; a.li = 0;
    hipLaunchKernelGGL(hybrid_fwd, dim3(grid), dim3(NTHR), LDS_BYTES, stream, a);
#endif
    const hipError_t le = hipPeekAtLastError();
    if (le != hipSuccess) fprintf(stderr, "kernel_launch: launch failed: %s\n", hipGetErrorName(le));
}
```

```cpp
#include <hip/hip_runtime.h>
#include <hip/hip_bf16.h>
#include <cstdio>
#include <cstdint>
#include <cmath>

#define GAS __attribute__((address_space(1)))
#define LAS __attribute__((address_space(3)))
typedef unsigned short bf16_t;
typedef short bf16x8 __attribute__((ext_vector_type(8)));
typedef short s16x4 __attribute__((ext_vector_type(4)));
typedef float f32x4 __attribute__((ext_vector_type(4)));
typedef float f32x2 __attribute__((ext_vector_type(2)));
typedef float f32x16 __attribute__((ext_vector_type(16)));
typedef unsigned u32x4 __attribute__((ext_vector_type(4)));
typedef unsigned u32x2 __attribute__((ext_vector_type(2)));
typedef GAS unsigned gu32;

__device__ __forceinline__ unsigned cvt_pk_bf16(float lo, float hi) { unsigned r; asm volatile("v_cvt_pk_bf16_f32 %0, %1, %2" : "=v"(r) : "v"(lo), "v"(hi)); return r; }
__device__ __forceinline__ float bf_lo(unsigned w) { return __uint_as_float(w << 16); }
__device__ __forceinline__ float bf_hi(unsigned w) { return __uint_as_float(w & 0xffff0000u); }
__device__ __forceinline__ float bf2f(bf16_t h) { return __uint_as_float(((unsigned)h) << 16); }
__device__ __forceinline__ bf16_t f2bf(float f) { return (bf16_t)(cvt_pk_bf16(f, 0.f) & 0xffffu); }

namespace pg8 {
constexpr int BM = 256, BK = 64, HALF = 128, HTB = HALF * BK * 2, STAGE_BYTES = 8 * HTB, NXCD = 8, WGM = 8;
__host__ __device__ __forceinline__ int lds_byte(int r, int c) { const int st = (r >> 4) * 2 + (c >> 5), rr = r & 15, cc = c & 31, ob = rr * 64 + cc * 2; return st * 1024 + (ob ^ (((ob >> 9) & 1) << 5)); }
__host__ __device__ __forceinline__ void stage_rc(int b, int& R, int& C) { const int st = b / 1024, sb = b % 1024, swz = sb ^ (((sb >> 9) & 1) << 5); R = (st >> 1) * 16 + swz / 64; C = (st & 1) * 32 + (swz % 64) / 2; }
__host__ __device__ __forceinline__ int perm32(int rho) { const int n = rho >> 4, i = rho & 15; return 8 * (i >> 2) + 4 * n + (i & 3); }

struct Unit { int pm, pn; };
struct Gemm { const bf16_t* A; const bf16_t* Bt; int lda, ldb, K, bshift; size_t bstride; const int* gather; };

struct StaticOrder {
    int nM, nN, nwg, G, c;
    __device__ void init(int M, int N, int G_, int c_) { nM = M / BM; nN = N / BM; nwg = nM * nN; G = G_; c = c_; }
    __device__ bool next(int i, Unit& u) const {
        const long L = (long)i * G + c; if (L >= nwg) return false;
        int wgid = (int)L; { const int q = nwg / NXCD, r = nwg % NXCD, xcd = wgid % NXCD, off = wgid / NXCD; wgid = (xcd < r ? xcd * (q + 1) : r * (q + 1) + (xcd - r) * q) + off; }
        const int nig = WGM * nN, gid = wgid / nig, fm = gid * WGM, gsz = (nM - fm) < WGM ? (nM - fm) : WGM;
        u.pm = fm + ((wgid % nig) % gsz); u.pn = (wgid % nig) / gsz; return true;
    }
};

template <class Epi, bool GATHER>
__device__ __forceinline__ void gemm_phase(LAS unsigned char* lds, const Gemm g, const StaticOrder& S, const Epi& E) {
    int tid_ = threadIdx.x; asm volatile("" : "+v"(tid_));
    const int tid = tid_, wid = __builtin_amdgcn_readfirstlane(tid >> 6), lane = tid & 63, wr = wid >> 2, wc = wid & 3, fr = lane & 15, fq = lane >> 4;
    const int K = g.K, nt = K / BK;
    unsigned voffA[2], voffB[2]; int RA[2], CA[2];
#pragma unroll
    for (int i = 0; i < 2; ++i) { int R, C; stage_rc(tid * 16 + i * 8192, R, C); const int Rb = Epi::PERM ? ((R & ~31) + perm32(R & 31)) : R;
        RA[i] = R; CA[i] = C; voffA[i] = (unsigned)(R * g.lda + C) * 2u; voffB[i] = (unsigned)(Rb * g.ldb + C) * 2u; }
    const size_t kstep = (size_t)(BK * 2);
    const size_t hstepA = (size_t)HALF * g.lda * 2, hstepB = (size_t)HALF * g.ldb * 2;
    const size_t tstepA = 2 * hstepA, tstepB = 2 * hstepB;
    const unsigned ldsw = (unsigned)wid * 1024u;
    const int aoff = lds_byte(wr * 64 + fr, fq * 8), boff = lds_byte(wc * 32 + fr, fq * 8);
#define PG8_SA(b, h) (((b) * 2 + (h)) * HTB)
#define PG8_SB(b, h) ((4 + (b) * 2 + (h)) * HTB)
#define PG8_STAGE(bufoff, gbase, voff) do { _Pragma("unroll") for (int _i = 0; _i < 2; ++_i) \
        __builtin_amdgcn_global_load_lds((const unsigned*)((const char*)(gbase) + (voff)[_i]), (LAS unsigned*)(lds + (bufoff) + ldsw + _i * 8192), 16, 0, 0); } while (0)
#define PG8_STAGE_A(bufoff, gptr, h, vg) do { if constexpr (GATHER) { PG8_STAGE(bufoff, gptr, vg[h]); } else { PG8_STAGE(bufoff, (gptr) + (h) * hstepA, voffA); } } while (0)
#define PG8_LDA(dst, b, h) do { _Pragma("unroll") for (int m = 0; m < 4; ++m) _Pragma("unroll") for (int k = 0; k < 2; ++k) dst[m][k] = *(const LAS bf16x8*)(lds + PG8_SA(b, h) + aoff + m * 2048 + k * 1024); } while (0)
#define PG8_LDB(dst, b, h) do { _Pragma("unroll") for (int n = 0; n < 2; ++n) _Pragma("unroll") for (int k = 0; k < 2; ++k) dst[n][k] = *(const LAS bf16x8*)(lds + PG8_SB(b, h) + boff + n * 2048 + k * 1024); } while (0)
#define PG8_MMA(ai, bj, At, Bt) do { __builtin_amdgcn_s_setprio(1); _Pragma("unroll") for (int m = 0; m < 4; ++m) _Pragma("unroll") for (int n = 0; n < 2; ++n) _Pragma("unroll") for (int k = 0; k < 2; ++k) \
        acc[ai][bj][m][n] = __builtin_amdgcn_mfma_f32_16x16x32_bf16(Bt[n][k], At[m][k], acc[ai][bj][m][n], 0, 0, 0); __builtin_amdgcn_s_setprio(0); } while (0)
#define PG8_WAIT_V(n) asm volatile("s_waitcnt vmcnt(" #n ")" ::: "memory")
#define PG8_WAIT_L(n) asm volatile("s_waitcnt lgkmcnt(" #n ")" ::: "memory")
#define PG8_BAR __builtin_amdgcn_s_barrier()
#define PG8_SCHED __builtin_amdgcn_sched_barrier(0)
    Unit cur, nxt; int ui = 0;
    if (!S.next(0, cur)) return;
    f32x4 acc[2][2][4][2];
#pragma unroll
    for (int a = 0; a < 2; ++a)
#pragma unroll
        for (int b = 0; b < 2; ++b)
#pragma unroll
            for (int m = 0; m < 4; ++m)
#pragma unroll
                for (int n = 0; n < 2; ++n) acc[a][b][m][n] = (f32x4){0.f, 0.f, 0.f, 0.f};
    bf16x8 At[4][2], B0[2][2], B1[2][2];
    unsigned vgc[2][2], vgn[2][2];
    if constexpr (GATHER) {
#pragma unroll
        for (int h = 0; h < 2; ++h)
#pragma unroll
            for (int i = 0; i < 2; ++i) { const int gr = g.gather[cur.pm * BM + h * HALF + RA[i]]; vgc[h][i] = (unsigned)(gr * g.lda + CA[i]) * 2u; vgn[h][i] = vgc[h][i]; }
    }
    const char* cA = GATHER ? (const char*)g.A : (const char*)g.A + (size_t)cur.pm * tstepA;
    const char* cB = (const char*)g.Bt + (size_t)(cur.pm >> g.bshift) * g.bstride * 2 + (size_t)cur.pn * tstepB;
    PG8_STAGE(PG8_SB(0, 0), cB, voffB); PG8_STAGE(PG8_SB(0, 1), cB + hstepB, voffB); PG8_STAGE_A(PG8_SA(0, 0), cA, 0, vgc); PG8_STAGE_A(PG8_SA(0, 1), cA, 1, vgc);
    if (wr == 1) PG8_BAR;
    PG8_WAIT_V(2); PG8_BAR;
    PG8_STAGE(PG8_SB(1, 0), cB + kstep, voffB); PG8_STAGE_A(PG8_SA(1, 0), cA + kstep, 0, vgc); PG8_STAGE(PG8_SB(1, 1), cB + hstepB + kstep, voffB);
    PG8_WAIT_V(6); PG8_BAR;
    for (;;) {
        const bool has_next = S.next(ui + 1, nxt);
        if constexpr (GATHER) {
            if (has_next) {
#pragma unroll
                for (int h = 0; h < 2; ++h)
#pragma unroll
                    for (int i = 0; i < 2; ++i) { const int gr = g.gather[nxt.pm * BM + h * HALF + RA[i]]; vgn[h][i] = (unsigned)(gr * g.lda + CA[i]) * 2u; }
            }
        }
        const char* nA = has_next ? (GATHER ? (const char*)g.A : (const char*)g.A + (size_t)nxt.pm * tstepA) : cA;
        const char* nB = has_next ? (const char*)g.Bt + (size_t)(nxt.pm >> g.bshift) * g.bstride * 2 + (size_t)nxt.pn * tstepB : cB;
#pragma nounroll
        for (int t = 0; t < nt; t += 2) {
            const bool last = (t == nt - 2);
            const char* a1 = cA + (size_t)(t + 1) * kstep;
            const char* a2 = last ? nA : cA + (size_t)(t + 2) * kstep; const char* b2 = last ? nB : cB + (size_t)(t + 2) * kstep;
            const char* a3 = a2 + kstep; const char* b3 = b2 + kstep;
            unsigned vg2[2][2];
            if constexpr (GATHER) {
#pragma unroll
                for (int h = 0; h < 2; ++h)
#pragma unroll
                    for (int i = 0; i < 2; ++i) vg2[h][i] = (last && has_next) ? vgn[h][i] : vgc[h][i];
            }
            PG8_LDB(B0, 0, 0); PG8_LDB(B1, 0, 1); PG8_SCHED; PG8_LDA(At, 0, 0); PG8_STAGE_A(PG8_SA(1, 1), a1, 1, vgc);
            PG8_WAIT_V(8); PG8_WAIT_L(0); PG8_BAR; PG8_MMA(0, 0, At, B0); PG8_MMA(0, 1, At, B1); PG8_BAR; PG8_SCHED;
            PG8_LDA(At, 0, 1); PG8_STAGE(PG8_SB(0, 0), b2, voffB); PG8_STAGE(PG8_SB(0, 1), b2 + hstepB, voffB); PG8_STAGE_A(PG8_SA(0, 0), a2, 0, vg2);
            PG8_WAIT_V(8); PG8_WAIT_L(0); PG8_BAR; PG8_MMA(1, 0, At, B0); PG8_MMA(1, 1, At, B1); PG8_BAR; PG8_SCHED;
            PG8_LDB(B0, 1, 0); PG8_LDB(B1, 1, 1); PG8_SCHED; PG8_LDA(At, 1, 0); PG8_STAGE_A(PG8_SA(0, 1), a2, 1, vg2);
            PG8_WAIT_V(8); PG8_WAIT_L(0); PG8_BAR; PG8_MMA(0, 0, At, B0); PG8_MMA(0, 1, At, B1); PG8_BAR; PG8_SCHED;
            PG8_LDA(At, 1, 1); PG8_STAGE(PG8_SB(1, 0), b3, voffB); PG8_STAGE(PG8_SB(1, 1), b3 + hstepB, voffB); PG8_STAGE_A(PG8_SA(1, 0), a3, 0, vg2);
            PG8_WAIT_V(8); PG8_WAIT_L(0); PG8_BAR; PG8_MMA(1, 0, At, B0); PG8_MMA(1, 1, At, B1); PG8_BAR; PG8_SCHED;
        }
        if (wr == 0) PG8_BAR;
        E(acc, cur, wr, wc, fr, fq);
        if (!has_next) break;
#pragma unroll
        for (int a = 0; a < 2; ++a)
#pragma unroll
            for (int b = 0; b < 2; ++b)
#pragma unroll
                for (int m = 0; m < 4; ++m)
#pragma unroll
                    for (int n = 0; n < 2; ++n) acc[a][b][m][n] = (f32x4){0.f, 0.f, 0.f, 0.f};
        cur = nxt; cA = nA; cB = nB; ++ui;
        if constexpr (GATHER) {
#pragma unroll
            for (int h = 0; h < 2; ++h)
#pragma unroll
                for (int i = 0; i < 2; ++i) vgc[h][i] = vgn[h][i];
        }
        if (wr == 1) PG8_BAR;
    }
    PG8_WAIT_V(0);
    PG8_BAR;
#undef PG8_SA
#undef PG8_SB
#undef PG8_STAGE
#undef PG8_STAGE_A
#undef PG8_LDA
#undef PG8_LDB
#undef PG8_MMA
#undef PG8_WAIT_V
#undef PG8_WAIT_L
#undef PG8_BAR
#undef PG8_SCHED
}
}
namespace pg8 {
struct EpiStoreBf16 {
    static constexpr bool PERM = true;
    bf16_t* O; int ldc;
    __device__ __forceinline__ void operator()(const f32x4 (&acc)[2][2][4][2], const Unit& u, int wr, int wc, int fr, int fq) const {
        const int row0 = u.pm * BM + wr * 64 + fr, col0 = u.pn * BM + wc * 32 + 8 * fq;
#pragma unroll
        for (int ai = 0; ai < 2; ++ai)
#pragma unroll
            for (int m = 0; m < 4; ++m) { bf16_t* rowp = O + (size_t)(row0 + ai * HALF + m * 16) * ldc + col0;
#pragma unroll
                for (int bj = 0; bj < 2; ++bj) { const f32x4 v0 = acc[ai][bj][m][0], v1 = acc[ai][bj][m][1];
                    u32x4 w; w.x = cvt_pk_bf16(v0[0], v0[1]); w.y = cvt_pk_bf16(v0[2], v0[3]); w.z = cvt_pk_bf16(v1[0], v1[1]); w.w = cvt_pk_bf16(v1[2], v1[3]);
                    *(u32x4*)(rowp + bj * HALF) = w; } }
    }
};
struct EpiQRope {
    static constexpr bool PERM = true;
    bf16_t* O; const f32x2* tab;
    __device__ __forceinline__ void operator()(const f32x4 (&acc)[2][2][4][2], const Unit& u, int wr, int wc, int fr, int fq) const {
        const int row0 = u.pm * BM + wr * 64 + fr, col0 = u.pn * BM + wc * 32 + 8 * fq;
#pragma unroll
        for (int bj = 0; bj < 2; ++bj) {
            const int col = col0 + bj * HALF, within = col % 192;
            const bool pe = within >= 128; const int p0 = (within - 128) >> 1;
#pragma unroll
            for (int ai = 0; ai < 2; ++ai)
#pragma unroll
                for (int m = 0; m < 4; ++m) { const int row = row0 + ai * HALF + m * 16;
                    f32x4 v0 = acc[ai][bj][m][0], v1 = acc[ai][bj][m][1];
                    if (pe) { const f32x2* tp = tab + (size_t)(row & 4095) * 32 + p0; const f32x4 t01 = *(const f32x4*)tp, t23 = *(const f32x4*)(tp + 2);
                        const f32x4 a = v0, b = v1;
                        v0[0] = a[0] * t01[0] - a[1] * t01[1]; v0[1] = a[0] * t01[1] + a[1] * t01[0]; v0[2] = a[2] * t01[2] - a[3] * t01[3]; v0[3] = a[2] * t01[3] + a[3] * t01[2];
                        v1[0] = b[0] * t23[0] - b[1] * t23[1]; v1[1] = b[0] * t23[1] + b[1] * t23[0]; v1[2] = b[2] * t23[2] - b[3] * t23[3]; v1[3] = b[2] * t23[3] + b[3] * t23[2]; }
                    u32x4 w; w.x = cvt_pk_bf16(v0[0], v0[1]); w.y = cvt_pk_bf16(v0[2], v0[3]); w.z = cvt_pk_bf16(v1[0], v1[1]); w.w = cvt_pk_bf16(v1[2], v1[3]);
                    *(u32x4*)(O + (size_t)row * 1536 + col) = w; asm volatile("" ::: "memory"); }
        }
    }
};
struct EpiKV {
    static constexpr bool PERM = true;
    bf16_t* Km; bf16_t* Vm;
    __device__ __forceinline__ void operator()(const f32x4 (&acc)[2][2][4][2], const Unit& u, int wr, int wc, int fr, int fq) const {
        const int row0 = u.pm * BM + wr * 64 + fr, c = wc * 32 + 8 * fq;
#pragma unroll
        for (int ai = 0; ai < 2; ++ai)
#pragma unroll
            for (int m = 0; m < 4; ++m) { const size_t row = (size_t)(row0 + ai * HALF + m * 16);
#pragma unroll
                for (int bj = 0; bj < 2; ++bj) { const f32x4 v0 = acc[ai][bj][m][0], v1 = acc[ai][bj][m][1];
                    u32x4 w; w.x = cvt_pk_bf16(v0[0], v0[1]); w.y = cvt_pk_bf16(v0[2], v0[3]); w.z = cvt_pk_bf16(v1[0], v1[1]); w.w = cvt_pk_bf16(v1[2], v1[3]);
                    if (bj == 0) *(u32x4*)(Km + row * 1536 + u.pn * 192 + c) = w; else *(u32x4*)(Vm + row * 1024 + u.pn * 128 + c) = w; }
                asm volatile("" ::: "memory"); }
    }
};
struct EpiResid {
    static constexpr bool PERM = false;
    const float* X; float* Y; float alpha;
    __device__ __forceinline__ void operator()(const f32x4 (&acc)[2][2][4][2], const Unit& u, int wr, int wc, int fr, int fq) const {
        const int row0 = u.pm * BM + wr * 64 + fr, col0 = u.pn * BM + wc * 32 + 4 * fq;
#pragma unroll
        for (int ai = 0; ai < 2; ++ai)
#pragma unroll
            for (int m = 0; m < 4; ++m) { const size_t off = (size_t)(row0 + ai * HALF + m * 16) * 2048 + col0;
#pragma unroll
                for (int bj = 0; bj < 2; ++bj)
#pragma unroll
                    for (int n = 0; n < 2; ++n) { const f32x4 xv = *(const f32x4*)(X + off + bj * HALF + n * 16); *(f32x4*)(Y + off + bj * HALF + n * 16) = xv * alpha + acc[ai][bj][m][n]; }
                if (m & 1) asm volatile("" ::: "memory"); }
    }
};
struct EpiSwiglu {
    static constexpr bool PERM = true;
    bf16_t* O;
    __device__ __forceinline__ void operator()(const f32x4 (&acc)[2][2][4][2], const Unit& u, int wr, int wc, int fr, int fq) const {
        const int row0 = u.pm * BM + wr * 64 + fr, col0 = u.pn * HALF + wc * 32 + 8 * fq;
#pragma unroll
        for (int ai = 0; ai < 2; ++ai)
#pragma unroll
            for (int m = 0; m < 4; ++m) { float h[8];
#pragma unroll
                for (int n = 0; n < 2; ++n)
#pragma unroll
                    for (int j = 0; j < 4; ++j) { const float a = acc[ai][0][m][n][j], b = acc[ai][1][m][n][j]; h[n * 4 + j] = a * __builtin_amdgcn_rcpf(1.f + __expf(-a)) * b; }
                u32x4 w; w.x = cvt_pk_bf16(h[0], h[1]); w.y = cvt_pk_bf16(h[2], h[3]); w.z = cvt_pk_bf16(h[4], h[5]); w.w = cvt_pk_bf16(h[6], h[7]);
                *(u32x4*)(O + (size_t)(row0 + ai * HALF + m * 16) * 1536 + col0) = w; }
    }
};
struct EpiGate {
    static constexpr bool PERM = true;
    bf16_t* O; const float* gate;
    __device__ __forceinline__ void operator()(const f32x4 (&acc)[2][2][4][2], const Unit& u, int wr, int wc, int fr, int fq) const {
        const int row0 = u.pm * BM + wr * 64 + fr, col0 = u.pn * BM + wc * 32 + 8 * fq;
#pragma unroll
        for (int ai = 0; ai < 2; ++ai)
#pragma unroll
            for (int m = 0; m < 4; ++m) { const int row = row0 + ai * HALF + m * 16; const float gt = gate[row]; bf16_t* rowp = O + (size_t)row * 2048 + col0;
#pragma unroll
                for (int bj = 0; bj < 2; ++bj) { const f32x4 v0 = acc[ai][bj][m][0] * gt, v1 = acc[ai][bj][m][1] * gt;
                    u32x4 w; w.x = cvt_pk_bf16(v0[0], v0[1]); w.y = cvt_pk_bf16(v0[2], v0[3]); w.z = cvt_pk_bf16(v1[0], v1[1]); w.w = cvt_pk_bf16(v1[2], v1[3]);
                    *(u32x4*)(rowp + bj * HALF) = w; } }
    }
};
}
namespace attn {
constexpr int NW = 8, QBLK = 32, KVBLK = 64, DV = 128;
#define SBAR() __builtin_amdgcn_sched_barrier(0)
__device__ __forceinline__ int crow(int r, int hi) { return (r & 3) + 8 * (r >> 2) + 4 * hi; }
template <int DQK> __device__ __forceinline__ int kswz(int row, int colB) {
    if constexpr (DQK == 128) return row * 256 + (colB ^ ((row & 15) << 4));
    else return row * (DQK * 2) + (colB ^ (((row >> 1) & 7) << 4));
}
template <int DQK> struct Shm { static constexpr int V = KVBLK * DV * 2, K = KVBLK * DQK * 2, TOTAL = 3 * V + 3 * K + NW * 64 * 4; };

template <float const& CREF> struct Dummy {};
__device__ __forceinline__ void partialSM(f32x16& p0, f32x16& p1, float& m_reg, float& mn, float& alpha, const float C, const float thr) {
  float pmax = p0[0];
#pragma unroll
  for (int r = 1; r < 16; ++r) pmax = fmaxf(pmax, p0[r]);
#pragma unroll
  for (int r = 0; r < 16; ++r) pmax = fmaxf(pmax, p1[r]);
  { auto rr = __builtin_amdgcn_permlane32_swap(__float_as_uint(pmax), __float_as_uint(pmax), false, false);
    pmax = fmaxf(__uint_as_float(rr[0]), __uint_as_float(rr[1])); }
  if (__builtin_expect(__all(pmax - m_reg <= thr), 1)) { mn = m_reg; alpha = 1.f; }
  else { mn = fmaxf(m_reg, pmax); alpha = __builtin_amdgcn_exp2f((m_reg - mn) * C); m_reg = mn; }
  float mnC = -mn * C;
#pragma unroll
  for (int r = 0; r < 16; ++r) p0[r] = fmaf(p0[r], C, mnC);
#pragma unroll
  for (int r = 0; r < 16; ++r) p1[r] = fmaf(p1[r], C, mnC);
#pragma unroll
  for (int r = 0; r < 16; ++r) p0[r] = __builtin_amdgcn_exp2f(p0[r]);
}
__device__ __forceinline__ void finishSM(f32x16& p0, f32x16& p1, float alpha, float& l_reg, bf16x8& pa0, bf16x8& pa1, bf16x8& pa2, bf16x8& pa3) {
#pragma unroll
  for (int r = 0; r < 16; ++r) p1[r] = __builtin_amdgcn_exp2f(p1[r]);
  float ps = 0;
#pragma unroll
  for (int r = 0; r < 16; ++r) ps += p0[r];
#pragma unroll
  for (int r = 0; r < 16; ++r) ps += p1[r];
  { auto rr = __builtin_amdgcn_permlane32_swap(__float_as_uint(ps), __float_as_uint(ps), false, false);
    ps = __uint_as_float(rr[0]) + __uint_as_float(rr[1]); }
  l_reg = l_reg * alpha + ps;
#define PK4(P, BASE, OUT) do { unsigned a0 = cvt_pk_bf16(P[BASE + 0], P[BASE + 1]), a1 = cvt_pk_bf16(P[BASE + 2], P[BASE + 3]);   \
    unsigned b0 = cvt_pk_bf16(P[BASE + 4], P[BASE + 5]), b1 = cvt_pk_bf16(P[BASE + 6], P[BASE + 7]);                              \
    auto r0 = __builtin_amdgcn_permlane32_swap(a0, b0, false, false); auto r1 = __builtin_amdgcn_permlane32_swap(a1, b1, false, false); \
    u32x4 w = {r0[0], r1[0], r0[1], r1[1]}; OUT = *reinterpret_cast<bf16x8*>(&w); } while (0)
  PK4(p0, 0, pa0); PK4(p0, 8, pa1); PK4(p1, 0, pa2); PK4(p1, 8, pa3);
#undef PK4
}
template <int DQK>
__device__ __forceinline__ void qkt(f32x16& p0, f32x16& p1, const char* Ks, const bf16x8* qr, int r32, int hi) {
  p0 = f32x16{}; p1 = f32x16{};
#pragma unroll
  for (int d0 = 0; d0 < DQK / 16; ++d0) { int cb = (d0 * 16 + hi * 8) * 2;
    bf16x8 b0 = *reinterpret_cast<const bf16x8*>(Ks + kswz<DQK>(r32, cb));
    bf16x8 b1 = *reinterpret_cast<const bf16x8*>(Ks + kswz<DQK>(32 + r32, cb));
    p0 = __builtin_amdgcn_mfma_f32_32x32x16_bf16(b0, qr[d0], p0, 0, 0, 0);
    p1 = __builtin_amdgcn_mfma_f32_32x32x16_bf16(b1, qr[d0], p1, 0, 0, 0); }
}
__device__ __forceinline__ int v_st(int k, int c) { const int kk = (k & ~0xC) | ((k & 4) << 1) | ((k & 8) >> 1); return ((kk >> 3) * 4 + (c >> 5)) * 512 + ((kk & 7) * 32 + (c & 31)) * 2; }
__device__ __forceinline__ int v_rd_base(int lane) { return ((lane & 3) << 3) | (((lane >> 2) & 3) << 6) | (((lane >> 4) & 1) << 5) | (((lane >> 5) & 1) << 8); }
constexpr int v_rd_off(int d0, int ks, int half) { return d0 * 512 + ks * 4096 + half * 2048; }
template <int OFF> __device__ __forceinline__ s16x4 tr_read(int vb) {
  s16x4 r; asm volatile("ds_read_b64_tr_b16 %0, %1 offset:%2" : "=&v"(r) : "v"(vb), "i"(OFF) : "memory"); return r;
}
template <int D0> __device__ __forceinline__ void pv_one(f32x16& od, int vb, bf16x8 pa0, bf16x8 pa1, bf16x8 pa2, bf16x8 pa3) {
  const s16x4 l0 = tr_read<v_rd_off(D0, 0, 0)>(vb), h0 = tr_read<v_rd_off(D0, 0, 1)>(vb), l1 = tr_read<v_rd_off(D0, 1, 0)>(vb), h1 = tr_read<v_rd_off(D0, 1, 1)>(vb);
  const s16x4 l2 = tr_read<v_rd_off(D0, 2, 0)>(vb), h2 = tr_read<v_rd_off(D0, 2, 1)>(vb), l3 = tr_read<v_rd_off(D0, 3, 0)>(vb), h3 = tr_read<v_rd_off(D0, 3, 1)>(vb);
  asm volatile("s_waitcnt lgkmcnt(0)" ::: "memory"); SBAR();
#define PK(L, H) (bf16x8){L[0], L[1], L[2], L[3], H[0], H[1], H[2], H[3]}
  od = __builtin_amdgcn_mfma_f32_32x32x16_bf16(pa0, PK(l0, h0), od, 0, 0, 0);
  od = __builtin_amdgcn_mfma_f32_32x32x16_bf16(pa1, PK(l1, h1), od, 0, 0, 0);
  od = __builtin_amdgcn_mfma_f32_32x32x16_bf16(pa2, PK(l2, h2), od, 0, 0, 0);
  od = __builtin_amdgcn_mfma_f32_32x32x16_bf16(pa3, PK(l3, h3), od, 0, 0, 0);
#undef PK
}
__device__ __forceinline__ void pv_d0(f32x16* o, int vb, bf16x8 pa0, bf16x8 pa1, bf16x8 pa2, bf16x8 pa3) {
  pv_one<0>(o[0], vb, pa0, pa1, pa2, pa3); pv_one<1>(o[1], vb, pa0, pa1, pa2, pa3); pv_one<2>(o[2], vb, pa0, pa1, pa2, pa3); pv_one<3>(o[3], vb, pa0, pa1, pa2, pa3);
}

__device__ __forceinline__ void glds16(const void* gsrc, unsigned lds_dst) { unsigned keep;
  asm volatile("s_mov_b32 %0, m0\n\ts_mov_b32 m0, %2\n\ts_nop 0\n\tglobal_load_lds_dwordx4 %1, off\n\ts_mov_b32 m0, %0" : "=&s"(keep) : "v"(gsrc), "s"(lds_dst) : "memory"); }
#define ATT_WAIT_BAR(N) asm volatile("s_waitcnt vmcnt(" #N ") lgkmcnt(0)\n\ts_barrier" ::: "memory")
__device__ __forceinline__ int nx3(int s) { return s == 2 ? 0 : s + 1; }
template <int DQK, int LDQ, int LDK, int LDV, int LDO>
__device__ __forceinline__ void attn_unit(const bf16_t* __restrict__ Qb, const bf16_t* __restrict__ Kh, const bf16_t* __restrict__ Vh, bf16_t* __restrict__ Ob, int seq, char* lds) {
  constexpr float scale = (DQK == 128) ? 0.08838834764831845f : 0.07216878364870323f;
  constexpr int SHM_V = KVBLK * DV * 2, SHM_K = KVBLK * DQK * 2, NQ = DQK / 16, NKP = SHM_K / 8192;
  constexpr int KRING = 0, VRING = 3 * SHM_K, WSOFF = 3 * SHM_K + 3 * SHM_V;
  constexpr float C = scale * 1.4426950408889634f, thr = 8.f / scale;
  int tid_ = threadIdx.x; asm volatile("" : "+v"(tid_));
  const int tid = tid_, lane = tid & 63, r32 = lane & 31, hi = lane >> 5; const int wid = __builtin_amdgcn_readfirstlane(tid >> 6);
  const unsigned lds0 = (unsigned)(uintptr_t)lds;
  float* ws = (float*)(lds + WSOFF) + wid * 64; float* li_l = ws; float* al_l = ws + 32;
  float m_reg = -1e30f, l_reg = 0; f32x16 o[4] = {}; bf16x8 qr[NQ];
  const bf16_t* Qw = Qb + (long)(wid * QBLK + r32) * LDQ + hi * 8;
#pragma unroll
  for (int d0 = 0; d0 < NQ; ++d0) qr[d0] = *reinterpret_cast<const bf16x8*>(Qw + d0 * 16);
  int koff[NKP], voff[2];
#pragma unroll
  for (int p = 0; p < NKP; ++p) { const int P = (p * 8 + wid) * 1024 + lane * 16, row = P / (DQK * 2), cs = P % (DQK * 2);
    const int colB = (DQK == 128) ? (cs ^ ((row & 15) << 4)) : (cs ^ (((row >> 1) & 7) << 4)); koff[p] = row * LDK + (colB >> 1); }
#pragma unroll
  for (int p = 0; p < 2; ++p) { const int P = (p * 8 + wid) * 1024 + lane * 16, sub = P >> 9, w5 = P & 511, kk = (sub >> 2) * 8 + (w5 >> 6), c = (sub & 3) * 32 + ((w5 & 63) >> 1);
    const int k = (kk & ~0xC) | ((kk & 4) << 1) | ((kk & 8) >> 1); voff[p] = k * LDV + c; }
#define DMA_K(t, slot) do { _Pragma("unroll") for (int p = 0; p < NKP; ++p) glds16(Kh + (long)(t) * KVBLK * LDK + koff[p], (unsigned)__builtin_amdgcn_readfirstlane((int)(lds0 + KRING + (slot) * SHM_K + (p * 8 + wid) * 1024))); } while (0)
#define DMA_V(t, slot) do { _Pragma("unroll") for (int p = 0; p < 2; ++p) glds16(Vh + (long)(t) * KVBLK * LDV + voff[p], (unsigned)__builtin_amdgcn_readfirstlane((int)(lds0 + VRING + (slot) * SHM_V + (p * 8 + wid) * 1024))); } while (0)
#define RESC(a) do { if (__any((a) < 1.f)) { if (hi == 0) al_l[r32] = (a); asm volatile("s_waitcnt lgkmcnt(0)" ::: "memory"); \
    _Pragma("unroll") for (int d = 0; d < 4; ++d) _Pragma("unroll") for (int r = 0; r < 16; ++r) o[d][r] *= al_l[crow(r, hi)]; } } while (0)
#define CLOSE(t) do { if ((t) + 2 < NT) { if constexpr (NKP == 2) ATT_WAIT_BAR(4); else ATT_WAIT_BAR(5); } else ATT_WAIT_BAR(0); } while (0)
  const int vb0 = (int)(lds0 + VRING) + v_rd_base(lane);
  const char* Kr = lds + KRING;
  f32x16 pA0, pA1, pB0, pB1; float mnA, mnB, alA, alB; bf16x8 pa0, pa1, pa2, pa3; const int NT = seq / KVBLK;
  DMA_K(0, 0); DMA_V(0, 0); DMA_K(1, 1);
  if constexpr (NKP == 2) ATT_WAIT_BAR(2); else ATT_WAIT_BAR(3);
  DMA_K(2, 2); DMA_V(1, 1);
  qkt<DQK>(pA0, pA1, Kr, qr, r32, hi); partialSM(pA0, pA1, m_reg, mnA, alA, C, thr);
  CLOSE(0);
  int sk = 1;
  for (int j = 1; j + 1 < NT; j += 2) {
    { const int s1 = nx3(sk), s2 = nx3(s1);
      if (j + 2 < NT) DMA_K(j + 2, s2); DMA_V(j + 1, s1);
      SBAR(); qkt<DQK>(pB0, pB1, Kr + sk * SHM_K, qr, r32, hi);
      finishSM(pA0, pA1, alA, l_reg, pa0, pa1, pa2, pa3); SBAR();
      pv_d0(o, vb0 + s2 * SHM_V, pa0, pa1, pa2, pa3); partialSM(pB0, pB1, m_reg, mnB, alB, C, thr);
      RESC(alB); CLOSE(j); sk = s1; }
    { const int s1 = nx3(sk), s2 = nx3(s1);
      if (j + 3 < NT) DMA_K(j + 3, s2); if (j + 2 < NT) DMA_V(j + 2, s1);
      SBAR(); qkt<DQK>(pA0, pA1, Kr + sk * SHM_K, qr, r32, hi);
      finishSM(pB0, pB1, alB, l_reg, pa0, pa1, pa2, pa3); SBAR();
      pv_d0(o, vb0 + s2 * SHM_V, pa0, pa1, pa2, pa3); partialSM(pA0, pA1, m_reg, mnA, alA, C, thr);
      RESC(alA); CLOSE(j + 1); sk = s1; }
  }
  { const int s1 = nx3(sk), s2 = nx3(s1);
    SBAR(); qkt<DQK>(pB0, pB1, Kr + sk * SHM_K, qr, r32, hi);
    finishSM(pA0, pA1, alA, l_reg, pa0, pa1, pa2, pa3); SBAR();
    pv_d0(o, vb0 + s2 * SHM_V, pa0, pa1, pa2, pa3); partialSM(pB0, pB1, m_reg, mnB, alB, C, thr);
    RESC(alB);
    finishSM(pB0, pB1, alB, l_reg, pa0, pa1, pa2, pa3); SBAR();
    pv_d0(o, vb0 + sk * SHM_V, pa0, pa1, pa2, pa3); (void)s1; }
  if (hi == 0) li_l[r32] = l_reg; asm volatile("s_waitcnt lgkmcnt(0)" ::: "memory");
  float rli[16];
#pragma unroll
  for (int r = 0; r < 16; ++r) rli[r] = __builtin_amdgcn_rcpf(li_l[crow(r, hi)]);
  bf16_t* Ow = Ob + (long)(wid * QBLK) * LDO;
#pragma unroll
  for (int r = 0; r < 16; ++r) { int orow = crow(r, hi);
#pragma unroll
    for (int d0 = 0; d0 < 4; ++d0) Ow[(long)orow * LDO + d0 * 32 + r32] = f2bf(o[d0][r] * rli[r]); }
  ATT_WAIT_BAR(0);
#undef DMA_K
#undef DMA_V
#undef RESC
#undef CLOSE
}
}
constexpr int BATCH = 4, SEQ = 4096, DM = 2048, M = BATCH * SEQ, DEPTH = 4;
constexpr int NEXP = 16, FF = 1536, CAP = 512, MX = NEXP * BATCH * CAP;
constexpr int HW = 4096;
constexpr int C_CQ = 0, C_CKV = 512, C_GQ = 768, C_GK = 1280, C_GV = 1792, C_GR = 2816, C_KR = 3840, C_LAT = 3904;
constexpr float LN_EPS = 1e-5f, RMS_EPS = 1e-6f;
constexpr float DN_ALPHA = 1.681792830507429f;
constexpr float MLA_SCALE = 0.07216878364870323f;
constexpr float GQA_SCALE = 0.08838834764831845f;

constexpr size_t MiB = 1u << 20;
constexpr size_t WS_CTL = 0, CTL_ZERO_BYTES = 1 * MiB;
constexpr size_t WS_ROPER = 1 * MiB, WS_ROPEG = 2 * MiB, WS_AFF = 4 * MiB, WS_IDX = 5 * MiB, WS_GATE = 5 * MiB + 512 * 1024, WS_SLOT = 6 * MiB, WS_DECAY = 7 * MiB;
constexpr size_t WS_WIN = 8 * MiB, WS_WUQ = 40 * MiB, WS_WUKV = 43 * MiB, WS_WMO = 48 * MiB, WS_WQKV = 64 * MiB, WS_WGO = 88 * MiB, WS_W13 = 104 * MiB, WS_W2 = 872 * MiB;
constexpr size_t WS_XB = 1256 * MiB, WS_X1 = 1320 * MiB, WS_X1B = 1448 * MiB, WS_H = 1512 * MiB, WS_QM = 1640 * MiB, WS_KM = 1688 * MiB, WS_VM = 1736 * MiB, WS_OCAT = 1768 * MiB;
constexpr size_t WS_QIN = 1832 * MiB, WS_KIN = 1864 * MiB, WS_KST = 1896 * MiB, WS_VT = 1928 * MiB, WS_OF = 1960 * MiB, WS_OB = 2024 * MiB, WS_HDN = 2088 * MiB, WS_Y = 2184 * MiB, WS_END = 2312 * MiB;
constexpr int CW_TMO = 0, CW_DBG = 2, CW_BAR = 4096;

constexpr int RING_BYTES = 131072, MISC_OFF = RING_BYTES + 320, LDS_BYTES = 147456;
constexpr int NWAVES = 8, NTHR = 512;

#define RLX_AGENT __ATOMIC_RELAXED, __HIP_MEMORY_SCOPE_AGENT
#define LDS_WAIT() asm volatile("s_waitcnt lgkmcnt(0)" ::: "memory")
#define VM_WAIT() asm volatile("s_waitcnt vmcnt(0)" ::: "memory")

#define XB_TMO      128
#define XB_XCNT(j)  (256  + 64 * (j))
#define XB_XSUB(j)  (1280 + 64 * (j))
#define XB_XGEN(j)  (2304 + 64 * (j))
#define XB_TOP      3328
#define XB_TOPGEN   3392
#define XCD_BAR_WORDS 3456
#define XB_SPIN_CAP (1u << 22)
__device__ __forceinline__ unsigned xb_ld(unsigned* p)              { return __hip_atomic_load(p, __ATOMIC_RELAXED, __HIP_MEMORY_SCOPE_AGENT); }
__device__ __forceinline__ unsigned xb_add(unsigned* p, unsigned v) { return __hip_atomic_fetch_add(p, v, __ATOMIC_RELAXED, __HIP_MEMORY_SCOPE_AGENT); }
__device__ __forceinline__ unsigned xb_xcc_id() { return (unsigned)__builtin_amdgcn_s_getreg((3 << 11) | 20) & 0xFu; }
#define XB_SPIN(cond, bar) do { unsigned _sp = 0; while (cond) { __builtin_amdgcn_s_sleep(1); \
    if ((++_sp & 255u) == 0u) { if (xb_ld(&(bar)[XB_TMO])) break; if (_sp > XB_SPIN_CAP) { atomicAdd(&(bar)[XB_TMO], 1u); break; } } } } while (0)
struct XcdBarrier { unsigned* bar; unsigned x; volatile LAS unsigned* st; };
__device__ __forceinline__ XcdBarrier xcd_barrier_post(unsigned* bar, volatile LAS unsigned* st) {
    XcdBarrier b; b.bar = bar; b.x = xb_xcc_id(); b.st = st;
    if (threadIdx.x == 0) (void)xb_add(&bar[XB_XCNT(b.x)], 1u);
    return b;
}
__device__ __forceinline__ void xcd_barrier_complete(unsigned* bar, unsigned x, unsigned& nloc, unsigned& nx) {
    const unsigned G = gridDim.x * gridDim.y * gridDim.z;
    unsigned sum, cnt, mine, sp = 0u;
    for (;;) {
        sum = 0u; cnt = 0u; mine = 0u;
#pragma unroll
        for (unsigned j = 0; j < 16; ++j) { const unsigned c = xb_ld(&bar[XB_XCNT(j)]); sum += c; cnt += (c > 0u) ? 1u : 0u; mine = (j == x) ? c : mine; }
        if (sum == G) break;
        __builtin_amdgcn_s_sleep(1);
        if ((++sp & 255u) == 0u) { if (xb_ld(&bar[XB_TMO])) break; if (sp > XB_SPIN_CAP) { atomicAdd(&bar[XB_TMO], 1u); break; } }
    }
    nloc = mine > 0u ? mine : 1u; nx = cnt > 0u ? cnt : 1u;
}
__device__ __forceinline__ void xcd_barrier(const XcdBarrier& b) {
    asm volatile("s_waitcnt vmcnt(0)" ::: "memory");
    __syncthreads();
    if (threadIdx.x == 0) {
        unsigned* bar = b.bar;
        __builtin_amdgcn_s_waitcnt(0);
        unsigned nloc = b.st[0], nx = b.st[1];
        if (nloc == 0u) { xcd_barrier_complete(bar, b.x, nloc, nx); b.st[0] = nloc; b.st[1] = nx; }
        const unsigned old = xb_add(&bar[XB_XSUB(b.x)], 1u);
        const unsigned gen = old / nloc;
        if (old + 1u == (gen + 1u) * nloc) {
            __builtin_amdgcn_fence(__ATOMIC_RELEASE, "agent");
            asm volatile("s_waitcnt vmcnt(0)" ::: "memory");
            const unsigned og = xb_add(&bar[XB_TOP], 1u);
            const unsigned tg = og / nx;
            if (og + 1u == (tg + 1u) * nx) xb_add(&bar[XB_TOPGEN], 1u);
            else XB_SPIN(xb_ld(&bar[XB_TOPGEN]) == tg, bar);
            __builtin_amdgcn_fence(__ATOMIC_ACQUIRE, "agent");
            xb_add(&bar[XB_XGEN(b.x)], 1u);
            asm volatile("s_waitcnt vmcnt(0)" ::: "memory");
        } else {
            XB_SPIN(xb_ld(&bar[XB_XGEN(b.x)]) == gen, bar);
            __builtin_amdgcn_fence(__ATOMIC_ACQUIRE, "agent");
            asm volatile("s_waitcnt vmcnt(0)" ::: "memory");
        }
    }
    __syncthreads();
}

__device__ __forceinline__ float wave_sum(float v) {
#pragma unroll
    for (int o = 1; o < 64; o <<= 1) v += __shfl_xor(v, o);
    return v;
}
__device__ __forceinline__ int wave_sum_i(int v) {
#pragma unroll
    for (int o = 1; o < 64; o <<= 1) v += __shfl_xor(v, o);
    return v;
}
#define WG_BAR() do { asm volatile("s_waitcnt lgkmcnt(0)" ::: "memory"); __builtin_amdgcn_s_barrier(); asm volatile("" ::: "memory"); } while (0)

struct Ctx { LAS unsigned char* lds; int tid, lane, wave, vcu, G; };
__device__ __forceinline__ Ctx opaque_ctx(const Ctx& c) { Ctx d = c; asm volatile("" : "+v"(d.tid)); d.lane = d.tid & 63; d.wave = __builtin_amdgcn_readfirstlane(d.tid >> 6); return d; }

__device__ __forceinline__ void transpose_item(const float* W, int K, int N, bf16_t* WT, int dst_row0, int k0, int n0, LAS unsigned* scr, int lane) {
    const int r2 = lane >> 4, c4 = lane & 15; const bool ok = (n0 + 4 * c4) < N;
    const float* src = W + (size_t)(k0 + 2 * r2) * N + n0 + 4 * c4;
#pragma unroll
    for (int i = 0; i < 8; ++i) { f32x4 a = {0.f, 0.f, 0.f, 0.f}, b = {0.f, 0.f, 0.f, 0.f};
        if (ok) { a = __builtin_nontemporal_load((const f32x4*)(src + (size_t)(8 * i) * N)); b = __builtin_nontemporal_load((const f32x4*)(src + (size_t)(8 * i + 1) * N)); }
        const int p = 4 * i + r2;
#pragma unroll
        for (int j = 0; j < 4; ++j) scr[(4 * c4 + j) * 33 + p] = cvt_pk_bf16(a[j], b[j]); }
    LDS_WAIT(); asm volatile("" ::: "memory");
    const int nvalid = (N - n0) < 64 ? (N - n0) : 64;
#pragma unroll
    for (int q = 0; q < 8; ++q) { const int ci = lane + 64 * q, n = ci >> 3, ch = ci & 7; const LAS unsigned* s = scr + n * 33 + ch * 4;
        const u32x4 o = {s[0], s[1], s[2], s[3]};
        if (n < nvalid) *(u32x4*)(WT + (size_t)(dst_row0 + n) * K + k0 + 8 * ch) = o; }
    LDS_WAIT(); asm volatile("" ::: "memory");
}
__device__ __forceinline__ int map_row(int map, int n0) {
    if (map == 1) return (n0 < 768) ? n0 : (n0 < 832 ? n0 + 3072 : (n0 < 3904 ? n0 - 64 : n0));
    if (map == 2) return (n0 >> 7) * 256 + (n0 & 127);
    if (map == 3) return (n0 >> 7) * 256 + 128 + (n0 & 127);
    return n0;
}
__device__ __forceinline__ void transpose_batch(const Ctx& c, const float* src, bf16_t* dst, int K, int N, int nmat, size_t src_ms, size_t dst_ms, int map) {
    LAS unsigned* scr = (LAS unsigned*)(c.lds + c.wave * 16384);
    const int gw = c.vcu * NWAVES + c.wave, NGW = c.G * NWAVES;
    const int nblk = (N + 63) / 64, per = (K / 64) * nblk; const long total = (long)per * nmat;
    for (long it = gw; it < total; it += NGW) {
        const int mat = (int)(it / per), r = (int)(it % per), kb = r / nblk, nb = r % nblk;
        transpose_item(src + (size_t)mat * src_ms, K, N, dst + (size_t)mat * dst_ms, map_row(map, nb * 64), kb * 64, nb * 64, scr, c.lane);
    }
}

__device__ __forceinline__ void fill_rope(const Ctx& c, f32x2* tabR, f32x2* tabG) {
    const int gt = (c.vcu * NTHR + c.tid), NT = c.G * NTHR;
    for (int i = gt; i < SEQ * 32; i += NT) { const int t = i >> 5, p = i & 31, j = p & 15; const float inv = exp2f(-(float)(2 * j) * (13.287712379549449f / 32.f));
        const float pos = (float)(p < 16 ? (t >> 6) : (t & 63)); const float a = pos * inv; tabR[i] = (f32x2){cosf(a), sinf(a)}; }
    for (int i = gt; i < SEQ * 64; i += NT) { const int t = i >> 6, p = i & 63, j = p & 31; const float inv = exp2f(-(float)(2 * j) * (13.287712379549449f / 64.f));
        const float pos = (float)(p < 32 ? (t >> 6) : (t & 63)); const float a = pos * inv; tabG[i] = (f32x2){cosf(a), sinf(a)}; }
}
__device__ __forceinline__ void cvt_rows_bf16(const Ctx& c, const float* x, bf16_t* xb) {
    const long gt = (long)c.vcu * NTHR + c.tid, NT = (long)c.G * NTHR, n8 = (long)M * DM / 8;
    for (long i = gt; i < n8; i += NT) { const f32x4 a = *(const f32x4*)(x + i * 8), b = *(const f32x4*)(x + i * 8 + 4);
        u32x4 w; w.x = cvt_pk_bf16(a[0], a[1]); w.y = cvt_pk_bf16(a[2], a[3]); w.z = cvt_pk_bf16(b[0], b[1]); w.w = cvt_pk_bf16(b[2], b[3]); *(u32x4*)(xb + i * 8) = w; }
}

__device__ __forceinline__ void mla_prep_rows(const Ctx& c, bf16_t* H, bf16_t* Hd, bf16_t* Km, const float* qn, const float* kvn, const f32x2* tabR) {
    const int gw = c.vcu * NWAVES + c.wave, NGW = c.G * NWAVES, lane = c.lane;
    for (int r = gw; r < M; r += NGW) {
        bf16_t* h = H + (size_t)r * HW; bf16_t* hd = Hd + (size_t)r * HW;
        { u32x4 w = *(const u32x4*)(h + C_CQ + lane * 8); float f[8] = {bf_lo(w.x), bf_hi(w.x), bf_lo(w.y), bf_hi(w.y), bf_lo(w.z), bf_hi(w.z), bf_lo(w.w), bf_hi(w.w)};
          float s = 0.f;
#pragma unroll
          for (int i = 0; i < 8; ++i) s += f[i] * f[i];
          const float rs = rsqrtf(wave_sum(s) * (1.f / 512.f) + RMS_EPS);
          const f32x4 g0 = *(const f32x4*)(qn + lane * 8), g1 = *(const f32x4*)(qn + lane * 8 + 4);
          u32x4 o; o.x = cvt_pk_bf16(f[0] * rs * g0[0], f[1] * rs * g0[1]); o.y = cvt_pk_bf16(f[2] * rs * g0[2], f[3] * rs * g0[3]);
          o.z = cvt_pk_bf16(f[4] * rs * g1[0], f[5] * rs * g1[1]); o.w = cvt_pk_bf16(f[6] * rs * g1[2], f[7] * rs * g1[3]);
          *(u32x4*)(hd + C_CQ + lane * 8) = o; }
        { u32x2 w = *(const u32x2*)(h + C_CKV + lane * 4); float f[4] = {bf_lo(w.x), bf_hi(w.x), bf_lo(w.y), bf_hi(w.y)};
          const float s = f[0] * f[0] + f[1] * f[1] + f[2] * f[2] + f[3] * f[3];
          const float rs = rsqrtf(wave_sum(s) * (1.f / 256.f) + RMS_EPS);
          const f32x4 g0 = *(const f32x4*)(kvn + lane * 4);
          u32x2 o; o.x = cvt_pk_bf16(f[0] * rs * g0[0], f[1] * rs * g0[1]); o.y = cvt_pk_bf16(f[2] * rs * g0[2], f[3] * rs * g0[3]);
          *(u32x2*)(hd + C_CKV + lane * 4) = o; }
        if (lane < 32) { const unsigned w = *(const unsigned*)(h + C_KR + 2 * lane); const float x1 = bf_lo(w), x2 = bf_hi(w); const f32x2 cs = tabR[(size_t)(r & (SEQ - 1)) * 32 + lane];
          const unsigned o = cvt_pk_bf16(x1 * cs.x - x2 * cs.y, x1 * cs.y + x2 * cs.x);
#pragma unroll
          for (int hh = 0; hh < 8; ++hh) *(unsigned*)(Km + (size_t)r * 1536 + hh * 192 + 128 + 2 * lane) = o; }
    }
}

__device__ __forceinline__ float log_sigmoid(float z) { const float e = __expf(-fabsf(z)); return fminf(z, 0.f) - __logf(1.f + e); }
__device__ __forceinline__ void gla_prep(const Ctx& c, const bf16_t* H, const float* w2  , const float* gb  , bf16_t* qin, bf16_t* att, bf16_t* kstT, bf16_t* vT, float* decay) {
    constexpr int TP = 66, QP = 136;
    LAS float* cum = (LAS float*)c.lds;
    LAS bf16_t* vt_l = (LAS bf16_t*)c.lds;
    LAS bf16_t* kst_l = (LAS bf16_t*)(c.lds + 32768);
    LAS bf16_t* Ql = (LAS bf16_t*)(c.lds + 32768 + 16896);
    LAS bf16_t* Kl = (LAS bf16_t*)(c.lds + 32768 + 16896 + 17408);
    LAS float* tot = (LAS float*)(c.lds + 32768 + 16896 + 2 * 17408);
    const int tid = c.tid, qtr = tid >> 7, dk = tid & 127, lane = c.lane, w = c.wave, fr = lane & 15, fq = lane >> 4;
    for (int item = c.vcu; item < BATCH * 64 * 4; item += c.G) {
        const int hh = item & 3, bc = item >> 2;
        const size_t row0 = (size_t)bc * 64;
        const int col = hh * 128 + dk;
#pragma nounroll
        for (int dir = 0; dir < 2; ++dir) {
            float wv[16];
#pragma unroll
            for (int j = 0; j < 16; ++j) wv[j] = w2[(dir * 16 + j) * 512 + col];
            const float bias = gb[dir * 512 + col];
            float run = 0.f;
#pragma unroll 2
            for (int i = 0; i < 16; ++i) { const int t = qtr * 16 + (dir ? 15 - i : i); const bf16_t* lp = H + (row0 + t) * HW + C_LAT + dir * 16;
                const u32x4 a = *(const u32x4*)lp, b = *(const u32x4*)(lp + 8);
                float z = bias;
                z += bf_lo(a.x) * wv[0] + bf_hi(a.x) * wv[1] + bf_lo(a.y) * wv[2] + bf_hi(a.y) * wv[3] + bf_lo(a.z) * wv[4] + bf_hi(a.z) * wv[5] + bf_lo(a.w) * wv[6] + bf_hi(a.w) * wv[7];
                z += bf_lo(b.x) * wv[8] + bf_hi(b.x) * wv[9] + bf_lo(b.y) * wv[10] + bf_hi(b.y) * wv[11] + bf_lo(b.z) * wv[12] + bf_hi(b.z) * wv[13] + bf_lo(b.w) * wv[14] + bf_hi(b.w) * wv[15];
                run += log_sigmoid(z) * (1.f / 16.f); cum[t * 128 + dk] = run; }
            tot[dk * 4 + qtr] = run;
            WG_BAR();
            const f32x4 tq = *(const LAS f32x4*)(tot + dk * 4);
            const float blast = (tq[0] + tq[1]) + (tq[2] + tq[3]);
            float off = 0.f;
#pragma unroll
            for (int q = 0; q < 4; ++q) off += ((dir == 0) ? (q < qtr) : (q > qtr)) ? tq[q] : 0.f;
#pragma unroll 2
            for (int i = 0; i < 16; ++i) { const int t = qtr * 16 + i; const size_t r = row0 + t;
                const float bcum = cum[t * 128 + dk] + off;
                const float q = bf2f(H[r * HW + C_GQ + col]) * 0.08838834764831845f, k = bf2f(H[r * HW + C_GK + col]);
                const bf16_t qb = f2bf(q * __expf(bcum));
                qin[((size_t)dir * M + r) * 512 + col] = qb; Ql[t * QP + dk] = qb;
                Kl[t * QP + dk] = f2bf(k * __expf(-bcum));
                kst_l[dk * TP + t] = f2bf(k * __expf(blast - bcum)); }
            if (qtr == 0) decay[(((size_t)dir * 256 + bc) * 4 + hh) * 128 + dk] = __expf(blast);
            WG_BAR();
            { const int ib = w >> 1, par = w & 1;
              const LAS bf16_t* qp = Ql + (ib * 16 + fr) * QP + 8 * fq; const LAS bf16_t* kp = Kl + (2 * par * 16 + fr) * QP + 8 * fq;
              f32x4 a0 = {0.f, 0.f, 0.f, 0.f}, a1 = {0.f, 0.f, 0.f, 0.f};
#pragma unroll
              for (int kk = 0; kk < 4; ++kk) { const bf16x8 qf = *(const LAS bf16x8*)(qp + kk * 32), k0 = *(const LAS bf16x8*)(kp + kk * 32), k1 = *(const LAS bf16x8*)(kp + 16 * QP + kk * 32);
                  a0 = __builtin_amdgcn_mfma_f32_16x16x32_bf16(k0, qf, a0, 0, 0, 0); a1 = __builtin_amdgcn_mfma_f32_16x16x32_bf16(k1, qf, a1, 0, 0, 0); }
              const int i = ib * 16 + fr, j0 = 2 * par * 16 + 4 * fq;
#pragma unroll
              for (int r = 0; r < 4; ++r) { const int j = j0 + r; a0[r] = (dir ? (j >= i) : (j <= i)) ? a0[r] : 0.f; a1[r] = (dir ? (j + 16 >= i) : (j + 16 <= i)) ? a1[r] : 0.f; }
              bf16_t* ap = att + ((((size_t)dir * 256 + bc) * 4 + hh) * 64 + i) * 64 + j0;
              u32x2 w0, w1; w0.x = cvt_pk_bf16(a0[0], a0[1]); w0.y = cvt_pk_bf16(a0[2], a0[3]); w1.x = cvt_pk_bf16(a1[0], a1[1]); w1.y = cvt_pk_bf16(a1[2], a1[3]);
              *(u32x2*)ap = w0; *(u32x2*)(ap + 16) = w1; }
#pragma unroll
            for (int q2 = 0; q2 < 2; ++q2) { const int ci = tid + 512 * q2, rowid = ci >> 3, ch = ci & 7; const LAS unsigned* sp = (const LAS unsigned*)(kst_l + rowid * TP + ch * 8);
                const u32x4 wd = {sp[0], sp[1], sp[2], sp[3]};
                *(u32x4*)(kstT + (((((size_t)dir * 256 + bc) * 4 + hh) * 128 + rowid) * 64 + ch * 8)) = wd; }
            WG_BAR();
        }
        { const int dv = tid & 255, half = tid >> 8;
#pragma unroll 4
          for (int i = 0; i < 32; ++i) { const int t = half * 32 + i; vt_l[dv * TP + t] = H[(row0 + t) * HW + C_GV + hh * 256 + dv]; } }
        WG_BAR();
#pragma unroll
        for (int q4 = 0; q4 < 4; ++q4) { const int ci = tid + 512 * q4, rowid = ci >> 3, ch = ci & 7; const LAS unsigned* sp = (const LAS unsigned*)(vt_l + rowid * TP + ch * 8);
            const u32x4 wd = {sp[0], sp[1], sp[2], sp[3]};
            *(u32x4*)(vT + ((((size_t)bc * 4 + hh) * 256 + rowid) * 64 + ch * 8)) = wd; }
        WG_BAR();
    }
}

__device__ __forceinline__ void gla_out_rows(const Ctx& c, const float* of, const float* ob, const bf16_t* H, const float* gn, bf16_t* Ocat) {
    const int gw = c.vcu * NWAVES + c.wave, NGW = c.G * NWAVES, lane = c.lane;
    for (int r = gw; r < M; r += NGW) {
#pragma unroll
        for (int hh = 0; hh < 4; ++hh) { const int j0 = hh * 256 + lane * 4;
            const f32x4 a = *(const f32x4*)(of + (size_t)r * 1024 + j0), b = *(const f32x4*)(ob + (size_t)r * 1024 + j0); const f32x4 s = a + b;
            const float ss = s[0] * s[0] + s[1] * s[1] + s[2] * s[2] + s[3] * s[3];
            const float rs = rsqrtf(wave_sum(ss) * (1.f / 256.f) + RMS_EPS);
            const f32x4 g = *(const f32x4*)(gn + j0); const u32x2 gw2 = *(const u32x2*)(H + (size_t)r * HW + C_GR + j0);
            const float gr[4] = {bf_lo(gw2.x), bf_hi(gw2.x), bf_lo(gw2.y), bf_hi(gw2.y)}; float o[4];
#pragma unroll
            for (int i = 0; i < 4; ++i) { const float sg = gr[i] * __builtin_amdgcn_rcpf(1.f + __expf(-gr[i])); o[i] = s[i] * rs * g[i] * sg; }
            u32x2 w; w.x = cvt_pk_bf16(o[0], o[1]); w.y = cvt_pk_bf16(o[2], o[3]);
            *(u32x2*)(Ocat + (size_t)r * 2048 + 1024 + j0) = w; }
    }
}

__device__ __forceinline__ void gqa_qknorm_rows(const Ctx& c, bf16_t* H, bf16_t* Hd, const float* qn, const float* kn, const f32x2* tabG) {
    const int gw = c.vcu * NWAVES + c.wave, NGW = c.G * NWAVES, lane = c.lane;
    const float q1 = qn[2 * lane], q2 = qn[2 * lane + 1], k1 = kn[2 * lane], k2 = kn[2 * lane + 1];
    for (int r = gw; r < M; r += NGW) {
        bf16_t* h = H + (size_t)r * 3072; const f32x2 cs = tabG[(size_t)(r & (SEQ - 1)) * 64 + lane];
#pragma unroll 4
        for (int hh = 0; hh < 20; ++hh) { unsigned* p = (unsigned*)(Hd + (size_t)r * 3072 + hh * 128 + 2 * lane); const unsigned w = *(const unsigned*)(h + hh * 128 + 2 * lane); const float x1 = bf_lo(w), x2 = bf_hi(w);
            const float rs = rsqrtf(wave_sum(x1 * x1 + x2 * x2) * (1.f / 128.f) + RMS_EPS);
            const float y1 = x1 * rs * (hh < 16 ? q1 : k1), y2 = x2 * rs * (hh < 16 ? q2 : k2);
            *p = cvt_pk_bf16(y1 * cs.x - y2 * cs.y, y1 * cs.y + y2 * cs.x); }
    }
}

__device__ __forceinline__ void ln_router_rows(const Ctx& c, const float* Yin, float* X1, bf16_t* X1b, const float* g, const float* bb, const float* wr  , float* aff) {
    LAS float* Wl = (LAS float*)c.lds;
    for (int i = c.tid; i < 2048 * 16 / 4; i += NTHR) { const f32x4 w = *(const f32x4*)(wr + (size_t)i * 4); const int k = i >> 2, e0 = (i & 3) * 4;
        Wl[(e0 + 0) * 2048 + k] = w[0]; Wl[(e0 + 1) * 2048 + k] = w[1]; Wl[(e0 + 2) * 2048 + k] = w[2]; Wl[(e0 + 3) * 2048 + k] = w[3]; }
    WG_BAR();
    const int gw = c.vcu * NWAVES + c.wave, NGW = c.G * NWAVES, lane = c.lane;
    for (int r = gw; r < M; r += NGW) {
        float* xr = X1 + (size_t)r * DM; const float* yr = Yin + (size_t)r * DM; f32x4 v[8]; float s = 0.f;
#pragma unroll
        for (int j = 0; j < 8; ++j) { v[j] = *(const f32x4*)(yr + j * 256 + lane * 4); s += (v[j][0] + v[j][1]) + (v[j][2] + v[j][3]); }
        const float mean = wave_sum(s) * (1.f / DM); float s2 = 0.f;
#pragma unroll
        for (int j = 0; j < 8; ++j) { v[j] = v[j] - mean; s2 += (v[j][0] * v[j][0] + v[j][1] * v[j][1]) + (v[j][2] * v[j][2] + v[j][3] * v[j][3]); }
        const float rstd = rsqrtf(wave_sum(s2) * (1.f / DM) + LN_EPS);
#pragma unroll
        for (int j = 0; j < 8; ++j) { const f32x4 gg = *(const f32x4*)(g + j * 256 + lane * 4), b4 = *(const f32x4*)(bb + j * 256 + lane * 4);
            v[j] = v[j] * rstd * gg + b4; *(f32x4*)(xr + j * 256 + lane * 4) = v[j];
            u32x2 w; w.x = cvt_pk_bf16(v[j][0], v[j][1]); w.y = cvt_pk_bf16(v[j][2], v[j][3]); *(u32x2*)(X1b + (size_t)r * DM + j * 256 + lane * 4) = w; }
        float lg[16];
#pragma unroll
        for (int e = 0; e < 16; ++e) { float a = 0.f;
#pragma unroll
            for (int j = 0; j < 8; ++j) { const f32x4 w = *(const LAS f32x4*)(Wl + e * 2048 + j * 256 + lane * 4); a += (v[j][0] * w[0] + v[j][1] * w[1]) + (v[j][2] * w[2] + v[j][3] * w[3]); }
            lg[e] = wave_sum(a); }
        float mx = lg[0];
#pragma unroll
        for (int e = 1; e < 16; ++e) mx = fmaxf(mx, lg[e]);
        float den = 0.f;
#pragma unroll
        for (int e = 0; e < 16; ++e) { lg[e] = __expf(lg[e] - mx); den += lg[e]; }
        const float inv = 1.f / den; float mine = 0.f;
#pragma unroll
        for (int e = 0; e < 16; ++e) mine = (lane == e) ? lg[e] * inv : mine;
        if (lane < 16) aff[((size_t)(r >> 12) * 16 + lane) * SEQ + (r & (SEQ - 1))] = mine;
    }
    WG_BAR();
}

__device__ __forceinline__ void topk_units(const Ctx& c, const float* aff, int* idx, float* gate, unsigned short* slotmap) {
    LAS unsigned* sm = (LAS unsigned*)c.lds;
    const int tid = c.tid, lane = c.lane, wid = c.wave;
    for (int be = c.vcu; be < BATCH * NEXP; be += c.G) {
        const int b = be >> 4, e = be & 15;
        const float* a = aff + (size_t)be * SEQ + tid * 8;
        const u32x4 k0 = *(const u32x4*)a, k1 = *(const u32x4*)(a + 4);
        const unsigned key[8] = {k0.x, k0.y, k0.z, k0.w, k1.x, k1.y, k1.z, k1.w};
        unsigned prefix = 0u; int par = 0;
        for (int bit = 30; bit >= 0; --bit) {
            const unsigned cand = prefix | (1u << bit); int cnt = 0;
#pragma unroll
            for (int i = 0; i < 8; ++i) cnt += (key[i] >= cand) ? 1 : 0;
            cnt = wave_sum_i(cnt);
            if (lane == 0) sm[par * 8 + wid] = (unsigned)cnt;
            WG_BAR();
            unsigned total = 0u;
#pragma unroll
            for (int w = 0; w < 8; ++w) total += sm[par * 8 + w];
            if (total >= (unsigned)CAP) prefix = cand;
            par ^= 1;
        }
        const unsigned T = prefix;
        int cgt = 0, ceq = 0;
#pragma unroll
        for (int i = 0; i < 8; ++i) { cgt += (key[i] > T) ? 1 : 0; ceq += (key[i] == T) ? 1 : 0; }
        unsigned pk = (unsigned)cgt | ((unsigned)ceq << 16), inc = pk;
#pragma unroll
        for (int o = 1; o < 64; o <<= 1) { const unsigned nb = __shfl_up(inc, o); if (lane >= o) inc += nb; }
        if (lane == 63) sm[32 + wid] = inc;
        WG_BAR();
        unsigned wpre = 0u, gtot = 0u;
#pragma unroll
        for (int w = 0; w < 8; ++w) { const unsigned v = sm[32 + w]; if (w < wid) wpre += v; gtot += v; }
        const unsigned ex = wpre + inc - pk;
        int pre_gt = (int)(ex & 0xffffu), pre_eq = (int)(ex >> 16);
        const int need_eq = CAP - (int)(gtot & 0xffffu);
        const size_t obase = ((size_t)e * BATCH + b) * CAP;
#pragma unroll
        for (int i = 0; i < 8; ++i) { const int t = tid * 8 + i; const bool gt = key[i] > T, eq = key[i] == T; const bool sel = gt || (eq && pre_eq < need_eq);
            const int slot = pre_gt + (pre_eq < need_eq ? pre_eq : need_eq);
            if (sel) { idx[obase + slot] = b * SEQ + t; gate[obase + slot] = __uint_as_float(key[i]); }
            slotmap[((size_t)b * SEQ + t) * 16 + e] = sel ? (unsigned short)slot : (unsigned short)0xFFFF;
            pre_gt += gt ? 1 : 0; pre_eq += eq ? 1 : 0; }
        WG_BAR();
    }
}

__device__ __forceinline__ void combine_ln_rows(const Ctx& c, const float* X1, const bf16_t* Y, const unsigned short* slotmap, const float* g, const float* bb, float* X2, bf16_t* Xb) {
    const int gw = c.vcu * NWAVES + c.wave, NGW = c.G * NWAVES, lane = c.lane;
    for (int r = gw; r < M; r += NGW) {
        const float* xr = X1 + (size_t)r * DM; f32x4 v[8];
#pragma unroll
        for (int j = 0; j < 8; ++j) v[j] = *(const f32x4*)(xr + j * 256 + lane * 4) * DN_ALPHA;
        const u32x4 s0 = *(const u32x4*)(slotmap + (size_t)r * 16), s1 = *(const u32x4*)(slotmap + (size_t)r * 16 + 8);
        const unsigned sw[8] = {s0.x, s0.y, s0.z, s0.w, s1.x, s1.y, s1.z, s1.w};
        const int b = r >> 12;
#pragma unroll
        for (int e = 0; e < 16; ++e) { const unsigned sl = (unsigned)__builtin_amdgcn_readfirstlane((int)((sw[e >> 1] >> ((e & 1) * 16)) & 0xffffu));
            if (sl != 0xffffu) { const bf16_t* yr = Y + (((size_t)e * BATCH + b) * CAP + sl) * DM;
#pragma unroll
                for (int j = 0; j < 8; ++j) { const u32x2 w = *(const u32x2*)(yr + j * 256 + lane * 4); v[j][0] += bf_lo(w.x); v[j][1] += bf_hi(w.x); v[j][2] += bf_lo(w.y); v[j][3] += bf_hi(w.y); } } }
        float s = 0.f;
#pragma unroll
        for (int j = 0; j < 8; ++j) s += (v[j][0] + v[j][1]) + (v[j][2] + v[j][3]);
        const float mean = wave_sum(s) * (1.f / DM); float s2 = 0.f;
#pragma unroll
        for (int j = 0; j < 8; ++j) { v[j] = v[j] - mean; s2 += (v[j][0] * v[j][0] + v[j][1] * v[j][1]) + (v[j][2] * v[j][2] + v[j][3] * v[j][3]); }
        const float rstd = rsqrtf(wave_sum(s2) * (1.f / DM) + LN_EPS);
#pragma unroll
        for (int j = 0; j < 8; ++j) { const f32x4 gg = *(const f32x4*)(g + j * 256 + lane * 4), b4 = *(const f32x4*)(bb + j * 256 + lane * 4);
            v[j] = v[j] * rstd * gg + b4; *(f32x4*)(X2 + (size_t)r * DM + j * 256 + lane * 4) = v[j];
            u32x2 w; w.x = cvt_pk_bf16(v[j][0], v[j][1]); w.y = cvt_pk_bf16(v[j][2], v[j][3]); *(u32x2*)(Xb + (size_t)r * DM + j * 256 + lane * 4) = w; }
    }
}
namespace gla {
constexpr int SP = 272, IMG = 32 * SP;
__device__ __forceinline__ unsigned long long pack4(const f32x4 v) { return (unsigned long long)cvt_pk_bf16(v[0], v[1]) | ((unsigned long long)cvt_pk_bf16(v[2], v[3]) << 32); }

__device__ __forceinline__ void unit(const Ctx& c, int u, const bf16_t* qin, const bf16_t* att, const bf16_t* kstT, const bf16_t* vT, const float* decay, float* of, float* ob) {
    const int vs = u & 7, dir = (u >> 3) & 1, hh = (u >> 4) & 3, b = u >> 6;
    int tid_ = c.tid; asm volatile("" : "+v"(tid_));
    const int w = __builtin_amdgcn_readfirstlane(tid_ >> 6), lane = tid_ & 63, fr = lane & 15, fq = lane >> 4, ib = w >> 1, par = w & 1;
    LAS unsigned char* Sl = c.lds;
    const bf16_t* qd = qin + (size_t)dir * M * 512;
    float* outp = dir ? ob : of;
    for (int i = tid_; i < 2 * IMG / 4; i += NTHR) ((LAS unsigned*)Sl)[i] = 0u;
    f32x4 accS0 = {0.f, 0.f, 0.f, 0.f}, accS1 = {0.f, 0.f, 0.f, 0.f};
#define GLA_DECL(P) bf16x8 P##q0, P##q1, P##q2, P##q3, P##a0, P##a1, P##v00, P##v01, P##v10, P##v11, P##k0, P##k1; f32x4 P##d
#define GLA_LOAD(P, nstep) do { const int n_ = (nstep) < 64 ? (nstep) : 63; const int bc_ = b * 64 + (dir ? 63 - n_ : n_); const size_t rb_ = (size_t)bc_ * 64; \
    const bf16_t* qp_ = qd + (rb_ + ib * 16 + fr) * 512 + hh * 128 + 8 * fq; \
    P##q0 = *(const bf16x8*)(qp_); P##q1 = *(const bf16x8*)(qp_ + 32); P##q2 = *(const bf16x8*)(qp_ + 64); P##q3 = *(const bf16x8*)(qp_ + 96); \
    const bf16_t* ap_ = att + ((((size_t)dir * 256 + bc_) * 4 + hh) * 64 + ib * 16 + fr) * 64 + 8 * fq; \
    P##a0 = *(const bf16x8*)(ap_); P##a1 = *(const bf16x8*)(ap_ + 32); \
    const bf16_t* vp_ = vT + (((size_t)bc_ * 4 + hh) * 256 + vs * 32 + fr) * 64 + 8 * fq; \
    P##v00 = *(const bf16x8*)(vp_); P##v01 = *(const bf16x8*)(vp_ + 32); P##v10 = *(const bf16x8*)(vp_ + 16 * 64); P##v11 = *(const bf16x8*)(vp_ + 16 * 64 + 32); \
    const bf16_t* sp_ = kstT + ((((size_t)dir * 256 + bc_) * 4 + hh) * 128 + w * 16 + fr) * 64 + 8 * fq; \
    P##k0 = *(const bf16x8*)(sp_); P##k1 = *(const bf16x8*)(sp_ + 32); \
    P##d = *(const f32x4*)(decay + (((size_t)dir * 256 + bc_) * 4 + hh) * 128 + w * 16 + 4 * fq); } while (0)
#define GLA_STEP(P, nstep) do { const int n_ = (nstep); const int ch_ = dir ? 63 - n_ : n_; \
    const LAS unsigned char* rd_ = Sl + (n_ & 1) * IMG + (par * 16 + fr) * SP + (8 * fq) * 2; LAS unsigned char* wr_ = Sl + ((n_ + 1) & 1) * IMG + fr * SP + (w * 16 + 4 * fq) * 2; \
    f32x4 o_ = {0.f, 0.f, 0.f, 0.f}; \
    o_ = __builtin_amdgcn_mfma_f32_16x16x32_bf16(*(const LAS bf16x8*)(rd_), P##q0, o_, 0, 0, 0); o_ = __builtin_amdgcn_mfma_f32_16x16x32_bf16(*(const LAS bf16x8*)(rd_ + 64), P##q1, o_, 0, 0, 0); \
    o_ = __builtin_amdgcn_mfma_f32_16x16x32_bf16(*(const LAS bf16x8*)(rd_ + 128), P##q2, o_, 0, 0, 0); o_ = __builtin_amdgcn_mfma_f32_16x16x32_bf16(*(const LAS bf16x8*)(rd_ + 192), P##q3, o_, 0, 0, 0); \
    o_ = __builtin_amdgcn_mfma_f32_16x16x32_bf16(par ? P##v10 : P##v00, P##a0, o_, 0, 0, 0); o_ = __builtin_amdgcn_mfma_f32_16x16x32_bf16(par ? P##v11 : P##v01, P##a1, o_, 0, 0, 0); \
    *(f32x4*)(outp + ((size_t)(b * 64 + ch_) * 64 + ib * 16 + fr) * 1024 + hh * 256 + vs * 32 + par * 16 + 4 * fq) = o_; \
    accS0 = accS0 * P##d; accS1 = accS1 * P##d; \
    accS0 = __builtin_amdgcn_mfma_f32_16x16x32_bf16(P##k0, P##v00, accS0, 0, 0, 0); accS0 = __builtin_amdgcn_mfma_f32_16x16x32_bf16(P##k1, P##v01, accS0, 0, 0, 0); \
    accS1 = __builtin_amdgcn_mfma_f32_16x16x32_bf16(P##k0, P##v10, accS1, 0, 0, 0); accS1 = __builtin_amdgcn_mfma_f32_16x16x32_bf16(P##k1, P##v11, accS1, 0, 0, 0); \
    *(LAS unsigned long long*)(wr_) = pack4(accS0); *(LAS unsigned long long*)(wr_ + 16 * SP) = pack4(accS1); \
    WG_BAR(); } while (0)
    GLA_DECL(A); GLA_DECL(B); GLA_DECL(C);
    GLA_LOAD(A, 0); GLA_LOAD(B, 1);
    WG_BAR();
#pragma nounroll
    for (int n = 0; n < 63; n += 3) {
        GLA_LOAD(C, n + 2); GLA_STEP(A, n);
        GLA_LOAD(A, n + 3); GLA_STEP(B, n + 1);
        GLA_LOAD(B, n + 4); GLA_STEP(C, n + 2);
    }
    GLA_STEP(A, 63);
#undef GLA_DECL
#undef GLA_LOAD
#undef GLA_STEP
}
}
#ifndef MK_SPLIT
#define MK_SPLIT 0
#endif
constexpr int NPH_LAYER = 11, NPHASE = 1 + DEPTH * NPH_LAYER;
struct Args { const float* in[22]; float* out; unsigned char* ws; int ph_lo, ph_hi, li, pad; };

__global__ void __launch_bounds__(NTHR, 2) hybrid_fwd(Args args) {
    extern __shared__ __attribute__((aligned(16))) unsigned char lds_raw[];
    Ctx c; c.lds = (LAS unsigned char*)lds_raw; c.tid = threadIdx.x; c.lane = c.tid & 63; c.wave = __builtin_amdgcn_readfirstlane(c.tid >> 6);
    c.G = gridDim.x; { const int bx = blockIdx.x; c.vcu = (c.G % 8 == 0) ? (bx % 8) * (c.G / 8) + bx / 8 : bx; }
    unsigned char* ws = args.ws;
    gu32* ctl = (gu32*)(ws + WS_CTL);
    volatile LAS unsigned* MISC = (volatile LAS unsigned*)(c.lds + MISC_OFF);
    for (int u = c.tid; u < (LDS_BYTES - RING_BYTES) / 4; u += NTHR) ((LAS unsigned*)(c.lds + RING_BYTES))[u] = 0u;
    __syncthreads();
    const int lo = args.ph_lo, hi = args.ph_hi;
    XcdBarrier bar; bar.bar = (unsigned*)(ctl + CW_BAR) + args.li * XCD_BAR_WORDS; bar.x = 0; bar.st = nullptr;
    if (hi - lo > 1) bar = xcd_barrier_post((unsigned*)(ctl + CW_BAR) + args.li * XCD_BAR_WORDS, MISC + 8);
#ifndef PHASE_MASK
#define PHASE_MASK 0xFFF
#endif
#define PHM(j) (((PHASE_MASK) >> (j)) & 1)
#ifndef DUP_PHASE
#define DUP_PHASE (-1)
#endif
#ifndef DUP_SUB
#define DUP_SUB 3
#endif
#ifndef DUP_PAR
#define DUP_PAR 2
#endif
#define NREP(k) ((DUP_PHASE == (k) && (DUP_PAR == 2 || DUP_PAR == (layer & 1))) ? 2 : 1)
#define IN(k) (lo <= (k) && (k) < hi)
#define SEAM(k) do { if (hi > (k) + 1) xcd_barrier(bar); } while (0)

    f32x2* tabR = (f32x2*)(ws + WS_ROPER); f32x2* tabG = (f32x2*)(ws + WS_ROPEG);
    float* aff = (float*)(ws + WS_AFF); int* idx = (int*)(ws + WS_IDX); float* gate = (float*)(ws + WS_GATE); unsigned short* slotmap = (unsigned short*)(ws + WS_SLOT); float* decay = (float*)(ws + WS_DECAY);
    bf16_t* Win_t = (bf16_t*)(ws + WS_WIN); bf16_t* Wuq_t = (bf16_t*)(ws + WS_WUQ); bf16_t* Wukv_t = (bf16_t*)(ws + WS_WUKV); bf16_t* Wmo_t = (bf16_t*)(ws + WS_WMO);
    bf16_t* Wqkv_t = (bf16_t*)(ws + WS_WQKV); bf16_t* Wgo_t = (bf16_t*)(ws + WS_WGO); bf16_t* W13_t = (bf16_t*)(ws + WS_W13); bf16_t* W2_t = (bf16_t*)(ws + WS_W2);
    bf16_t* Xb = (bf16_t*)(ws + WS_XB); float* X1 = (float*)(ws + WS_X1); bf16_t* X1b = (bf16_t*)(ws + WS_X1B); bf16_t* H = (bf16_t*)(ws + WS_H);
    bf16_t* Qm = (bf16_t*)(ws + WS_QM); bf16_t* Km = (bf16_t*)(ws + WS_KM); bf16_t* Vm = (bf16_t*)(ws + WS_VM); bf16_t* Ocat = (bf16_t*)(ws + WS_OCAT);
    bf16_t* qin = (bf16_t*)(ws + WS_QIN); bf16_t* kin = (bf16_t*)(ws + WS_KIN); bf16_t* kstT = (bf16_t*)(ws + WS_KST); bf16_t* vT = (bf16_t*)(ws + WS_VT);
    float* of = (float*)(ws + WS_OF); float* ob = (float*)(ws + WS_OB); bf16_t* hdn = (bf16_t*)(ws + WS_HDN); bf16_t* Yb = (bf16_t*)(ws + WS_Y);
    float* X2 = args.out; float* Ypre = (float*)(ws + WS_OF);

    if (PHM(11) && IN(0)) for (int rep_ = 0; rep_ < ((DUP_PHASE == 11) ? 2 : 1); ++rep_) {
        fill_rope(c, tabR, tabG);
        cvt_rows_bf16(c, args.in[0], Xb);
        transpose_batch(c, args.in[15], W13_t, DM, FF, DEPTH * NEXP, (size_t)DM * FF, (size_t)2 * FF * DM, 2);
        transpose_batch(c, args.in[16], W13_t, DM, FF, DEPTH * NEXP, (size_t)DM * FF, (size_t)2 * FF * DM, 3);
        transpose_batch(c, args.in[17], W2_t, FF, DM, DEPTH * NEXP, (size_t)FF * DM, (size_t)DM * FF, 0);
        transpose_batch(c, args.in[1], Win_t, DM, 3936, 2, (size_t)DM * 3936, (size_t)4096 * DM, 1);
        transpose_batch(c, args.in[10], Wqkv_t, DM, 3072, 2, (size_t)DM * 3072, (size_t)3072 * DM, 0);
        transpose_batch(c, args.in[9], Wmo_t, DM, DM, 2, (size_t)DM * DM, (size_t)DM * DM, 0);
        transpose_batch(c, args.in[13], Wgo_t, DM, DM, 2, (size_t)DM * DM, (size_t)DM * DM, 0);
        transpose_batch(c, args.in[3], Wuq_t, 512, 1536, 2, (size_t)512 * 1536, (size_t)1536 * 512, 0);
        transpose_batch(c, args.in[5], Wukv_t, 256, 2048, 2, (size_t)256 * 2048, (size_t)2048 * 256, 0);
        { const long gt = (long)c.vcu * NTHR + c.tid, NT = (long)c.G * NTHR;
          for (long i = gt; i < 2L * 160 * DM / 8; i += NT) { const long l2 = i / (160 * DM / 8), rr = i % (160 * DM / 8); *(u32x4*)(Win_t + (size_t)l2 * 4096 * DM + (size_t)3936 * DM + rr * 8) = (u32x4){0u, 0u, 0u, 0u}; } }
        SEAM(0);
    }

    const Ctx c0 = c;
    for (int layer = 0; layer < DEPTH; ++layer) {
        const int pb = 1 + layer * NPH_LAYER, i2 = layer >> 1; const bool even = (layer & 1) == 0;
        const float* Xres = (layer == 0) ? args.in[0] : (const float*)X2;
        if (PHM(0) && IN(pb + 0)) _Pragma("nounroll") for (int rep_ = 0; rep_ < NREP(0); ++rep_) { const Ctx c = opaque_ctx(c0);
            const int N = even ? 4096 : 3072;
            pg8::Gemm g{Xb, even ? Win_t + (size_t)i2 * 4096 * DM : Wqkv_t + (size_t)i2 * 3072 * DM, DM, DM, DM, 0, 0, nullptr};
            pg8::StaticOrder S; S.init(M, N, c.G, (int)blockIdx.x);
            pg8::EpiStoreBf16 E{H, N};
            pg8::gemm_phase<pg8::EpiStoreBf16, false>(c.lds, g, S, E);
            SEAM(pb + 0);
        }
        if (PHM(1) && IN(pb + 1)) _Pragma("nounroll") for (int rep_ = 0; rep_ < NREP(1); ++rep_) { const Ctx c = opaque_ctx(c0);
            if (even) { if (rep_ == 0 || (DUP_SUB & 4)) mla_prep_rows(c, H, rep_ == 0 ? H : (bf16_t*)(ws + WS_HDN), Km, args.in[2] + i2 * 512, args.in[4] + i2 * 256, tabR);
                        if (rep_ == 0 || !(DUP_SUB & 4)) gla_prep(c, H, args.in[6] + (size_t)i2 * 2 * 16 * 512, args.in[7] + i2 * 2 * 512, qin, kin  , kstT, vT, decay); }
            else gqa_qknorm_rows(c, H, rep_ == 0 ? H : (bf16_t*)(ws + WS_HDN), args.in[11] + i2 * 128, args.in[12] + i2 * 128, tabG);
            SEAM(pb + 1);
        }
        if (PHM(2) && IN(pb + 2) && even) _Pragma("nounroll") for (int rep_ = 0; rep_ < NREP(2); ++rep_) { const Ctx c = opaque_ctx(c0);
#ifndef SUBM
#define SUBM 0x1F
#endif
            if (SUBM & 1) { pg8::Gemm g{H + C_CQ, Wuq_t + (size_t)i2 * 1536 * 512, HW, 512, 512, 0, 0, nullptr}; pg8::StaticOrder S; S.init(M, 1536, c.G, (int)blockIdx.x);
              pg8::EpiQRope E{Qm, tabR}; pg8::gemm_phase<pg8::EpiQRope, false>(c.lds, g, S, E); }
            if (SUBM & 2) { pg8::Gemm g{H + C_CKV, Wukv_t + (size_t)i2 * 2048 * 256, HW, 256, 256, 0, 0, nullptr}; pg8::StaticOrder S; S.init(M, 2048, c.G, (int)blockIdx.x);
              pg8::EpiKV E{Km, Vm}; pg8::gemm_phase<pg8::EpiKV, false>(c.lds, g, S, E); }
            SEAM(pb + 2);
        }
        if (PHM(3) && IN(pb + 3)) _Pragma("nounroll") for (int rep_ = 0; rep_ < NREP(3); ++rep_) { const Ctx c = opaque_ctx(c0);
            if (even) {
                if ((SUBM & 4) && (rep_ == 0 || (DUP_SUB & 1))) for (int u = c.vcu; u < 256; u += c.G) gla::unit(c, u, qin, kin  , kstT, vT, decay, of, ob);
                if ((SUBM & 8) && (rep_ == 0 || (DUP_SUB & 2))) for (int uid = c.vcu; uid < 512; uid += c.G) { const int b = uid >> 7, h = (uid >> 4) & 7, qb = uid & 15; const size_t r0 = (size_t)b * SEQ;
                    attn::attn_unit<192, 1536, 1536, 1024, 2048>(Qm + (r0 + qb * 256) * 1536 + h * 192, Km + r0 * 1536 + h * 192, Vm + r0 * 1024 + h * 128, Ocat + (r0 + qb * 256) * 2048 + h * 128, SEQ, (char*)lds_raw); }
            } else {
                if (SUBM & 16) for (int uid = c.vcu; uid < 1024; uid += c.G) { const int b = uid >> 8, kvh = (uid >> 6) & 3, gq = (uid >> 4) & 3, qb = uid & 15, h = kvh * 4 + gq; const size_t r0 = (size_t)b * SEQ;
                    attn::attn_unit<128, 3072, 3072, 3072, 2048>(H + (r0 + qb * 256) * 3072 + h * 128, H + r0 * 3072 + 2048 + kvh * 128, H + r0 * 3072 + 2560 + kvh * 128, Ocat + (r0 + qb * 256) * 2048 + h * 128, SEQ, (char*)lds_raw); }
            }
            SEAM(pb + 3);
        }
        if (PHM(4) && IN(pb + 4) && even) _Pragma("nounroll") for (int rep_ = 0; rep_ < NREP(4); ++rep_) { const Ctx c = opaque_ctx(c0); gla_out_rows(c, of, ob, H, args.in[8] + i2 * 1024, Ocat); SEAM(pb + 4); }
        if (PHM(5) && IN(pb + 5)) _Pragma("nounroll") for (int rep_ = 0; rep_ < NREP(5); ++rep_) { const Ctx c = opaque_ctx(c0);
            pg8::Gemm g{Ocat, even ? Wmo_t + (size_t)i2 * DM * DM : Wgo_t + (size_t)i2 * DM * DM, DM, DM, DM, 0, 0, nullptr};
            pg8::StaticOrder S; S.init(M, DM, c.G, (int)blockIdx.x);
            pg8::EpiResid E{Xres, Ypre, DN_ALPHA};
            pg8::gemm_phase<pg8::EpiResid, false>(c.lds, g, S, E);
            SEAM(pb + 5);
        }
        if (PHM(6) && IN(pb + 6)) _Pragma("nounroll") for (int rep_ = 0; rep_ < NREP(6); ++rep_) { const Ctx c = opaque_ctx(c0); ln_router_rows(c, Ypre, X1, X1b, args.in[18] + layer * DM, args.in[19] + layer * DM, args.in[14] + (size_t)layer * DM * NEXP, aff); SEAM(pb + 6); }
        if (PHM(7) && IN(pb + 7)) _Pragma("nounroll") for (int rep_ = 0; rep_ < NREP(7); ++rep_) { const Ctx c = opaque_ctx(c0); topk_units(c, aff, idx, gate, slotmap); SEAM(pb + 7); }
        if (PHM(8) && IN(pb + 8)) _Pragma("nounroll") for (int rep_ = 0; rep_ < NREP(8); ++rep_) { const Ctx c = opaque_ctx(c0);
            pg8::Gemm g{X1b, W13_t + (size_t)layer * NEXP * 2 * FF * DM, DM, DM, DM, 3, (size_t)2 * FF * DM, idx};
            pg8::StaticOrder S; S.init(MX, 2 * FF, c.G, (int)blockIdx.x);
            pg8::EpiSwiglu E{hdn};
            pg8::gemm_phase<pg8::EpiSwiglu, true>(c.lds, g, S, E);
            SEAM(pb + 8);
        }
        if (PHM(9) && IN(pb + 9)) _Pragma("nounroll") for (int rep_ = 0; rep_ < NREP(9); ++rep_) { const Ctx c = opaque_ctx(c0);
            pg8::Gemm g{hdn, W2_t + (size_t)layer * NEXP * DM * FF, FF, FF, FF, 3, (size_t)DM * FF, nullptr};
            pg8::StaticOrder S; S.init(MX, DM, c.G, (int)blockIdx.x);
            pg8::EpiGate E{Yb, gate};
            pg8::gemm_phase<pg8::EpiGate, false>(c.lds, g, S, E);
            SEAM(pb + 9);
        }
        if (PHM(10) && IN(pb + 10)) _Pragma("nounroll") for (int rep_ = 0; rep_ < NREP(10); ++rep_) { const Ctx c = opaque_ctx(c0); combine_ln_rows(c, X1, Yb, slotmap, args.in[20] + layer * DM, args.in[21] + layer * DM, X2, Xb); SEAM(pb + 10); }
    }
#undef IN
#undef SEAM
}

extern "C" void kernel_launch(void* const* d_in, const int* in_sizes, int n_in, void* d_out, int out_size, void* d_ws, size_t ws_size, hipStream_t stream) {
    static int grid = 0;
    if (grid == 0) {
        if (n_in != 22 || in_sizes[0] != M * DM || out_size != M * DM || ws_size < WS_END) { fprintf(stderr, "kernel_launch: unexpected shapes (n_in %d, in0 %d, out %d, ws %zu < %zu); nothing launched\n", n_in, n_in > 0 ? in_sizes[0] : -1, out_size, ws_size, (size_t)WS_END); grid = -1; return; }
        int dev = 0, cus = 0, per_cu = 0;
        if (hipGetDevice(&dev) != hipSuccess || hipDeviceGetAttribute(&cus, hipDeviceAttributeMultiprocessorCount, dev) != hipSuccess) { grid = -1; return; }
        if (hipFuncSetAttribute((const void*)hybrid_fwd, hipFuncAttributeMaxDynamicSharedMemorySize, LDS_BYTES) != hipSuccess) { fprintf(stderr, "kernel_launch: hipFuncSetAttribute failed\n"); grid = -1; return; }
        if (hipOccupancyMaxActiveBlocksPerMultiprocessor(&per_cu, (const void*)hybrid_fwd, NTHR, LDS_BYTES) != hipSuccess || per_cu < 1) fprintf(stderr, "kernel_launch: occupancy query reports %d\n", per_cu);
        (void)hipGetLastError();
        grid = cus;
    }
    if (grid < 0) return;
    if (hipMemsetAsync((char*)d_ws + WS_CTL, 0, CTL_ZERO_BYTES, stream) != hipSuccess) return;
    Args a{};
    for (int i = 0; i < 22; ++i) a.in[i] = (const float*)d_in[i];
    a.out = (float*)d_out; a.ws = (unsigned char*)d_ws; a.pad = 0;
#if MK_SPLIT
    for (int p = 0; p < NPHASE; ++p) {
        if (p > 0) { const int layer = (p - 1) / NPH_LAYER, k = (p - 1) % NPH_LAYER; if ((layer & 1) && (k == 2 || k == 4)) continue; }
        a.ph_lo = p; a.ph_hi = p + 1; a.li = 0;
        hipLaunchKernelGGL(hybrid_fwd, dim3(grid), dim3(NTHR), LDS_BYTES, stream, a);
    }
#elif defined(RELAUNCH_PHASE)
    a.ph_lo = 0; a.ph_hi = RELAUNCH_PHASE + 1; a.li = 0; hipLaunchKernelGGL(hybrid_fwd, dim3(grid), dim3(NTHR), LDS_BYTES, stream, a);
    a.ph_lo = RELAUNCH_PHASE; a.ph_hi = RELAUNCH_PHASE + 1; a.li = 1; hipLaunchKernelGGL(hybrid_fwd, dim3(grid), dim3(NTHR), LDS_BYTES, stream, a);
    a.ph_lo = RELAUNCH_PHASE + 1; a.ph_hi = NPHASE; a.li = 2; hipLaunchKernelGGL(hybrid_fwd, dim3(grid), dim3(NTHR), LDS_BYTES, stream, a);
#else
    a.ph_lo = 0; a.ph_hi = NPHASE; a.li = 0;
    hipLaunchKernelGGL(hybrid_fwd, dim3(grid), dim3(NTHR), LDS_BYTES, stream, a);
#endif
    const hipError_t le = hipPeekAtLastError();
    if (le != hipSuccess) fprintf(stderr, "kernel_launch: launch failed: %s\n", hipGetErrorName(le));
}
```

```cpp
#include <hip/hip_runtime.h>
#include <hip/hip_bf16.h>
#include <cstdio>
#include <cstdint>
#include <cmath>

#define GAS __attribute__((address_space(1)))
#define LAS __attribute__((address_space(3)))
typedef unsigned short bf16_t;
typedef short bf16x8 __attribute__((ext_vector_type(8)));
typedef short s16x4 __attribute__((ext_vector_type(4)));
typedef float f32x4 __attribute__((ext_vector_type(4)));
typedef float f32x2 __attribute__((ext_vector_type(2)));
typedef float f32x16 __attribute__((ext_vector_type(16)));
typedef unsigned u32x4 __attribute__((ext_vector_type(4)));
typedef unsigned u32x2 __attribute__((ext_vector_type(2)));
typedef GAS unsigned gu32;

__device__ __forceinline__ unsigned cvt_pk_bf16(float lo, float hi) { unsigned r; asm volatile("v_cvt_pk_bf16_f32 %0, %1, %2" : "=v"(r) : "v"(lo), "v"(hi)); return r; }
__device__ __forceinline__ float bf_lo(unsigned w) { return __uint_as_float(w << 16); }
__device__ __forceinline__ float bf_hi(unsigned w) { return __uint_as_float(w & 0xffff0000u); }
__device__ __forceinline__ float bf2f(bf16_t h) { return __uint_as_float(((unsigned)h) << 16); }
__device__ __forceinline__ bf16_t f2bf(float f) { return (bf16_t)(cvt_pk_bf16(f, 0.f) & 0xffffu); }

namespace pg8 {
constexpr int BM = 256, BK = 64, HALF = 128, HTB = HALF * BK * 2, STAGE_BYTES = 8 * HTB, NXCD = 8, WGM = 8;
__host__ __device__ __forceinline__ int lds_byte(int r, int c) { const int st = (r >> 4) * 2 + (c >> 5), rr = r & 15, cc = c & 31, ob = rr * 64 + cc * 2; return st * 1024 + (ob ^ (((ob >> 9) & 1) << 5)); }
__host__ __device__ __forceinline__ void stage_rc(int b, int& R, int& C) { const int st = b / 1024, sb = b % 1024, swz = sb ^ (((sb >> 9) & 1) << 5); R = (st >> 1) * 16 + swz / 64; C = (st & 1) * 32 + (swz % 64) / 2; }
__host__ __device__ __forceinline__ int perm32(int rho) { const int n = rho >> 4, i = rho & 15; return 8 * (i >> 2) + 4 * n + (i & 3); }

struct Unit { int pm, pn; };
struct Gemm { const bf16_t* A; const bf16_t* Bt; int lda, ldb, K, bshift; size_t bstride; const int* gather; };

struct StaticOrder {
    int nM, nN, nwg, G, c;
    __device__ void init(int M, int N, int G_, int c_) { nM = M / BM; nN = N / BM; nwg = nM * nN; G = G_; c = c_; }
    __device__ bool next(int i, Unit& u) const {
        const long L = (long)i * G + c; if (L >= nwg) return false;
        int wgid = (int)L; { const int q = nwg / NXCD, r = nwg % NXCD, xcd = wgid % NXCD, off = wgid / NXCD; wgid = (xcd < r ? xcd * (q + 1) : r * (q + 1) + (xcd - r) * q) + off; }
        const int nig = WGM * nN, gid = wgid / nig, fm = gid * WGM, gsz = (nM - fm) < WGM ? (nM - fm) : WGM;
        u.pm = fm + ((wgid % nig) % gsz); u.pn = (wgid % nig) / gsz; return true;
    }
};

template <class Epi, bool GATHER>
__device__ __forceinline__ void gemm_phase(LAS unsigned char* lds, const Gemm g, const StaticOrder& S, const Epi& E) {
    int tid_ = threadIdx.x; asm volatile("" : "+v"(tid_));
    const int tid = tid_, wid = __builtin_amdgcn_readfirstlane(tid >> 6), lane = tid & 63, wr = wid >> 2, wc = wid & 3, fr = lane & 15, fq = lane >> 4;
    const int K = g.K, nt = K / BK;
    unsigned voffA[2], voffB[2]; int RA[2], CA[2];
#pragma unroll
    for (int i = 0; i < 2; ++i) { int R, C; stage_rc(tid * 16 + i * 8192, R, C); const int Rb = Epi::PERM ? ((R & ~31) + perm32(R & 31)) : R;
        RA[i] = R; CA[i] = C; voffA[i] = (unsigned)(R * g.lda + C) * 2u; voffB[i] = (unsigned)(Rb * g.ldb + C) * 2u; }
    const size_t kstep = (size_t)(BK * 2);
    const size_t hstepA = (size_t)HALF * g.lda * 2, hstepB = (size_t)HALF * g.ldb * 2;
    const size_t tstepA = 2 * hstepA, tstepB = 2 * hstepB;
    const unsigned ldsw = (unsigned)wid * 1024u;
    const int aoff = lds_byte(wr * 64 + fr, fq * 8), boff = lds_byte(wc * 32 + fr, fq * 8);
#define PG8_SA(b, h) (((b) * 2 + (h)) * HTB)
#define PG8_SB(b, h) ((4 + (b) * 2 + (h)) * HTB)
#define PG8_STAGE(bufoff, gbase, voff) do { _Pragma("unroll") for (int _i = 0; _i < 2; ++_i) \
        __builtin_amdgcn_global_load_lds((const unsigned*)((const char*)(gbase) + (voff)[_i]), (LAS unsigned*)(lds + (bufoff) + ldsw + _i * 8192), 16, 0, 0); } while (0)
#define PG8_STAGE_A(bufoff, gptr, h, vg) do { if constexpr (GATHER) { PG8_STAGE(bufoff, gptr, vg[h]); } else { PG8_STAGE(bufoff, (gptr) + (h) * hstepA, voffA); } } while (0)
#define PG8_LDA(dst, b, h) do { _Pragma("unroll") for (int m = 0; m < 4; ++m) _Pragma("unroll") for (int k = 0; k < 2; ++k) dst[m][k] = *(const LAS bf16x8*)(lds + PG8_SA(b, h) + aoff + m * 2048 + k * 1024); } while (0)
#define PG8_LDB(dst, b, h) do { _Pragma("unroll") for (int n = 0; n < 2; ++n) _Pragma("unroll") for (int k = 0; k < 2; ++k) dst[n][k] = *(const LAS bf16x8*)(lds + PG8_SB(b, h) + boff + n * 2048 + k * 1024); } while (0)
#define PG8_MMA(ai, bj, At, Bt) do { __builtin_amdgcn_s_setprio(1); _Pragma("unroll") for (int m = 0; m < 4; ++m) _Pragma("unroll") for (int n = 0; n < 2; ++n) _Pragma("unroll") for (int k = 0; k < 2; ++k) \
        acc[ai][bj][m][n] = __builtin_amdgcn_mfma_f32_16x16x32_bf16(Bt[n][k], At[m][k], acc[ai][bj][m][n], 0, 0, 0); __builtin_amdgcn_s_setprio(0); } while (0)
#define PG8_WAIT_V(n) asm volatile("s_waitcnt vmcnt(" #n ")" ::: "memory")
#define PG8_WAIT_L(n) asm volatile("s_waitcnt lgkmcnt(" #n ")" ::: "memory")
#define PG8_BAR __builtin_amdgcn_s_barrier()
#define PG8_SCHED __builtin_amdgcn_sched_barrier(0)
    Unit cur, nxt; int ui = 0;
    if (!S.next(0, cur)) return;
    f32x4 acc[2][2][4][2];
#pragma unroll
    for (int a = 0; a < 2; ++a)
#pragma unroll
        for (int b = 0; b < 2; ++b)
#pragma unroll
            for (int m = 0; m < 4; ++m)
#pragma unroll
                for (int n = 0; n < 2; ++n) acc[a][b][m][n] = (f32x4){0.f, 0.f, 0.f, 0.f};
    bf16x8 At[4][2], B0[2][2], B1[2][2];
    unsigned vgc[2][2], vgn[2][2];
    if constexpr (GATHER) {
#pragma unroll
        for (int h = 0; h < 2; ++h)
#pragma unroll
            for (int i = 0; i < 2; ++i) { const int gr = g.gather[cur.pm * BM + h * HALF + RA[i]]; vgc[h][i] = (unsigned)(gr * g.lda + CA[i]) * 2u; vgn[h][i] = vgc[h][i]; }
    }
    const char* cA = GATHER ? (const char*)g.A : (const char*)g.A + (size_t)cur.pm * tstepA;
    const char* cB = (const char*)g.Bt + (size_t)(cur.pm >> g.bshift) * g.bstride * 2 + (size_t)cur.pn * tstepB;
    PG8_STAGE(PG8_SB(0, 0), cB, voffB); PG8_STAGE(PG8_SB(0, 1), cB + hstepB, voffB); PG8_STAGE_A(PG8_SA(0, 0), cA, 0, vgc); PG8_STAGE_A(PG8_SA(0, 1), cA, 1, vgc);
    if (wr == 1) PG8_BAR;
    PG8_WAIT_V(2); PG8_BAR;
    PG8_STAGE(PG8_SB(1, 0), cB + kstep, voffB); PG8_STAGE_A(PG8_SA(1, 0), cA + kstep, 0, vgc); PG8_STAGE(PG8_SB(1, 1), cB + hstepB + kstep, voffB);
    PG8_WAIT_V(6); PG8_BAR;
    for (;;) {
        const bool has_next = S.next(ui + 1, nxt);
        if constexpr (GATHER) {
            if (has_next) {
#pragma unroll
                for (int h = 0; h < 2; ++h)
#pragma unroll
                    for (int i = 0; i < 2; ++i) { const int gr = g.gather[nxt.pm * BM + h * HALF + RA[i]]; vgn[h][i] = (unsigned)(gr * g.lda + CA[i]) * 2u; }
            }
        }
        const char* nA = has_next ? (GATHER ? (const char*)g.A : (const char*)g.A + (size_t)nxt.pm * tstepA) : cA;
        const char* nB = has_next ? (const char*)g.Bt + (size_t)(nxt.pm >> g.bshift) * g.bstride * 2 + (size_t)nxt.pn * tstepB : cB;
#pragma nounroll
        for (int t = 0; t < nt; t += 2) {
            const bool last = (t == nt - 2);
            const char* a1 = cA + (size_t)(t + 1) * kstep;
            const char* a2 = last ? nA : cA + (size_t)(t + 2) * kstep; const char* b2 = last ? nB : cB + (size_t)(t + 2) * kstep;
            const char* a3 = a2 + kstep; const char* b3 = b2 + kstep;
            unsigned vg2[2][2];
            if constexpr (GATHER) {
#pragma unroll
                for (int h = 0; h < 2; ++h)
#pragma unroll
                    for (int i = 0; i < 2; ++i) vg2[h][i] = (last && has_next) ? vgn[h][i] : vgc[h][i];
            }
            PG8_LDB(B0, 0, 0); PG8_LDB(B1, 0, 1); PG8_SCHED; PG8_LDA(At, 0, 0); PG8_STAGE_A(PG8_SA(1, 1), a1, 1, vgc);
            PG8_WAIT_V(8); PG8_WAIT_L(0); PG8_BAR; PG8_MMA(0, 0, At, B0); PG8_MMA(0, 1, At, B1); PG8_BAR; PG8_SCHED;
            PG8_LDA(At, 0, 1); PG8_STAGE(PG8_SB(0, 0), b2, voffB); PG8_STAGE(PG8_SB(0, 1), b2 + hstepB, voffB); PG8_STAGE_A(PG8_SA(0, 0), a2, 0, vg2);
            PG8_WAIT_V(8); PG8_WAIT_L(0); PG8_BAR; PG8_MMA(1, 0, At, B0); PG8_MMA(1, 1, At, B1); PG8_BAR; PG8_SCHED;
            PG8_LDB(B0, 1, 0); PG8_LDB(B1, 1, 1); PG8_SCHED; PG8_LDA(At, 1, 0); PG8_STAGE_A(PG8_SA(0, 1), a2, 1, vg2);
            PG8_WAIT_V(8); PG8_WAIT_L(0); PG8_BAR; PG8_MMA(0, 0, At, B0); PG8_MMA(0, 1, At, B1); PG8_BAR; PG8_SCHED;
            PG8_LDA(At, 1, 1); PG8_STAGE(PG8_SB(1, 0), b3, voffB); PG8_STAGE(PG8_SB(1, 1), b3 + hstepB, voffB); PG8_STAGE_A(PG8_SA(1, 0), a3, 0, vg2);
            PG8_WAIT_V(8); PG8_WAIT_L(0); PG8_BAR; PG8_MMA(1, 0, At, B0); PG8_MMA(1, 1, At, B1); PG8_BAR; PG8_SCHED;
        }
        if (wr == 0) PG8_BAR;
        E(acc, cur, wr, wc, fr, fq);
        if (!has_next) break;
#pragma unroll
        for (int a = 0; a < 2; ++a)
#pragma unroll
            for (int b = 0; b < 2; ++b)
#pragma unroll
                for (int m = 0; m < 4; ++m)
#pragma unroll
                    for (int n = 0; n < 2; ++n) acc[a][b][m][n] = (f32x4){0.f, 0.f, 0.f, 0.f};
        cur = nxt; cA = nA; cB = nB; ++ui;
        if constexpr (GATHER) {
#pragma unroll
            for (int h = 0; h < 2; ++h)
#pragma unroll
                for (int i = 0; i < 2; ++i) vgc[h][i] = vgn[h][i];
        }
        if (wr == 1) PG8_BAR;
    }
    PG8_WAIT_V(0);
    PG8_BAR;
#undef PG8_SA
#undef PG8_SB
#undef PG8_STAGE
#undef PG8_STAGE_A
#undef PG8_LDA
#undef PG8_LDB
#undef PG8_MMA
#undef PG8_WAIT_V
#undef PG8_WAIT_L
#undef PG8_BAR
#undef PG8_SCHED
}
}
namespace pg8 {
struct EpiStoreBf16 {
    static constexpr bool PERM = true;
    bf16_t* O; int ldc;
    __device__ __forceinline__ void operator()(const f32x4 (&acc)[2][2][4][2], const Unit& u, int wr, int wc, int fr, int fq) const {
        const int row0 = u.pm * BM + wr * 64 + fr, col0 = u.pn * BM + wc * 32 + 8 * fq;
#pragma unroll
        for (int ai = 0; ai < 2; ++ai)
#pragma unroll
            for (int m = 0; m < 4; ++m) { bf16_t* rowp = O + (size_t)(row0 + ai * HALF + m * 16) * ldc + col0;
#pragma unroll
                for (int bj = 0; bj < 2; ++bj) { const f32x4 v0 = acc[ai][bj][m][0], v1 = acc[ai][bj][m][1];
                    u32x4 w; w.x = cvt_pk_bf16(v0[0], v0[1]); w.y = cvt_pk_bf16(v0[2], v0[3]); w.z = cvt_pk_bf16(v1[0], v1[1]); w.w = cvt_pk_bf16(v1[2], v1[3]);
                    *(u32x4*)(rowp + bj * HALF) = w; } }
    }
};
struct EpiQRope {
    static constexpr bool PERM = true;
    bf16_t* O; const f32x2* tab;
    __device__ __forceinline__ void operator()(const f32x4 (&acc)[2][2][4][2], const Unit& u, int wr, int wc, int fr, int fq) const {
        const int row0 = u.pm * BM + wr * 64 + fr, col0 = u.pn * BM + wc * 32 + 8 * fq;
#pragma unroll
        for (int bj = 0; bj < 2; ++bj) {
            const int col = col0 + bj * HALF, within = col % 192;
            const bool pe = within >= 128; const int p0 = (within - 128) >> 1;
#pragma unroll
            for (int ai = 0; ai < 2; ++ai)
#pragma unroll
                for (int m = 0; m < 4; ++m) { const int row = row0 + ai * HALF + m * 16;
                    f32x4 v0 = acc[ai][bj][m][0], v1 = acc[ai][bj][m][1];
                    if (pe) { const f32x2* tp = tab + (size_t)(row & 4095) * 32 + p0; const f32x4 t01 = *(const f32x4*)tp, t23 = *(const f32x4*)(tp + 2);
                        const f32x4 a = v0, b = v1;
                        v0[0] = a[0] * t01[0] - a[1] * t01[1]; v0[1] = a[0] * t01[1] + a[1] * t01[0]; v0[2] = a[2] * t01[2] - a[3] * t01[3]; v0[3] = a[2] * t01[3] + a[3] * t01[2];
                        v1[0] = b[0] * t23[0] - b[1] * t23[1]; v1[1] = b[0] * t23[1] + b[1] * t23[0]; v1[2] = b[2] * t23[2] - b[3] * t23[3]; v1[3] = b[2] * t23[3] + b[3] * t23[2]; }
                    u32x4 w; w.x = cvt_pk_bf16(v0[0], v0[1]); w.y = cvt_pk_bf16(v0[2], v0[3]); w.z = cvt_pk_bf16(v1[0], v1[1]); w.w = cvt_pk_bf16(v1[2], v1[3]);
                    *(u32x4*)(O + (size_t)row * 1536 + col) = w; asm volatile("" ::: "memory"); }
        }
    }
};
struct EpiKV {
    static constexpr bool PERM = true;
    bf16_t* Km; bf16_t* Vm;
    __device__ __forceinline__ void operator()(const f32x4 (&acc)[2][2][4][2], const Unit& u, int wr, int wc, int fr, int fq) const {
        const int row0 = u.pm * BM + wr * 64 + fr, c = wc * 32 + 8 * fq;
#pragma unroll
        for (int ai = 0; ai < 2; ++ai)
#pragma unroll
            for (int m = 0; m < 4; ++m) { const size_t row = (size_t)(row0 + ai * HALF + m * 16);
#pragma unroll
                for (int bj = 0; bj < 2; ++bj) { const f32x4 v0 = acc[ai][bj][m][0], v1 = acc[ai][bj][m][1];
                    u32x4 w; w.x = cvt_pk_bf16(v0[0], v0[1]); w.y = cvt_pk_bf16(v0[2], v0[3]); w.z = cvt_pk_bf16(v1[0], v1[1]); w.w = cvt_pk_bf16(v1[2], v1[3]);
                    if (bj == 0) *(u32x4*)(Km + row * 1536 + u.pn * 192 + c) = w; else *(u32x4*)(Vm + row * 1024 + u.pn * 128 + c) = w; }
                asm volatile("" ::: "memory"); }
    }
};
struct EpiResid {
    static constexpr bool PERM = false;
    const float* X; float* Y; float alpha;
    __device__ __forceinline__ void operator()(const f32x4 (&acc)[2][2][4][2], const Unit& u, int wr, int wc, int fr, int fq) const {
        const int row0 = u.pm * BM + wr * 64 + fr, col0 = u.pn * BM + wc * 32 + 4 * fq;
#pragma unroll
        for (int ai = 0; ai < 2; ++ai)
#pragma unroll
            for (int m = 0; m < 4; ++m) { const size_t off = (size_t)(row0 + ai * HALF + m * 16) * 2048 + col0;
#pragma unroll
                for (int bj = 0; bj < 2; ++bj)
#pragma unroll
                    for (int n = 0; n < 2; ++n) { const f32x4 xv = *(const f32x4*)(X + off + bj * HALF + n * 16); *(f32x4*)(Y + off + bj * HALF + n * 16) = xv * alpha + acc[ai][bj][m][n]; }
                if (m & 1) asm volatile("" ::: "memory"); }
    }
};
struct EpiSwiglu {
    static constexpr bool PERM = true;
    bf16_t* O;
    __device__ __forceinline__ void operator()(const f32x4 (&acc)[2][2][4][2], const Unit& u, int wr, int wc, int fr, int fq) const {
        const int row0 = u.pm * BM + wr * 64 + fr, col0 = u.pn * HALF + wc * 32 + 8 * fq;
#pragma unroll
        for (int ai = 0; ai < 2; ++ai)
#pragma unroll
            for (int m = 0; m < 4; ++m) { float h[8];
#pragma unroll
                for (int n = 0; n < 2; ++n)
#pragma unroll
                    for (int j = 0; j < 4; ++j) { const float a = acc[ai][0][m][n][j], b = acc[ai][1][m][n][j]; h[n * 4 + j] = a * __builtin_amdgcn_rcpf(1.f + __expf(-a)) * b; }
                u32x4 w; w.x = cvt_pk_bf16(h[0], h[1]); w.y = cvt_pk_bf16(h[2], h[3]); w.z = cvt_pk_bf16(h[4], h[5]); w.w = cvt_pk_bf16(h[6], h[7]);
                *(u32x4*)(O + (size_t)(row0 + ai * HALF + m * 16) * 1536 + col0) = w; }
    }
};
struct EpiGate {
    static constexpr bool PERM = true;
    bf16_t* O; const float* gate;
    __device__ __forceinline__ void operator()(const f32x4 (&acc)[2][2][4][2], const Unit& u, int wr, int wc, int fr, int fq) const {
        const int row0 = u.pm * BM + wr * 64 + fr, col0 = u.pn * BM + wc * 32 + 8 * fq;
#pragma unroll
        for (int ai = 0; ai < 2; ++ai)
#pragma unroll
            for (int m = 0; m < 4; ++m) { const int row = row0 + ai * HALF + m * 16; const float gt = gate[row]; bf16_t* rowp = O + (size_t)row * 2048 + col0;
#pragma unroll
                for (int bj = 0; bj < 2; ++bj) { const f32x4 v0 = acc[ai][bj][m][0] * gt, v1 = acc[ai][bj][m][1] * gt;
                    u32x4 w; w.x = cvt_pk_bf16(v0[0], v0[1]); w.y = cvt_pk_bf16(v0[2], v0[3]); w.z = cvt_pk_bf16(v1[0], v1[1]); w.w = cvt_pk_bf16(v1[2], v1[3]);
                    *(u32x4*)(rowp + bj * HALF) = w; } }
    }
};
}
namespace attn {
constexpr int NW = 8, QBLK = 32, KVBLK = 64, DV = 128;
#define SBAR() __builtin_amdgcn_sched_barrier(0)
__device__ __forceinline__ int crow(int r, int hi) { return (r & 3) + 8 * (r >> 2) + 4 * hi; }
template <int DQK> __device__ __forceinline__ int kswz(int row, int colB) {
    if constexpr (DQK == 128) return row * 256 + (colB ^ ((row & 15) << 4));
    else return row * (DQK * 2) + (colB ^ (((row >> 1) & 7) << 4));
}
template <int DQK> struct Shm { static constexpr int V = KVBLK * DV * 2, K = KVBLK * DQK * 2, TOTAL = 3 * V + 3 * K + NW * 64 * 4; };

template <float const& CREF> struct Dummy {};
__device__ __forceinline__ void partialSM(f32x16& p0, f32x16& p1, float& m_reg, float& mn, float& alpha, const float C, const float thr) {
  float pmax = p0[0];
#pragma unroll
  for (int r = 1; r < 16; ++r) pmax = fmaxf(pmax, p0[r]);
#pragma unroll
  for (int r = 0; r < 16; ++r) pmax = fmaxf(pmax, p1[r]);
  { auto rr = __builtin_amdgcn_permlane32_swap(__float_as_uint(pmax), __float_as_uint(pmax), false, false);
    pmax = fmaxf(__uint_as_float(rr[0]), __uint_as_float(rr[1])); }
  if (__builtin_expect(__all(pmax - m_reg <= thr), 1)) { mn = m_reg; alpha = 1.f; }
  else { mn = fmaxf(m_reg, pmax); alpha = __builtin_amdgcn_exp2f((m_reg - mn) * C); m_reg = mn; }
  float mnC = -mn * C;
#pragma unroll
  for (int r = 0; r < 16; ++r) p0[r] = fmaf(p0[r], C, mnC);
#pragma unroll
  for (int r = 0; r < 16; ++r) p1[r] = fmaf(p1[r], C, mnC);
#pragma unroll
  for (int r = 0; r < 16; ++r) p0[r] = __builtin_amdgcn_exp2f(p0[r]);
}
__device__ __forceinline__ void finishSM(f32x16& p0, f32x16& p1, float alpha, float& l_reg, bf16x8& pa0, bf16x8& pa1, bf16x8& pa2, bf16x8& pa3) {
#pragma unroll
  for (int r = 0; r < 16; ++r) p1[r] = __builtin_amdgcn_exp2f(p1[r]);
  float ps = 0;
#pragma unroll
  for (int r = 0; r < 16; ++r) ps += p0[r];
#pragma unroll
  for (int r = 0; r < 16; ++r) ps += p1[r];
  { auto rr = __builtin_amdgcn_permlane32_swap(__float_as_uint(ps), __float_as_uint(ps), false, false);
    ps = __uint_as_float(rr[0]) + __uint_as_float(rr[1]); }
  l_reg = l_reg * alpha + ps;
#define PK4(P, BASE, OUT) do { unsigned a0 = cvt_pk_bf16(P[BASE + 0], P[BASE + 1]), a1 = cvt_pk_bf16(P[BASE + 2], P[BASE + 3]);   \
    unsigned b0 = cvt_pk_bf16(P[BASE + 4], P[BASE + 5]), b1 = cvt_pk_bf16(P[BASE + 6], P[BASE + 7]);                              \
    auto r0 = __builtin_amdgcn_permlane32_swap(a0, b0, false, false); auto r1 = __builtin_amdgcn_permlane32_swap(a1, b1, false, false); \
    u32x4 w = {r0[0], r1[0], r0[1], r1[1]}; OUT = *reinterpret_cast<bf16x8*>(&w); } while (0)
  PK4(p0, 0, pa0); PK4(p0, 8, pa1); PK4(p1, 0, pa2); PK4(p1, 8, pa3);
#undef PK4
}
template <int DQK>
__device__ __forceinline__ void qkt(f32x16& p0, f32x16& p1, const char* Ks, const bf16x8* qr, int r32, int hi) {
  p0 = f32x16{}; p1 = f32x16{};
#pragma unroll
  for (int d0 = 0; d0 < DQK / 16; ++d0) { int cb = (d0 * 16 + hi * 8) * 2;
    bf16x8 b0 = *reinterpret_cast<const bf16x8*>(Ks + kswz<DQK>(r32, cb));
    bf16x8 b1 = *reinterpret_cast<const bf16x8*>(Ks + kswz<DQK>(32 + r32, cb));
    p0 = __builtin_amdgcn_mfma_f32_32x32x16_bf16(b0, qr[d0], p0, 0, 0, 0);
    p1 = __builtin_amdgcn_mfma_f32_32x32x16_bf16(b1, qr[d0], p1, 0, 0, 0); }
}
__device__ __forceinline__ int v_st(int k, int c) { const int kk = (k & ~0xC) | ((k & 4) << 1) | ((k & 8) >> 1); return ((kk >> 3) * 4 + (c >> 5)) * 512 + ((kk & 7) * 32 + (c & 31)) * 2; }
__device__ __forceinline__ int v_rd_base(int lane) { return ((lane & 3) << 3) | (((lane >> 2) & 3) << 6) | (((lane >> 4) & 1) << 5) | (((lane >> 5) & 1) << 8); }
constexpr int v_rd_off(int d0, int ks, int half) { return d0 * 512 + ks * 4096 + half * 2048; }
template <int OFF> __device__ __forceinline__ s16x4 tr_read(int vb) {
  s16x4 r; asm volatile("ds_read_b64_tr_b16 %0, %1 offset:%2" : "=&v"(r) : "v"(vb), "i"(OFF) : "memory"); return r;
}
template <int D0> __device__ __forceinline__ void pv_one(f32x16& od, int vb, bf16x8 pa0, bf16x8 pa1, bf16x8 pa2, bf16x8 pa3) {
  const s16x4 l0 = tr_read<v_rd_off(D0, 0, 0)>(vb), h0 = tr_read<v_rd_off(D0, 0, 1)>(vb), l1 = tr_read<v_rd_off(D0, 1, 0)>(vb), h1 = tr_read<v_rd_off(D0, 1, 1)>(vb);
  const s16x4 l2 = tr_read<v_rd_off(D0, 2, 0)>(vb), h2 = tr_read<v_rd_off(D0, 2, 1)>(vb), l3 = tr_read<v_rd_off(D0, 3, 0)>(vb), h3 = tr_read<v_rd_off(D0, 3, 1)>(vb);
  asm volatile("s_waitcnt lgkmcnt(0)" ::: "memory"); SBAR();
#define PK(L, H) (bf16x8){L[0], L[1], L[2], L[3], H[0], H[1], H[2], H[3]}
  od = __builtin_amdgcn_mfma_f32_32x32x16_bf16(pa0, PK(l0, h0), od, 0, 0, 0);
  od = __builtin_amdgcn_mfma_f32_32x32x16_bf16(pa1, PK(l1, h1), od, 0, 0, 0);
  od = __builtin_amdgcn_mfma_f32_32x32x16_bf16(pa2, PK(l2, h2), od, 0, 0, 0);
  od = __builtin_amdgcn_mfma_f32_32x32x16_bf16(pa3, PK(l3, h3), od, 0, 0, 0);
#undef PK
}
__device__ __forceinline__ void pv_d0(f32x16* o, int vb, bf16x8 pa0, bf16x8 pa1, bf16x8 pa2, bf16x8 pa3) {
  pv_one<0>(o[0], vb, pa0, pa1, pa2, pa3); pv_one<1>(o[1], vb, pa0, pa1, pa2, pa3); pv_one<2>(o[2], vb, pa0, pa1, pa2, pa3); pv_one<3>(o[3], vb, pa0, pa1, pa2, pa3);
}

__device__ __forceinline__ void glds16(const void* gsrc, unsigned lds_dst) { unsigned keep;
  asm volatile("s_mov_b32 %0, m0\n\ts_mov_b32 m0, %2\n\ts_nop 0\n\tglobal_load_lds_dwordx4 %1, off\n\ts_mov_b32 m0, %0" : "=&s"(keep) : "v"(gsrc), "s"(lds_dst) : "memory"); }
#define ATT_WAIT_BAR(N) asm volatile("s_waitcnt vmcnt(" #N ") lgkmcnt(0)\n\ts_barrier" ::: "memory")
__device__ __forceinline__ int nx3(int s) { return s == 2 ? 0 : s + 1; }
template <int DQK, int LDQ, int LDK, int LDV, int LDO>
__device__ __forceinline__ void attn_unit(const bf16_t* __restrict__ Qb, const bf16_t* __restrict__ Kh, const bf16_t* __restrict__ Vh, bf16_t* __restrict__ Ob, int seq, char* lds) {
  constexpr float scale = (DQK == 128) ? 0.08838834764831845f : 0.07216878364870323f;
  constexpr int SHM_V = KVBLK * DV * 2, SHM_K = KVBLK * DQK * 2, NQ = DQK / 16, NKP = SHM_K / 8192;
  constexpr int KRING = 0, VRING = 3 * SHM_K, WSOFF = 3 * SHM_K + 3 * SHM_V;
  constexpr float C = scale * 1.4426950408889634f, thr = 8.f / scale;
  int tid_ = threadIdx.x; asm volatile("" : "+v"(tid_));
  const int tid = tid_, lane = tid & 63, r32 = lane & 31, hi = lane >> 5; const int wid = __builtin_amdgcn_readfirstlane(tid >> 6);
  const unsigned lds0 = (unsigned)(uintptr_t)lds;
  float* ws = (float*)(lds + WSOFF) + wid * 64; float* li_l = ws; float* al_l = ws + 32;
  float m_reg = -1e30f, l_reg = 0; f32x16 o[4] = {}; bf16x8 qr[NQ];
  const bf16_t* Qw = Qb + (long)(wid * QBLK + r32) * LDQ + hi * 8;
#pragma unroll
  for (int d0 = 0; d0 < NQ; ++d0) qr[d0] = *reinterpret_cast<const bf16x8*>(Qw + d0 * 16);
  int koff[NKP], voff[2];
#pragma unroll
  for (int p = 0; p < NKP; ++p) { const int P = (p * 8 + wid) * 1024 + lane * 16, row = P / (DQK * 2), cs = P % (DQK * 2);
    const int colB = (DQK == 128) ? (cs ^ ((row & 15) << 4)) : (cs ^ (((row >> 1) & 7) << 4)); koff[p] = row * LDK + (colB >> 1); }
#pragma unroll
  for (int p = 0; p < 2; ++p) { const int P = (p * 8 + wid) * 1024 + lane * 16, sub = P >> 9, w5 = P & 511, kk = (sub >> 2) * 8 + (w5 >> 6), c = (sub & 3) * 32 + ((w5 & 63) >> 1);
    const int k = (kk & ~0xC) | ((kk & 4) << 1) | ((kk & 8) >> 1); voff[p] = k * LDV + c; }
#define DMA_K(t, slot) do { _Pragma("unroll") for (int p = 0; p < NKP; ++p) glds16(Kh + (long)(t) * KVBLK * LDK + koff[p], (unsigned)__builtin_amdgcn_readfirstlane((int)(lds0 + KRING + (slot) * SHM_K + (p * 8 + wid) * 1024))); } while (0)
#define DMA_V(t, slot) do { _Pragma("unroll") for (int p = 0; p < 2; ++p) glds16(Vh + (long)(t) * KVBLK * LDV + voff[p], (unsigned)__builtin_amdgcn_readfirstlane((int)(lds0 + VRING + (slot) * SHM_V + (p * 8 + wid) * 1024))); } while (0)
#define RESC(a) do { if (__any((a) < 1.f)) { if (hi == 0) al_l[r32] = (a); asm volatile("s_waitcnt lgkmcnt(0)" ::: "memory"); \
    _Pragma("unroll") for (int d = 0; d < 4; ++d) _Pragma("unroll") for (int r = 0; r < 16; ++r) o[d][r] *= al_l[crow(r, hi)]; } } while (0)
#define CLOSE(t) do { if ((t) + 2 < NT) { if constexpr (NKP == 2) ATT_WAIT_BAR(4); else ATT_WAIT_BAR(5); } else ATT_WAIT_BAR(0); } while (0)
  const int vb0 = (int)(lds0 + VRING) + v_rd_base(lane);
  const char* Kr = lds + KRING;
  f32x16 pA0, pA1, pB0, pB1; float mnA, mnB, alA, alB; bf16x8 pa0, pa1, pa2, pa3; const int NT = seq / KVBLK;
  DMA_K(0, 0); DMA_V(0, 0); DMA_K(1, 1);
  if constexpr (NKP == 2) ATT_WAIT_BAR(2); else ATT_WAIT_BAR(3);
  DMA_K(2, 2); DMA_V(1, 1);
  qkt<DQK>(pA0, pA1, Kr, qr, r32, hi); partialSM(pA0, pA1, m_reg, mnA, alA, C, thr);
  CLOSE(0);
  int sk = 1;
  for (int j = 1; j + 1 < NT; j += 2) {
    { const int s1 = nx3(sk), s2 = nx3(s1);
      if (j + 2 < NT) DMA_K(j + 2, s2); DMA_V(j + 1, s1);
      SBAR(); qkt<DQK>(pB0, pB1, Kr + sk * SHM_K, qr, r32, hi);
      finishSM(pA0, pA1, alA, l_reg, pa0, pa1, pa2, pa3); SBAR();
      pv_d0(o, vb0 + s2 * SHM_V, pa0, pa1, pa2, pa3); partialSM(pB0, pB1, m_reg, mnB, alB, C, thr);
      RESC(alB); CLOSE(j); sk = s1; }
    { const int s1 = nx3(sk), s2 = nx3(s1);
      if (j + 3 < NT) DMA_K(j + 3, s2); if (j + 2 < NT) DMA_V(j + 2, s1);
      SBAR(); qkt<DQK>(pA0, pA1, Kr + sk * SHM_K, qr, r32, hi);
      finishSM(pB0, pB1, alB, l_reg, pa0, pa1, pa2, pa3); SBAR();
      pv_d0(o, vb0 + s2 * SHM_V, pa0, pa1, pa2, pa3); partialSM(pA0, pA1, m_reg, mnA, alA, C, thr);
      RESC(alA); CLOSE(j + 1); sk = s1; }
  }
  { const int s1 = nx3(sk), s2 = nx3(s1);
    SBAR(); qkt<DQK>(pB0, pB1, Kr + sk * SHM_K, qr, r32, hi);
    finishSM(pA0, pA1, alA, l_reg, pa0, pa1, pa2, pa3); SBAR();
    pv_d0(o, vb0 + s2 * SHM_V, pa0, pa1, pa2, pa3); partialSM(pB0, pB1, m_reg, mnB, alB, C, thr);
    RESC(alB);
    finishSM(pB0, pB1, alB, l_reg, pa0, pa1, pa2, pa3); SBAR();
    pv_d0(o, vb0 + sk * SHM_V, pa0, pa1, pa2, pa3); (void)s1; }
  if (hi == 0) li_l[r32] = l_reg; asm volatile("s_waitcnt lgkmcnt(0)" ::: "memory");
  float rli[16];
#pragma unroll
  for (int r = 0; r < 16; ++r) rli[r] = __builtin_amdgcn_rcpf(li_l[crow(r, hi)]);
  bf16_t* Ow = Ob + (long)(wid * QBLK) * LDO;
#pragma unroll
  for (int r = 0; r < 16; ++r) { int orow = crow(r, hi);
#pragma unroll
    for (int d0 = 0; d0 < 4; ++d0) Ow[(long)orow * LDO + d0 * 32 + r32] = f2bf(o[d0][r] * rli[r]); }
  ATT_WAIT_BAR(0);
#undef DMA_K
#undef DMA_V
#undef RESC
#undef CLOSE
}
}
constexpr int BATCH = 4, SEQ = 4096, DM = 2048, M = BATCH * SEQ, DEPTH = 4;
constexpr int NEXP = 16, FF = 1536, CAP = 512, MX = NEXP * BATCH * CAP;
constexpr int HW = 4096;
constexpr int C_CQ = 0, C_CKV = 512, C_GQ = 768, C_GK = 1280, C_GV = 1792, C_GR = 2816, C_KR = 3840, C_LAT = 3904;
constexpr float LN_EPS = 1e-5f, RMS_EPS = 1e-6f;
constexpr float DN_ALPHA = 1.681792830507429f;
constexpr float MLA_SCALE = 0.07216878364870323f;
constexpr float GQA_SCALE = 0.08838834764831845f;

constexpr size_t MiB = 1u << 20;
constexpr size_t WS_CTL = 0, CTL_ZERO_BYTES = 1 * MiB;
constexpr size_t WS_ROPER = 1 * MiB, WS_ROPEG = 2 * MiB, WS_AFF = 4 * MiB, WS_IDX = 5 * MiB, WS_GATE = 5 * MiB + 512 * 1024, WS_SLOT = 6 * MiB, WS_DECAY = 7 * MiB;
constexpr size_t WS_WIN = 8 * MiB, WS_WUQ = 40 * MiB, WS_WUKV = 43 * MiB, WS_WMO = 48 * MiB, WS_WQKV = 64 * MiB, WS_WGO = 88 * MiB, WS_W13 = 104 * MiB, WS_W2 = 872 * MiB;
constexpr size_t WS_XB = 1256 * MiB, WS_X1 = 1320 * MiB, WS_X1B = 1448 * MiB, WS_H = 1512 * MiB, WS_QM = 1640 * MiB, WS_KM = 1688 * MiB, WS_VM = 1736 * MiB, WS_OCAT = 1768 * MiB;
constexpr size_t WS_QIN = 1832 * MiB, WS_KIN = 1864 * MiB, WS_KST = 1896 * MiB, WS_VT = 1928 * MiB, WS_OF = 1960 * MiB, WS_OB = 2024 * MiB, WS_HDN = 2088 * MiB, WS_Y = 2184 * MiB, WS_END = 2312 * MiB;
constexpr int CW_TMO = 0, CW_DBG = 2, CW_BAR = 4096;

constexpr int RING_BYTES = 131072, MISC_OFF = RING_BYTES + 320, LDS_BYTES = 147456;
constexpr int NWAVES = 8, NTHR = 512;

#define RLX_AGENT __ATOMIC_RELAXED, __HIP_MEMORY_SCOPE_AGENT
#define LDS_WAIT() asm volatile("s_waitcnt lgkmcnt(0)" ::: "memory")
#define VM_WAIT() asm volatile("s_waitcnt vmcnt(0)" ::: "memory")

#define XB_TMO      128
#define XB_XCNT(j)  (256  + 64 * (j))
#define XB_XSUB(j)  (1280 + 64 * (j))
#define XB_XGEN(j)  (2304 + 64 * (j))
#define XB_TOP      3328
#define XB_TOPGEN   3392
#define XCD_BAR_WORDS 3456
#define XB_SPIN_CAP (1u << 22)
__device__ __forceinline__ unsigned xb_ld(unsigned* p)              { return __hip_atomic_load(p, __ATOMIC_RELAXED, __HIP_MEMORY_SCOPE_AGENT); }
__device__ __forceinline__ unsigned xb_add(unsigned* p, unsigned v) { return __hip_atomic_fetch_add(p, v, __ATOMIC_RELAXED, __HIP_MEMORY_SCOPE_AGENT); }
__device__ __forceinline__ unsigned xb_xcc_id() { return (unsigned)__builtin_amdgcn_s_getreg((3 << 11) | 20) & 0xFu; }
#define XB_SPIN(cond, bar) do { unsigned _sp = 0; while (cond) { __builtin_amdgcn_s_sleep(1); \
    if ((++_sp & 255u) == 0u) { if (xb_ld(&(bar)[XB_TMO])) break; if (_sp > XB_SPIN_CAP) { atomicAdd(&(bar)[XB_TMO], 1u); break; } } } } while (0)
struct XcdBarrier { unsigned* bar; unsigned x; volatile LAS unsigned* st; };
__device__ __forceinline__ XcdBarrier xcd_barrier_post(unsigned* bar, volatile LAS unsigned* st) {
    XcdBarrier b; b.bar = bar; b.x = xb_xcc_id(); b.st = st;
    if (threadIdx.x == 0) (void)xb_add(&bar[XB_XCNT(b.x)], 1u);
    return b;
}
__device__ __forceinline__ void xcd_barrier_complete(unsigned* bar, unsigned x, unsigned& nloc, unsigned& nx) {
    const unsigned G = gridDim.x * gridDim.y * gridDim.z;
    unsigned sum, cnt, mine, sp = 0u;
    for (;;) {
        sum = 0u; cnt = 0u; mine = 0u;
#pragma unroll
        for (unsigned j = 0; j < 16; ++j) { const unsigned c = xb_ld(&bar[XB_XCNT(j)]); sum += c; cnt += (c > 0u) ? 1u : 0u; mine = (j == x) ? c : mine; }
        if (sum == G) break;
        __builtin_amdgcn_s_sleep(1);
        if ((++sp & 255u) == 0u) { if (xb_ld(&bar[XB_TMO])) break; if (sp > XB_SPIN_CAP) { atomicAdd(&bar[XB_TMO], 1u); break; } }
    }
    nloc = mine > 0u ? mine : 1u; nx = cnt > 0u ? cnt : 1u;
}
__device__ __forceinline__ void xcd_barrier(const XcdBarrier& b) {
    asm volatile("s_waitcnt vmcnt(0)" ::: "memory");
    __syncthreads();
    if (threadIdx.x == 0) {
        unsigned* bar = b.bar;
        __builtin_amdgcn_s_waitcnt(0);
        unsigned nloc = b.st[0], nx = b.st[1];
        if (nloc == 0u) { xcd_barrier_complete(bar, b.x, nloc, nx); b.st[0] = nloc; b.st[1] = nx; }
        const unsigned old = xb_add(&bar[XB_XSUB(b.x)], 1u);
        const unsigned gen = old / nloc;
        if (old + 1u == (gen + 1u) * nloc) {
            __builtin_amdgcn_fence(__ATOMIC_RELEASE, "agent");
            asm volatile("s_waitcnt vmcnt(0)" ::: "memory");
            const unsigned og = xb_add(&bar[XB_TOP], 1u);
            const unsigned tg = og / nx;
            if (og + 1u == (tg + 1u) * nx) xb_add(&bar[XB_TOPGEN], 1u);
            else XB_SPIN(xb_ld(&bar[XB_TOPGEN]) == tg, bar);
            __builtin_amdgcn_fence(__ATOMIC_ACQUIRE, "agent");
            xb_add(&bar[XB_XGEN(b.x)], 1u);
            asm volatile("s_waitcnt vmcnt(0)" ::: "memory");
        } else {
            XB_SPIN(xb_ld(&bar[XB_XGEN(b.x)]) == gen, bar);
            __builtin_amdgcn_fence(__ATOMIC_ACQUIRE, "agent");
            asm volatile("s_waitcnt vmcnt(0)" ::: "memory");
        }
    }
    __syncthreads();
}

__device__ __forceinline__ float wave_sum(float v) {
#pragma unroll
    for (int o = 1; o < 64; o <<= 1) v += __shfl_xor(v, o);
    return v;
}
__device__ __forceinline__ int wave_sum_i(int v) {
#pragma unroll
    for (int o = 1; o < 64; o <<= 1) v += __shfl_xor(v, o);
    return v;
}
#define WG_BAR() do { asm volatile("s_waitcnt lgkmcnt(0)" ::: "memory"); __builtin_amdgcn_s_barrier(); asm volatile("" ::: "memory"); } while (0)

struct Ctx { LAS unsigned char* lds; int tid, lane, wave, vcu, G; };
__device__ __forceinline__ Ctx opaque_ctx(const Ctx& c) { Ctx d = c; asm volatile("" : "+v"(d.tid)); d.lane = d.tid & 63; d.wave = __builtin_amdgcn_readfirstlane(d.tid >> 6); return d; }

__device__ __forceinline__ void transpose_item(const float* W, int K, int N, bf16_t* WT, int dst_row0, int k0, int n0, LAS unsigned* scr, int lane) {
    const int r2 = lane >> 4, c4 = lane & 15; const bool ok = (n0 + 4 * c4) < N;
    const float* src = W + (size_t)(k0 + 2 * r2) * N + n0 + 4 * c4;
#pragma unroll
    for (int i = 0; i < 8; ++i) { f32x4 a = {0.f, 0.f, 0.f, 0.f}, b = {0.f, 0.f, 0.f, 0.f};
        if (ok) { a = __builtin_nontemporal_load((const f32x4*)(src + (size_t)(8 * i) * N)); b = __builtin_nontemporal_load((const f32x4*)(src + (size_t)(8 * i + 1) * N)); }
        const int p = 4 * i + r2;
#pragma unroll
        for (int j = 0; j < 4; ++j) scr[(4 * c4 + j) * 33 + p] = cvt_pk_bf16(a[j], b[j]); }
    LDS_WAIT(); asm volatile("" ::: "memory");
    const int nvalid = (N - n0) < 64 ? (N - n0) : 64;
#pragma unroll
    for (int q = 0; q < 8; ++q) { const int ci = lane + 64 * q, n = ci >> 3, ch = ci & 7; const LAS unsigned* s = scr + n * 33 + ch * 4;
        const u32x4 o = {s[0], s[1], s[2], s[3]};
        if (n < nvalid) *(u32x4*)(WT + (size_t)(dst_row0 + n) * K + k0 + 8 * ch) = o; }
    LDS_WAIT(); asm volatile("" ::: "memory");
}
__device__ __forceinline__ int map_row(int map, int n0) {
    if (map == 1) return (n0 < 768) ? n0 : (n0 < 832 ? n0 + 3072 : (n0 < 3904 ? n0 - 64 : n0));
    if (map == 2) return (n0 >> 7) * 256 + (n0 & 127);
    if (map == 3) return (n0 >> 7) * 256 + 128 + (n0 & 127);
    return n0;
}
__device__ __forceinline__ void transpose_batch(const Ctx& c, const float* src, bf16_t* dst, int K, int N, int nmat, size_t src_ms, size_t dst_ms, int map) {
    LAS unsigned* scr = (LAS unsigned*)(c.lds + c.wave * 16384);
    const int gw = c.vcu * NWAVES + c.wave, NGW = c.G * NWAVES;
    const int nblk = (N + 63) / 64, per = (K / 64) * nblk; const long total = (long)per * nmat;
    for (long it = gw; it < total; it += NGW) {
        const int mat = (int)(it / per), r = (int)(it % per), kb = r / nblk, nb = r % nblk;
        transpose_item(src + (size_t)mat * src_ms, K, N, dst + (size_t)mat * dst_ms, map_row(map, nb * 64), kb * 64, nb * 64, scr, c.lane);
    }
}

__device__ __forceinline__ void fill_rope(const Ctx& c, f32x2* tabR, f32x2* tabG) {
    const int gt = (c.vcu * NTHR + c.tid), NT = c.G * NTHR;
    for (int i = gt; i < SEQ * 32; i += NT) { const int t = i >> 5, p = i & 31, j = p & 15; const float inv = exp2f(-(float)(2 * j) * (13.287712379549449f / 32.f));
        const float pos = (float)(p < 16 ? (t >> 6) : (t & 63)); const float a = pos * inv; tabR[i] = (f32x2){cosf(a), sinf(a)}; }
    for (int i = gt; i < SEQ * 64; i += NT) { const int t = i >> 6, p = i & 63, j = p & 31; const float inv = exp2f(-(float)(2 * j) * (13.287712379549449f / 64.f));
        const float pos = (float)(p < 32 ? (t >> 6) : (t & 63)); const float a = pos * inv; tabG[i] = (f32x2){cosf(a), sinf(a)}; }
}
__device__ __forceinline__ void cvt_rows_bf16(const Ctx& c, const float* x, bf16_t* xb) {
    const long gt = (long)c.vcu * NTHR + c.tid, NT = (long)c.G * NTHR, n8 = (long)M * DM / 8;
    for (long i = gt; i < n8; i += NT) { const f32x4 a = *(const f32x4*)(x + i * 8), b = *(const f32x4*)(x + i * 8 + 4);
        u32x4 w; w.x = cvt_pk_bf16(a[0], a[1]); w.y = cvt_pk_bf16(a[2], a[3]); w.z = cvt_pk_bf16(b[0], b[1]); w.w = cvt_pk_bf16(b[2], b[3]); *(u32x4*)(xb + i * 8) = w; }
}

__device__ __forceinline__ void mla_prep_rows(const Ctx& c, bf16_t* H, bf16_t* Hd, bf16_t* Km, const float* qn, const float* kvn, const f32x2* tabR) {
    const int gw = c.vcu * NWAVES + c.wave, NGW = c.G * NWAVES, lane = c.lane;
    for (int r = gw; r < M; r += NGW) {
        bf16_t* h = H + (size_t)r * HW; bf16_t* hd = Hd + (size_t)r * HW;
        { u32x4 w = *(const u32x4*)(h + C_CQ + lane * 8); float f[8] = {bf_lo(w.x), bf_hi(w.x), bf_lo(w.y), bf_hi(w.y), bf_lo(w.z), bf_hi(w.z), bf_lo(w.w), bf_hi(w.w)};
          float s = 0.f;
#pragma unroll
          for (int i = 0; i < 8; ++i) s += f[i] * f[i];
          const float rs = rsqrtf(wave_sum(s) * (1.f / 512.f) + RMS_EPS);
          const f32x4 g0 = *(const f32x4*)(qn + lane * 8), g1 = *(const f32x4*)(qn + lane * 8 + 4);
          u32x4 o; o.x = cvt_pk_bf16(f[0] * rs * g0[0], f[1] * rs * g0[1]); o.y = cvt_pk_bf16(f[2] * rs * g0[2], f[3] * rs * g0[3]);
          o.z = cvt_pk_bf16(f[4] * rs * g1[0], f[5] * rs * g1[1]); o.w = cvt_pk_bf16(f[6] * rs * g1[2], f[7] * rs * g1[3]);
          *(u32x4*)(hd + C_CQ + lane * 8) = o; }
        { u32x2 w = *(const u32x2*)(h + C_CKV + lane * 4); float f[4] = {bf_lo(w.x), bf_hi(w.x), bf_lo(w.y), bf_hi(w.y)};
          const float s = f[0] * f[0] + f[1] * f[1] + f[2] * f[2] + f[3] * f[3];
          const float rs = rsqrtf(wave_sum(s) * (1.f / 256.f) + RMS_EPS);
          const f32x4 g0 = *(const f32x4*)(kvn + lane * 4);
          u32x2 o; o.x = cvt_pk_bf16(f[0] * rs * g0[0], f[1] * rs * g0[1]); o.y = cvt_pk_bf16(f[2] * rs * g0[2], f[3] * rs * g0[3]);
          *(u32x2*)(hd + C_CKV + lane * 4) = o; }
        if (lane < 32) { const unsigned w = *(const unsigned*)(h + C_KR + 2 * lane); const float x1 = bf_lo(w), x2 = bf_hi(w); const f32x2 cs = tabR[(size_t)(r & (SEQ - 1)) * 32 + lane];
          const unsigned o = cvt_pk_bf16(x1 * cs.x - x2 * cs.y, x1 * cs.y + x2 * cs.x);
#pragma unroll
          for (int hh = 0; hh < 8; ++hh) *(unsigned*)(Km + (size_t)r * 1536 + hh * 192 + 128 + 2 * lane) = o; }
    }
}

__device__ __forceinline__ float log_sigmoid(float z) { const float e = __expf(-fabsf(z)); return fminf(z, 0.f) - __logf(1.f + e); }
__device__ __forceinline__ void gla_prep(const Ctx& c, const bf16_t* H, const float* w2  , const float* gb  , bf16_t* qin, bf16_t* att, bf16_t* kstT, bf16_t* vT, float* decay) {
    constexpr int TP = 66, QP = 136;
    LAS float* cum = (LAS float*)c.lds;
    LAS bf16_t* vt_l = (LAS bf16_t*)c.lds;
    LAS bf16_t* kst_l = (LAS bf16_t*)(c.lds + 32768);
    LAS bf16_t* Ql = (LAS bf16_t*)(c.lds + 32768 + 16896);
    LAS bf16_t* Kl = (LAS bf16_t*)(c.lds + 32768 + 16896 + 17408);
    LAS float* tot = (LAS float*)(c.lds + 32768 + 16896 + 2 * 17408);
    const int tid = c.tid, qtr = tid >> 7, dk = tid & 127, lane = c.lane, w = c.wave, fr = lane & 15, fq = lane >> 4;
    for (int item = c.vcu; item < BATCH * 64 * 4; item += c.G) {
        const int hh = item & 3, bc = item >> 2;
        const size_t row0 = (size_t)bc * 64;
        const int col = hh * 128 + dk;
#pragma nounroll
        for (int dir = 0; dir < 2; ++dir) {
            float wv[16];
#pragma unroll
            for (int j = 0; j < 16; ++j) wv[j] = w2[(dir * 16 + j) * 512 + col];
            const float bias = gb[dir * 512 + col];
            float run = 0.f;
#pragma unroll 2
            for (int i = 0; i < 16; ++i) { const int t = qtr * 16 + (dir ? 15 - i : i); const bf16_t* lp = H + (row0 + t) * HW + C_LAT + dir * 16;
                const u32x4 a = *(const u32x4*)lp, b = *(const u32x4*)(lp + 8);
                float z = bias;
                z += bf_lo(a.x) * wv[0] + bf_hi(a.x) * wv[1] + bf_lo(a.y) * wv[2] + bf_hi(a.y) * wv[3] + bf_lo(a.z) * wv[4] + bf_hi(a.z) * wv[5] + bf_lo(a.w) * wv[6] + bf_hi(a.w) * wv[7];
                z += bf_lo(b.x) * wv[8] + bf_hi(b.x) * wv[9] + bf_lo(b.y) * wv[10] + bf_hi(b.y) * wv[11] + bf_lo(b.z) * wv[12] + bf_hi(b.z) * wv[13] + bf_lo(b.w) * wv[14] + bf_hi(b.w) * wv[15];
                run += log_sigmoid(z) * (1.f / 16.f); cum[t * 128 + dk] = run; }
            tot[dk * 4 + qtr] = run;
            WG_BAR();
            const f32x4 tq = *(const LAS f32x4*)(tot + dk * 4);
            const float blast = (tq[0] + tq[1]) + (tq[2] + tq[3]);
            float off = 0.f;
#pragma unroll
            for (int q = 0; q < 4; ++q) off += ((dir == 0) ? (q < qtr) : (q > qtr)) ? tq[q] : 0.f;
#pragma unroll 2
            for (int i = 0; i < 16; ++i) { const int t = qtr * 16 + i; const size_t r = row0 + t;
                const float bcum = cum[t * 128 + dk] + off;
                const float q = bf2f(H[r * HW + C_GQ + col]) * 0.08838834764831845f, k = bf2f(H[r * HW + C_GK + col]);
                const bf16_t qb = f2bf(q * __expf(bcum));
                qin[((size_t)dir * M + r) * 512 + col] = qb; Ql[t * QP + dk] = qb;
                Kl[t * QP + dk] = f2bf(k * __expf(-bcum));
                kst_l[dk * TP + t] = f2bf(k * __expf(blast - bcum)); }
            if (qtr == 0) decay[(((size_t)dir * 256 + bc) * 4 + hh) * 128 + dk] = __expf(blast);
            WG_BAR();
            { const int ib = w >> 1, par = w & 1;
              const LAS bf16_t* qp = Ql + (ib * 16 + fr) * QP + 8 * fq; const LAS bf16_t* kp = Kl + (2 * par * 16 + fr) * QP + 8 * fq;
              f32x4 a0 = {0.f, 0.f, 0.f, 0.f}, a1 = {0.f, 0.f, 0.f, 0.f};
#pragma unroll
              for (int kk = 0; kk < 4; ++kk) { const bf16x8 qf = *(const LAS bf16x8*)(qp + kk * 32), k0 = *(const LAS bf16x8*)(kp + kk * 32), k1 = *(const LAS bf16x8*)(kp + 16 * QP + kk * 32);
                  a0 = __builtin_amdgcn_mfma_f32_16x16x32_bf16(k0, qf, a0, 0, 0, 0); a1 = __builtin_amdgcn_mfma_f32_16x16x32_bf16(k1, qf, a1, 0, 0, 0); }
              const int i = ib * 16 + fr, j0 = 2 * par * 16 + 4 * fq;
#pragma unroll
              for (int r = 0; r < 4; ++r) { const int j = j0 + r; a0[r] = (dir ? (j >= i) : (j <= i)) ? a0[r] : 0.f; a1[r] = (dir ? (j + 16 >= i) : (j + 16 <= i)) ? a1[r] : 0.f; }
              bf16_t* ap = att + ((((size_t)dir * 256 + bc) * 4 + hh) * 64 + i) * 64 + j0;
              u32x2 w0, w1; w0.x = cvt_pk_bf16(a0[0], a0[1]); w0.y = cvt_pk_bf16(a0[2], a0[3]); w1.x = cvt_pk_bf16(a1[0], a1[1]); w1.y = cvt_pk_bf16(a1[2], a1[3]);
              *(u32x2*)ap = w0; *(u32x2*)(ap + 16) = w1; }
#pragma unroll
            for (int q2 = 0; q2 < 2; ++q2) { const int ci = tid + 512 * q2, rowid = ci >> 3, ch = ci & 7; const LAS unsigned* sp = (const LAS unsigned*)(kst_l + rowid * TP + ch * 8);
                const u32x4 wd = {sp[0], sp[1], sp[2], sp[3]};
                *(u32x4*)(kstT + (((((size_t)dir * 256 + bc) * 4 + hh) * 128 + rowid) * 64 + ch * 8)) = wd; }
            WG_BAR();
        }
        { const int dv = tid & 255, half = tid >> 8;
#pragma unroll 4
          for (int i = 0; i < 32; ++i) { const int t = half * 32 + i; vt_l[dv * TP + t] = H[(row0 + t) * HW + C_GV + hh * 256 + dv]; } }
        WG_BAR();
#pragma unroll
        for (int q4 = 0; q4 < 4; ++q4) { const int ci = tid + 512 * q4, rowid = ci >> 3, ch = ci & 7; const LAS unsigned* sp = (const LAS unsigned*)(vt_l + rowid * TP + ch * 8);
            const u32x4 wd = {sp[0], sp[1], sp[2], sp[3]};
            *(u32x4*)(vT + ((((size_t)bc * 4 + hh) * 256 + rowid) * 64 + ch * 8)) = wd; }
        WG_BAR();
    }
}

__device__ __forceinline__ void gla_out_rows(const Ctx& c, const float* of, const float* ob, const bf16_t* H, const float* gn, bf16_t* Ocat) {
    const int gw = c.vcu * NWAVES + c.wave, NGW = c.G * NWAVES, lane = c.lane;
    for (int r = gw; r < M; r += NGW) {
#pragma unroll
        for (int hh = 0; hh < 4; ++hh) { const int j0 = hh * 256 + lane * 4;
            const f32x4 a = *(const f32x4*)(of + (size_t)r * 1024 + j0), b = *(const f32x4*)(ob + (size_t)r * 1024 + j0); const f32x4 s = a + b;
            const float ss = s[0] * s[0] + s[1] * s[1] + s[2] * s[2] + s[3] * s[3];
            const float rs = rsqrtf(wave_sum(ss) * (1.f / 256.f) + RMS_EPS);
            const f32x4 g = *(const f32x4*)(gn + j0); const u32x2 gw2 = *(const u32x2*)(H + (size_t)r * HW + C_GR + j0);
            const float gr[4] = {bf_lo(gw2.x), bf_hi(gw2.x), bf_lo(gw2.y), bf_hi(gw2.y)}; float o[4];
#pragma unroll
            for (int i = 0; i < 4; ++i) { const float sg = gr[i] * __builtin_amdgcn_rcpf(1.f + __expf(-gr[i])); o[i] = s[i] * rs * g[i] * sg; }
            u32x2 w; w.x = cvt_pk_bf16(o[0], o[1]); w.y = cvt_pk_bf16(o[2], o[3]);
            *(u32x2*)(Ocat + (size_t)r * 2048 + 1024 + j0) = w; }
    }
}

__device__ __forceinline__ void gqa_qknorm_rows(const Ctx& c, bf16_t* H, bf16_t* Hd, const float* qn, const float* kn, const f32x2* tabG) {
    const int gw = c.vcu * NWAVES + c.wave, NGW = c.G * NWAVES, lane = c.lane, l16 = lane & 15, hg = lane >> 4;
    const f32x4 q0 = *(const f32x4*)(qn + l16 * 8), q1 = *(const f32x4*)(qn + l16 * 8 + 4), k0 = *(const f32x4*)(kn + l16 * 8), k1 = *(const f32x4*)(kn + l16 * 8 + 4);
    for (int r = gw; r < M; r += NGW) {
        const bf16_t* h = H + (size_t)r * 3072; bf16_t* hd = Hd + (size_t)r * 3072;
        const f32x2* tp = tabG + (size_t)(r & (SEQ - 1)) * 64 + l16 * 4; const f32x4 t01 = *(const f32x4*)tp, t23 = *(const f32x4*)(tp + 2);
        u32x4 wv[5];
#pragma unroll
        for (int p = 0; p < 5; ++p) wv[p] = *(const u32x4*)(h + (p * 4 + hg) * 128 + l16 * 8);
#pragma unroll
        for (int p = 0; p < 5; ++p) { const u32x4 w = wv[p];
            float f[8] = {bf_lo(w.x), bf_hi(w.x), bf_lo(w.y), bf_hi(w.y), bf_lo(w.z), bf_hi(w.z), bf_lo(w.w), bf_hi(w.w)};
            float ss = 0.f;
#pragma unroll
            for (int i = 0; i < 8; ++i) ss += f[i] * f[i];
            ss += __shfl_xor(ss, 1); ss += __shfl_xor(ss, 2); ss += __shfl_xor(ss, 4); ss += __shfl_xor(ss, 8);
            const float rs = rsqrtf(ss * (1.f / 128.f) + RMS_EPS);
            const bool isq = (p < 4);
            const f32x4 g0 = isq ? q0 : k0, g1 = isq ? q1 : k1;
            const float y0 = f[0] * rs * g0[0], y1 = f[1] * rs * g0[1], y2 = f[2] * rs * g0[2], y3 = f[3] * rs * g0[3], y4 = f[4] * rs * g1[0], y5 = f[5] * rs * g1[1], y6 = f[6] * rs * g1[2], y7 = f[7] * rs * g1[3];
            u32x4 o; o.x = cvt_pk_bf16(y0 * t01[0] - y1 * t01[1], y0 * t01[1] + y1 * t01[0]); o.y = cvt_pk_bf16(y2 * t01[2] - y3 * t01[3], y2 * t01[3] + y3 * t01[2]);
            o.z = cvt_pk_bf16(y4 * t23[0] - y5 * t23[1], y4 * t23[1] + y5 * t23[0]); o.w = cvt_pk_bf16(y6 * t23[2] - y7 * t23[3], y6 * t23[3] + y7 * t23[2]);
            *(u32x4*)(hd + (p * 4 + hg) * 128 + l16 * 8) = o; }
    }
}

__device__ __forceinline__ void ln_router_rows(const Ctx& c, const float* Xres, const bf16_t* Mb, float* X1, bf16_t* X1b, const float* g, const float* bb, const float* wr  , float* aff) {
    LAS float* Wl = (LAS float*)c.lds;
    for (int i = c.tid; i < 2048 * 16 / 4; i += NTHR) { const f32x4 w = *(const f32x4*)(wr + (size_t)i * 4); const int k = i >> 2, e0 = (i & 3) * 4;
        Wl[(e0 + 0) * 2048 + k] = w[0]; Wl[(e0 + 1) * 2048 + k] = w[1]; Wl[(e0 + 2) * 2048 + k] = w[2]; Wl[(e0 + 3) * 2048 + k] = w[3]; }
    WG_BAR();
    const int gw = c.vcu * NWAVES + c.wave, NGW = c.G * NWAVES, lane = c.lane;
    for (int rr = gw; rr < M; rr += 2 * NGW) {
        const int rw[2] = {rr, (rr + NGW < M) ? rr + NGW : rr};
        f32x4 v[2][8];
#pragma unroll
        for (int q = 0; q < 2; ++q)
#pragma unroll
            for (int j = 0; j < 8; ++j) { const f32x4 x = *(const f32x4*)(Xres + (size_t)rw[q] * DM + j * 256 + lane * 4); const u32x2 mw = *(const u32x2*)(Mb + (size_t)rw[q] * DM + j * 256 + lane * 4);
                v[q][j] = x * DN_ALPHA + (f32x4){bf_lo(mw.x), bf_hi(mw.x), bf_lo(mw.y), bf_hi(mw.y)}; }
#pragma unroll
        for (int q = 0; q < 2; ++q) { float s = 0.f;
#pragma unroll
            for (int j = 0; j < 8; ++j) s += (v[q][j][0] + v[q][j][1]) + (v[q][j][2] + v[q][j][3]);
            const float mean = wave_sum(s) * (1.f / DM); float s2 = 0.f;
#pragma unroll
            for (int j = 0; j < 8; ++j) { v[q][j] = v[q][j] - mean; s2 += (v[q][j][0] * v[q][j][0] + v[q][j][1] * v[q][j][1]) + (v[q][j][2] * v[q][j][2] + v[q][j][3] * v[q][j][3]); }
            const float rstd = rsqrtf(wave_sum(s2) * (1.f / DM) + LN_EPS);
#pragma unroll
            for (int j = 0; j < 8; ++j) { const f32x4 gg = *(const f32x4*)(g + j * 256 + lane * 4), b4 = *(const f32x4*)(bb + j * 256 + lane * 4);
                v[q][j] = v[q][j] * rstd * gg + b4;
                if (q == 0 || rw[1] != rw[0]) { *(f32x4*)(X1 + (size_t)rw[q] * DM + j * 256 + lane * 4) = v[q][j];
                    u32x2 w; w.x = cvt_pk_bf16(v[q][j][0], v[q][j][1]); w.y = cvt_pk_bf16(v[q][j][2], v[q][j][3]); *(u32x2*)(X1b + (size_t)rw[q] * DM + j * 256 + lane * 4) = w; } } }
        float lg[2][16];
#pragma unroll
        for (int e = 0; e < 16; ++e) { float a0 = 0.f, a1 = 0.f;
#pragma unroll
            for (int j = 0; j < 8; ++j) { const f32x4 w = *(const LAS f32x4*)(Wl + e * 2048 + j * 256 + lane * 4);
                a0 += (v[0][j][0] * w[0] + v[0][j][1] * w[1]) + (v[0][j][2] * w[2] + v[0][j][3] * w[3]); a1 += (v[1][j][0] * w[0] + v[1][j][1] * w[1]) + (v[1][j][2] * w[2] + v[1][j][3] * w[3]); }
            lg[0][e] = wave_sum(a0); lg[1][e] = wave_sum(a1); }
#pragma unroll
        for (int q = 0; q < 2; ++q) { float mx = lg[q][0];
#pragma unroll
            for (int e = 1; e < 16; ++e) mx = fmaxf(mx, lg[q][e]);
            float den = 0.f;
#pragma unroll
            for (int e = 0; e < 16; ++e) { lg[q][e] = __expf(lg[q][e] - mx); den += lg[q][e]; }
            const float inv = 1.f / den; float mine = 0.f;
#pragma unroll
            for (int e = 0; e < 16; ++e) mine = (lane == e) ? lg[q][e] * inv : mine;
            if (lane < 16 && (q == 0 || rw[1] != rw[0])) aff[((size_t)(rw[q] >> 12) * 16 + lane) * SEQ + (rw[q] & (SEQ - 1))] = mine; }
    }
    WG_BAR();
}

__device__ __forceinline__ void topk_units(const Ctx& c, const float* aff, int* idx, float* gate, unsigned short* slotmap) {
    LAS unsigned* sm = (LAS unsigned*)c.lds;
    const int tid = c.tid, lane = c.lane, wid = c.wave;
    for (int be = c.vcu; be < BATCH * NEXP; be += c.G) {
        const int b = be >> 4, e = be & 15;
        const float* a = aff + (size_t)be * SEQ + tid * 8;
        const u32x4 k0 = *(const u32x4*)a, k1 = *(const u32x4*)(a + 4);
        const unsigned key[8] = {k0.x, k0.y, k0.z, k0.w, k1.x, k1.y, k1.z, k1.w};
        unsigned prefix = 0u; int par = 0;
        for (int bit = 30; bit >= 0; --bit) {
            const unsigned cand = prefix | (1u << bit); int cnt = 0;
#pragma unroll
            for (int i = 0; i < 8; ++i) cnt += (key[i] >= cand) ? 1 : 0;
            cnt = wave_sum_i(cnt);
            if (lane == 0) sm[par * 8 + wid] = (unsigned)cnt;
            WG_BAR();
            unsigned total = 0u;
#pragma unroll
            for (int w = 0; w < 8; ++w) total += sm[par * 8 + w];
            if (total >= (unsigned)CAP) prefix = cand;
            par ^= 1;
        }
        const unsigned T = prefix;
        int cgt = 0, ceq = 0;
#pragma unroll
        for (int i = 0; i < 8; ++i) { cgt += (key[i] > T) ? 1 : 0; ceq += (key[i] == T) ? 1 : 0; }
        unsigned pk = (unsigned)cgt | ((unsigned)ceq << 16), inc = pk;
#pragma unroll
        for (int o = 1; o < 64; o <<= 1) { const unsigned nb = __shfl_up(inc, o); if (lane >= o) inc += nb; }
        if (lane == 63) sm[32 + wid] = inc;
        WG_BAR();
        unsigned wpre = 0u, gtot = 0u;
#pragma unroll
        for (int w = 0; w < 8; ++w) { const unsigned v = sm[32 + w]; if (w < wid) wpre += v; gtot += v; }
        const unsigned ex = wpre + inc - pk;
        int pre_gt = (int)(ex & 0xffffu), pre_eq = (int)(ex >> 16);
        const int need_eq = CAP - (int)(gtot & 0xffffu);
        const size_t obase = ((size_t)e * BATCH + b) * CAP;
#pragma unroll
        for (int i = 0; i < 8; ++i) { const int t = tid * 8 + i; const bool gt = key[i] > T, eq = key[i] == T; const bool sel = gt || (eq && pre_eq < need_eq);
            const int slot = pre_gt + (pre_eq < need_eq ? pre_eq : need_eq);
            if (sel) { idx[obase + slot] = b * SEQ + t; gate[obase + slot] = __uint_as_float(key[i]); }
            slotmap[((size_t)b * SEQ + t) * 16 + e] = sel ? (unsigned short)slot : (unsigned short)0xFFFF;
            pre_gt += gt ? 1 : 0; pre_eq += eq ? 1 : 0; }
        WG_BAR();
    }
}

__device__ __forceinline__ void combine_ln_rows(const Ctx& c, const float* X1, const bf16_t* Y, const unsigned short* slotmap, const float* g, const float* bb, float* X2, bf16_t* Xb) {
    const int gw = c.vcu * NWAVES + c.wave, NGW = c.G * NWAVES, lane = c.lane;
    for (int rr = gw; rr < M; rr += 2 * NGW) {
        const int rw[2] = {rr, (rr + NGW < M) ? rr + NGW : rr};
        f32x4 v[2][8]; unsigned sw[2][8];
#pragma unroll
        for (int q = 0; q < 2; ++q) {
#pragma unroll
            for (int j = 0; j < 8; ++j) v[q][j] = *(const f32x4*)(X1 + (size_t)rw[q] * DM + j * 256 + lane * 4);
            const u32x4 s0 = *(const u32x4*)(slotmap + (size_t)rw[q] * 16), s1 = *(const u32x4*)(slotmap + (size_t)rw[q] * 16 + 8);
            sw[q][0] = s0.x; sw[q][1] = s0.y; sw[q][2] = s0.z; sw[q][3] = s0.w; sw[q][4] = s1.x; sw[q][5] = s1.y; sw[q][6] = s1.z; sw[q][7] = s1.w; }
#pragma unroll
        for (int q = 0; q < 2; ++q) {
#pragma unroll
            for (int j = 0; j < 8; ++j) v[q][j] = v[q][j] * DN_ALPHA;
            const int b = rw[q] >> 12;
#pragma unroll
            for (int e = 0; e < 16; ++e) { const unsigned sl = (unsigned)__builtin_amdgcn_readfirstlane((int)((sw[q][e >> 1] >> ((e & 1) * 16)) & 0xffffu));
                if (sl != 0xffffu) { const bf16_t* yr = Y + (((size_t)e * BATCH + b) * CAP + sl) * DM;
#pragma unroll
                    for (int j = 0; j < 8; ++j) { const u32x2 w = *(const u32x2*)(yr + j * 256 + lane * 4); v[q][j][0] += bf_lo(w.x); v[q][j][1] += bf_hi(w.x); v[q][j][2] += bf_lo(w.y); v[q][j][3] += bf_hi(w.y); } } }
        }
#pragma unroll
        for (int q = 0; q < 2; ++q) { float s = 0.f;
#pragma unroll
            for (int j = 0; j < 8; ++j) s += (v[q][j][0] + v[q][j][1]) + (v[q][j][2] + v[q][j][3]);
            const float mean = wave_sum(s) * (1.f / DM); float s2 = 0.f;
#pragma unroll
            for (int j = 0; j < 8; ++j) { v[q][j] = v[q][j] - mean; s2 += (v[q][j][0] * v[q][j][0] + v[q][j][1] * v[q][j][1]) + (v[q][j][2] * v[q][j][2] + v[q][j][3] * v[q][j][3]); }
            const float rstd = rsqrtf(wave_sum(s2) * (1.f / DM) + LN_EPS);
            if (q == 0 || rw[1] != rw[0]) {
#pragma unroll
                for (int j = 0; j < 8; ++j) { const f32x4 gg = *(const f32x4*)(g + j * 256 + lane * 4), b4 = *(const f32x4*)(bb + j * 256 + lane * 4);
                    const f32x4 o = v[q][j] * rstd * gg + b4; *(f32x4*)(X2 + (size_t)rw[q] * DM + j * 256 + lane * 4) = o;
                    u32x2 w; w.x = cvt_pk_bf16(o[0], o[1]); w.y = cvt_pk_bf16(o[2], o[3]); *(u32x2*)(Xb + (size_t)rw[q] * DM + j * 256 + lane * 4) = w; } } }
    }
}
namespace gla {
constexpr int SP = 272, IMG = 32 * SP;
__device__ __forceinline__ unsigned long long pack4(const f32x4 v) { return (unsigned long long)cvt_pk_bf16(v[0], v[1]) | ((unsigned long long)cvt_pk_bf16(v[2], v[3]) << 32); }

__device__ __forceinline__ void unit(const Ctx& c, int u, const bf16_t* qin, const bf16_t* att, const bf16_t* kstT, const bf16_t* vT, const float* decay, float* of, float* ob) {
    const int vs = u & 7, dir = (u >> 3) & 1, hh = (u >> 4) & 3, b = u >> 6;
    int tid_ = c.tid; asm volatile("" : "+v"(tid_));
    const int w = __builtin_amdgcn_readfirstlane(tid_ >> 6), lane = tid_ & 63, fr = lane & 15, fq = lane >> 4, ib = w >> 1, par = w & 1;
    LAS unsigned char* Sl = c.lds;
    const bf16_t* qd = qin + (size_t)dir * M * 512;
    float* outp = dir ? ob : of;
    for (int i = tid_; i < 2 * IMG / 4; i += NTHR) ((LAS unsigned*)Sl)[i] = 0u;
    f32x4 accS0 = {0.f, 0.f, 0.f, 0.f}, accS1 = {0.f, 0.f, 0.f, 0.f};
#define GLA_DECL(P) bf16x8 P##q0, P##q1, P##q2, P##q3, P##a0, P##a1, P##v00, P##v01, P##v10, P##v11, P##k0, P##k1; f32x4 P##d
#define GLA_LOAD(P, nstep) do { const int n_ = (nstep) < 64 ? (nstep) : 63; const int bc_ = b * 64 + (dir ? 63 - n_ : n_); const size_t rb_ = (size_t)bc_ * 64; \
    const bf16_t* qp_ = qd + (rb_ + ib * 16 + fr) * 512 + hh * 128 + 8 * fq; \
    P##q0 = *(const bf16x8*)(qp_); P##q1 = *(const bf16x8*)(qp_ + 32); P##q2 = *(const bf16x8*)(qp_ + 64); P##q3 = *(const bf16x8*)(qp_ + 96); \
    const bf16_t* ap_ = att + ((((size_t)dir * 256 + bc_) * 4 + hh) * 64 + ib * 16 + fr) * 64 + 8 * fq; \
    P##a0 = *(const bf16x8*)(ap_); P##a1 = *(const bf16x8*)(ap_ + 32); \
    const bf16_t* vp_ = vT + (((size_t)bc_ * 4 + hh) * 256 + vs * 32 + fr) * 64 + 8 * fq; \
    P##v00 = *(const bf16x8*)(vp_); P##v01 = *(const bf16x8*)(vp_ + 32); P##v10 = *(const bf16x8*)(vp_ + 16 * 64); P##v11 = *(const bf16x8*)(vp_ + 16 * 64 + 32); \
    const bf16_t* sp_ = kstT + ((((size_t)dir * 256 + bc_) * 4 + hh) * 128 + w * 16 + fr) * 64 + 8 * fq; \
    P##k0 = *(const bf16x8*)(sp_); P##k1 = *(const bf16x8*)(sp_ + 32); \
    P##d = *(const f32x4*)(decay + (((size_t)dir * 256 + bc_) * 4 + hh) * 128 + w * 16 + 4 * fq); } while (0)
#define GLA_STEP(P, nstep) do { const int n_ = (nstep); const int ch_ = dir ? 63 - n_ : n_; \
    const LAS unsigned char* rd_ = Sl + (n_ & 1) * IMG + (par * 16 + fr) * SP + (8 * fq) * 2; LAS unsigned char* wr_ = Sl + ((n_ + 1) & 1) * IMG + fr * SP + (w * 16 + 4 * fq) * 2; \
    f32x4 o_ = {0.f, 0.f, 0.f, 0.f}; \
    o_ = __builtin_amdgcn_mfma_f32_16x16x32_bf16(*(const LAS bf16x8*)(rd_), P##q0, o_, 0, 0, 0); o_ = __builtin_amdgcn_mfma_f32_16x16x32_bf16(*(const LAS bf16x8*)(rd_ + 64), P##q1, o_, 0, 0, 0); \
    o_ = __builtin_amdgcn_mfma_f32_16x16x32_bf16(*(const LAS bf16x8*)(rd_ + 128), P##q2, o_, 0, 0, 0); o_ = __builtin_amdgcn_mfma_f32_16x16x32_bf16(*(const LAS bf16x8*)(rd_ + 192), P##q3, o_, 0, 0, 0); \
    o_ = __builtin_amdgcn_mfma_f32_16x16x32_bf16(par ? P##v10 : P##v00, P##a0, o_, 0, 0, 0); o_ = __builtin_amdgcn_mfma_f32_16x16x32_bf16(par ? P##v11 : P##v01, P##a1, o_, 0, 0, 0); \
    *(f32x4*)(outp + ((size_t)(b * 64 + ch_) * 64 + ib * 16 + fr) * 1024 + hh * 256 + vs * 32 + par * 16 + 4 * fq) = o_; \
    accS0 = accS0 * P##d; accS1 = accS1 * P##d; \
    accS0 = __builtin_amdgcn_mfma_f32_16x16x32_bf16(P##k0, P##v00, accS0, 0, 0, 0); accS0 = __builtin_amdgcn_mfma_f32_16x16x32_bf16(P##k1, P##v01, accS0, 0, 0, 0); \
    accS1 = __builtin_amdgcn_mfma_f32_16x16x32_bf16(P##k0, P##v10, accS1, 0, 0, 0); accS1 = __builtin_amdgcn_mfma_f32_16x16x32_bf16(P##k1, P##v11, accS1, 0, 0, 0); \
    *(LAS unsigned long long*)(wr_) = pack4(accS0); *(LAS unsigned long long*)(wr_ + 16 * SP) = pack4(accS1); \
    WG_BAR(); } while (0)
    GLA_DECL(A); GLA_DECL(B); GLA_DECL(C);
    GLA_LOAD(A, 0); GLA_LOAD(B, 1);
    WG_BAR();
#pragma nounroll
    for (int n = 0; n < 63; n += 3) {
        GLA_LOAD(C, n + 2); GLA_STEP(A, n);
        GLA_LOAD(A, n + 3); GLA_STEP(B, n + 1);
        GLA_LOAD(B, n + 4); GLA_STEP(C, n + 2);
    }
    GLA_STEP(A, 63);
#undef GLA_DECL
#undef GLA_LOAD
#undef GLA_STEP
}
}
#ifndef MK_SPLIT
#define MK_SPLIT 0
#endif
constexpr int NPH_LAYER = 11, NPHASE = 1 + DEPTH * NPH_LAYER;
struct Args { const float* in[22]; float* out; unsigned char* ws; int ph_lo, ph_hi, li, pad; };

__global__ void __launch_bounds__(NTHR, 2) hybrid_fwd(Args args) {
    extern __shared__ __attribute__((aligned(16))) unsigned char lds_raw[];
    Ctx c; c.lds = (LAS unsigned char*)lds_raw; c.tid = threadIdx.x; c.lane = c.tid & 63; c.wave = __builtin_amdgcn_readfirstlane(c.tid >> 6);
    c.G = gridDim.x; { const int bx = blockIdx.x; c.vcu = (c.G % 8 == 0) ? (bx % 8) * (c.G / 8) + bx / 8 : bx; }
    unsigned char* ws = args.ws;
    gu32* ctl = (gu32*)(ws + WS_CTL);
    volatile LAS unsigned* MISC = (volatile LAS unsigned*)(c.lds + MISC_OFF);
    for (int u = c.tid; u < (LDS_BYTES - RING_BYTES) / 4; u += NTHR) ((LAS unsigned*)(c.lds + RING_BYTES))[u] = 0u;
    __syncthreads();
    const int lo = args.ph_lo, hi = args.ph_hi;
    XcdBarrier bar; bar.bar = (unsigned*)(ctl + CW_BAR) + args.li * XCD_BAR_WORDS; bar.x = 0; bar.st = nullptr;
    if (hi - lo > 1) bar = xcd_barrier_post((unsigned*)(ctl + CW_BAR) + args.li * XCD_BAR_WORDS, MISC + 8);
#ifndef PHASE_MASK
#define PHASE_MASK 0xFFF
#endif
#define PHM(j) (((PHASE_MASK) >> (j)) & 1)
#ifndef DUP_PHASE
#define DUP_PHASE (-1)
#endif
#ifndef DUP_SUB
#define DUP_SUB 3
#endif
#ifndef DUP_PAR
#define DUP_PAR 2
#endif
#define NREP(k) ((DUP_PHASE == (k) && (DUP_PAR == 2 || DUP_PAR == (layer & 1))) ? 2 : 1)
#define IN(k) (lo <= (k) && (k) < hi)
#define SEAM(k) do { if (hi > (k) + 1) xcd_barrier(bar); } while (0)

    f32x2* tabR = (f32x2*)(ws + WS_ROPER); f32x2* tabG = (f32x2*)(ws + WS_ROPEG);
    float* aff = (float*)(ws + WS_AFF); int* idx = (int*)(ws + WS_IDX); float* gate = (float*)(ws + WS_GATE); unsigned short* slotmap = (unsigned short*)(ws + WS_SLOT); float* decay = (float*)(ws + WS_DECAY);
    bf16_t* Win_t = (bf16_t*)(ws + WS_WIN); bf16_t* Wuq_t = (bf16_t*)(ws + WS_WUQ); bf16_t* Wukv_t = (bf16_t*)(ws + WS_WUKV); bf16_t* Wmo_t = (bf16_t*)(ws + WS_WMO);
    bf16_t* Wqkv_t = (bf16_t*)(ws + WS_WQKV); bf16_t* Wgo_t = (bf16_t*)(ws + WS_WGO); bf16_t* W13_t = (bf16_t*)(ws + WS_W13); bf16_t* W2_t = (bf16_t*)(ws + WS_W2);
    bf16_t* Xb = (bf16_t*)(ws + WS_XB); float* X1 = (float*)(ws + WS_X1); bf16_t* X1b = (bf16_t*)(ws + WS_X1B); bf16_t* H = (bf16_t*)(ws + WS_H);
    bf16_t* Qm = (bf16_t*)(ws + WS_QM); bf16_t* Km = (bf16_t*)(ws + WS_KM); bf16_t* Vm = (bf16_t*)(ws + WS_VM); bf16_t* Ocat = (bf16_t*)(ws + WS_OCAT);
    bf16_t* qin = (bf16_t*)(ws + WS_QIN); bf16_t* kin = (bf16_t*)(ws + WS_KIN); bf16_t* kstT = (bf16_t*)(ws + WS_KST); bf16_t* vT = (bf16_t*)(ws + WS_VT);
    float* of = (float*)(ws + WS_OF); float* ob = (float*)(ws + WS_OB); bf16_t* hdn = (bf16_t*)(ws + WS_HDN); bf16_t* Yb = (bf16_t*)(ws + WS_Y);
    float* X2 = args.out; bf16_t* Mb = (bf16_t*)(ws + WS_OF);

    if (PHM(11) && IN(0)) for (int rep_ = 0; rep_ < ((DUP_PHASE == 11) ? 2 : 1); ++rep_) {
        fill_rope(c, tabR, tabG);
        cvt_rows_bf16(c, args.in[0], Xb);
        transpose_batch(c, args.in[15], W13_t, DM, FF, DEPTH * NEXP, (size_t)DM * FF, (size_t)2 * FF * DM, 2);
        transpose_batch(c, args.in[16], W13_t, DM, FF, DEPTH * NEXP, (size_t)DM * FF, (size_t)2 * FF * DM, 3);
        transpose_batch(c, args.in[17], W2_t, FF, DM, DEPTH * NEXP, (size_t)FF * DM, (size_t)DM * FF, 0);
        transpose_batch(c, args.in[1], Win_t, DM, 3936, 2, (size_t)DM * 3936, (size_t)4096 * DM, 1);
        transpose_batch(c, args.in[10], Wqkv_t, DM, 3072, 2, (size_t)DM * 3072, (size_t)3072 * DM, 0);
        transpose_batch(c, args.in[9], Wmo_t, DM, DM, 2, (size_t)DM * DM, (size_t)DM * DM, 0);
        transpose_batch(c, args.in[13], Wgo_t, DM, DM, 2, (size_t)DM * DM, (size_t)DM * DM, 0);
        transpose_batch(c, args.in[3], Wuq_t, 512, 1536, 2, (size_t)512 * 1536, (size_t)1536 * 512, 0);
        transpose_batch(c, args.in[5], Wukv_t, 256, 2048, 2, (size_t)256 * 2048, (size_t)2048 * 256, 0);
        { const long gt = (long)c.vcu * NTHR + c.tid, NT = (long)c.G * NTHR;
          for (long i = gt; i < 2L * 160 * DM / 8; i += NT) { const long l2 = i / (160 * DM / 8), rr = i % (160 * DM / 8); *(u32x4*)(Win_t + (size_t)l2 * 4096 * DM + (size_t)3936 * DM + rr * 8) = (u32x4){0u, 0u, 0u, 0u}; } }
        SEAM(0);
    }

    const Ctx c0 = c;
    for (int layer = 0; layer < DEPTH; ++layer) {
        const int pb = 1 + layer * NPH_LAYER, i2 = layer >> 1; const bool even = (layer & 1) == 0;
        const float* Xres = (layer == 0) ? args.in[0] : (const float*)X2;
        if (PHM(0) && IN(pb + 0)) _Pragma("nounroll") for (int rep_ = 0; rep_ < NREP(0); ++rep_) { const Ctx c = opaque_ctx(c0);
            const int N = even ? 4096 : 3072;
            pg8::Gemm g{Xb, even ? Win_t + (size_t)i2 * 4096 * DM : Wqkv_t + (size_t)i2 * 3072 * DM, DM, DM, DM, 0, 0, nullptr};
            pg8::StaticOrder S; S.init(M, N, c.G, (int)blockIdx.x);
            pg8::EpiStoreBf16 E{H, N};
            pg8::gemm_phase<pg8::EpiStoreBf16, false>(c.lds, g, S, E);
            SEAM(pb + 0);
        }
        if (PHM(1) && IN(pb + 1)) _Pragma("nounroll") for (int rep_ = 0; rep_ < NREP(1); ++rep_) { const Ctx c = opaque_ctx(c0);
            if (even) { if (rep_ == 0 || (DUP_SUB & 4)) mla_prep_rows(c, H, rep_ == 0 ? H : (bf16_t*)(ws + WS_HDN), Km, args.in[2] + i2 * 512, args.in[4] + i2 * 256, tabR);
                        if (rep_ == 0 || !(DUP_SUB & 4)) gla_prep(c, H, args.in[6] + (size_t)i2 * 2 * 16 * 512, args.in[7] + i2 * 2 * 512, qin, kin  , kstT, vT, decay); }
            else gqa_qknorm_rows(c, H, rep_ == 0 ? H : (bf16_t*)(ws + WS_HDN), args.in[11] + i2 * 128, args.in[12] + i2 * 128, tabG);
            SEAM(pb + 1);
        }
        if (PHM(2) && IN(pb + 2) && even) _Pragma("nounroll") for (int rep_ = 0; rep_ < NREP(2); ++rep_) { const Ctx c = opaque_ctx(c0);
#ifndef SUBM
#define SUBM 0x1F
#endif
            if (SUBM & 1) { pg8::Gemm g{H + C_CQ, Wuq_t + (size_t)i2 * 1536 * 512, HW, 512, 512, 0, 0, nullptr}; pg8::StaticOrder S; S.init(M, 1536, c.G, (int)blockIdx.x);
              pg8::EpiQRope E{Qm, tabR}; pg8::gemm_phase<pg8::EpiQRope, false>(c.lds, g, S, E); }
            if (SUBM & 2) { pg8::Gemm g{H + C_CKV, Wukv_t + (size_t)i2 * 2048 * 256, HW, 256, 256, 0, 0, nullptr}; pg8::StaticOrder S; S.init(M, 2048, c.G, (int)blockIdx.x);
              pg8::EpiKV E{Km, Vm}; pg8::gemm_phase<pg8::EpiKV, false>(c.lds, g, S, E); }
            SEAM(pb + 2);
        }
        if (PHM(3) && IN(pb + 3)) _Pragma("nounroll") for (int rep_ = 0; rep_ < NREP(3); ++rep_) { const Ctx c = opaque_ctx(c0);
            if (even) {
                if ((SUBM & 4) && (rep_ == 0 || (DUP_SUB & 1))) for (int u = c.vcu; u < 256; u += c.G) gla::unit(c, u, qin, kin  , kstT, vT, decay, of, ob);
                if ((SUBM & 8) && (rep_ == 0 || (DUP_SUB & 2))) for (int uid = c.vcu; uid < 512; uid += c.G) { const int b = uid >> 7, h = (uid >> 4) & 7, qb = uid & 15; const size_t r0 = (size_t)b * SEQ;
                    attn::attn_unit<192, 1536, 1536, 1024, 2048>(Qm + (r0 + qb * 256) * 1536 + h * 192, Km + r0 * 1536 + h * 192, Vm + r0 * 1024 + h * 128, Ocat + (r0 + qb * 256) * 2048 + h * 128, SEQ, (char*)lds_raw); }
            } else {
                if (SUBM & 16) for (int uid = c.vcu; uid < 1024; uid += c.G) { const int b = uid >> 8, kvh = (uid >> 6) & 3, gq = (uid >> 4) & 3, qb = uid & 15, h = kvh * 4 + gq; const size_t r0 = (size_t)b * SEQ;
                    attn::attn_unit<128, 3072, 3072, 3072, 2048>(H + (r0 + qb * 256) * 3072 + h * 128, H + r0 * 3072 + 2048 + kvh * 128, H + r0 * 3072 + 2560 + kvh * 128, Ocat + (r0 + qb * 256) * 2048 + h * 128, SEQ, (char*)lds_raw); }
            }
            SEAM(pb + 3);
        }
        if (PHM(4) && IN(pb + 4) && even) _Pragma("nounroll") for (int rep_ = 0; rep_ < NREP(4); ++rep_) { const Ctx c = opaque_ctx(c0); gla_out_rows(c, of, ob, H, args.in[8] + i2 * 1024, Ocat); SEAM(pb + 4); }
        if (PHM(5) && IN(pb + 5)) _Pragma("nounroll") for (int rep_ = 0; rep_ < NREP(5); ++rep_) { const Ctx c = opaque_ctx(c0);
            pg8::Gemm g{Ocat, even ? Wmo_t + (size_t)i2 * DM * DM : Wgo_t + (size_t)i2 * DM * DM, DM, DM, DM, 0, 0, nullptr};
            pg8::StaticOrder S; S.init(M, DM, c.G, (int)blockIdx.x);
            pg8::EpiStoreBf16 E{Mb, DM};
            pg8::gemm_phase<pg8::EpiStoreBf16, false>(c.lds, g, S, E);
            SEAM(pb + 5);
        }
        if (PHM(6) && IN(pb + 6)) _Pragma("nounroll") for (int rep_ = 0; rep_ < NREP(6); ++rep_) { const Ctx c = opaque_ctx(c0); ln_router_rows(c, Xres, Mb, X1, X1b, args.in[18] + layer * DM, args.in[19] + layer * DM, args.in[14] + (size_t)layer * DM * NEXP, aff); SEAM(pb + 6); }
        if (PHM(7) && IN(pb + 7)) _Pragma("nounroll") for (int rep_ = 0; rep_ < NREP(7); ++rep_) { const Ctx c = opaque_ctx(c0); topk_units(c, aff, idx, gate, slotmap); SEAM(pb + 7); }
        if (PHM(8) && IN(pb + 8)) _Pragma("nounroll") for (int rep_ = 0; rep_ < NREP(8); ++rep_) { const Ctx c = opaque_ctx(c0);
            pg8::Gemm g{X1b, W13_t + (size_t)layer * NEXP * 2 * FF * DM, DM, DM, DM, 3, (size_t)2 * FF * DM, idx};
            pg8::StaticOrder S; S.init(MX, 2 * FF, c.G, (int)blockIdx.x);
            pg8::EpiSwiglu E{hdn};
            pg8::gemm_phase<pg8::EpiSwiglu, true>(c.lds, g, S, E);
            SEAM(pb + 8);
        }
        if (PHM(9) && IN(pb + 9)) _Pragma("nounroll") for (int rep_ = 0; rep_ < NREP(9); ++rep_) { const Ctx c = opaque_ctx(c0);
            pg8::Gemm g{hdn, W2_t + (size_t)layer * NEXP * DM * FF, FF, FF, FF, 3, (size_t)DM * FF, nullptr};
            pg8::StaticOrder S; S.init(MX, DM, c.G, (int)blockIdx.x);
            pg8::EpiGate E{Yb, gate};
            pg8::gemm_phase<pg8::EpiGate, false>(c.lds, g, S, E);
            SEAM(pb + 9);
        }
        if (PHM(10) && IN(pb + 10)) _Pragma("nounroll") for (int rep_ = 0; rep_ < NREP(10); ++rep_) { const Ctx c = opaque_ctx(c0); combine_ln_rows(c, X1, Yb, slotmap, args.in[20] + layer * DM, args.in[21] + layer * DM, X2, Xb); SEAM(pb + 10); }
    }
#undef IN
#undef SEAM
}

extern "C" void kernel_launch(void* const* d_in, const int* in_sizes, int n_in, void* d_out, int out_size, void* d_ws, size_t ws_size, hipStream_t stream) {
    static int grid = 0;
    if (grid == 0) {
        if (n_in != 22 || in_sizes[0] != M * DM || out_size != M * DM || ws_size < WS_END) { fprintf(stderr, "kernel_launch: unexpected shapes (n_in %d, in0 %d, out %d, ws %zu < %zu); nothing launched\n", n_in, n_in > 0 ? in_sizes[0] : -1, out_size, ws_size, (size_t)WS_END); grid = -1; return; }
        int dev = 0, cus = 0, per_cu = 0;
        if (hipGetDevice(&dev) != hipSuccess || hipDeviceGetAttribute(&cus, hipDeviceAttributeMultiprocessorCount, dev) != hipSuccess) { grid = -1; return; }
        if (hipFuncSetAttribute((const void*)hybrid_fwd, hipFuncAttributeMaxDynamicSharedMemorySize, LDS_BYTES) != hipSuccess) { fprintf(stderr, "kernel_launch: hipFuncSetAttribute failed\n"); grid = -1; return; }
        if (hipOccupancyMaxActiveBlocksPerMultiprocessor(&per_cu, (const void*)hybrid_fwd, NTHR, LDS_BYTES) != hipSuccess || per_cu < 1) fprintf(stderr, "kernel_launch: occupancy query reports %d\n", per_cu);
        (void)hipGetLastError();
        grid = cus;
    }
    if (grid < 0) return;
    if (hipMemsetAsync((char*)d_ws + WS_CTL, 0, CTL_ZERO_BYTES, stream) != hipSuccess) return;
    Args a{};
    for (int i = 0; i < 22; ++i) a.in[i] = (const float*)d_in[i];
    a.out = (float*)d_out; a.ws = (unsigned char*)d_ws; a.pad = 0;
#if MK_SPLIT
    for (int p = 0; p < NPHASE; ++p) {
        if (p > 0) { const int layer = (p - 1) / NPH_LAYER, k = (p - 1) % NPH_LAYER; if ((layer & 1) && (k == 2 || k == 4)) continue; }
        a.ph_lo = p; a.ph_hi = p + 1; a.li = 0;
        hipLaunchKernelGGL(hybrid_fwd, dim3(grid), dim3(NTHR), LDS_BYTES, stream, a);
    }
#elif defined(RELAUNCH_PHASE)
    a.ph_lo = 0; a.ph_hi = RELAUNCH_PHASE + 1; a.li = 0; hipLaunchKernelGGL(hybrid_fwd, dim3(grid), dim3(NTHR), LDS_BYTES, stream, a);
    a.ph_lo = RELAUNCH_PHASE; a.ph_hi = RELAUNCH_PHASE + 1; a.li = 1; hipLaunchKernelGGL(hybrid_fwd, dim3(grid), dim3(NTHR), LDS_BYTES, stream, a);
    a.ph_lo = RELAUNCH_PHASE + 1; a.ph_hi = NPHASE; a.li = 2; hipLaunchKernelGGL(hybrid_fwd, dim3(grid), dim3(NTHR), LDS_BYTES, stream, a);
#else
    a.ph_lo = 0; a.ph_hi = NPHASE; a.li = 0;
    hipLaunchKernelGGL(hybrid_fwd, dim3(grid), dim3(NTHR), LDS_BYTES, stream, a);
#endif
    const hipError_t le = hipPeekAtLastError();
    if (le != hipSuccess) fprintf(stderr, "kernel_launch: launch failed: %s\n", hipGetErrorName(le));
}
```

```cpp
#include <hip/hip_runtime.h>
#include <hip/hip_bf16.h>
#include <cstdio>
#include <cstdint>
#include <cmath>

#define GAS __attribute__((address_space(1)))
#define LAS __attribute__((address_space(3)))
typedef unsigned short bf16_t;
typedef short bf16x8 __attribute__((ext_vector_type(8)));
typedef short s16x4 __attribute__((ext_vector_type(4)));
typedef float f32x4 __attribute__((ext_vector_type(4)));
typedef float f32x2 __attribute__((ext_vector_type(2)));
typedef float f32x16 __attribute__((ext_vector_type(16)));
typedef unsigned u32x4 __attribute__((ext_vector_type(4)));
typedef unsigned u32x2 __attribute__((ext_vector_type(2)));
typedef GAS unsigned gu32;

__device__ __forceinline__ unsigned cvt_pk_bf16(float lo, float hi) { unsigned r; asm volatile("v_cvt_pk_bf16_f32 %0, %1, %2" : "=v"(r) : "v"(lo), "v"(hi)); return r; }
__device__ __forceinline__ float bf_lo(unsigned w) { return __uint_as_float(w << 16); }
__device__ __forceinline__ float bf_hi(unsigned w) { return __uint_as_float(w & 0xffff0000u); }
__device__ __forceinline__ float bf2f(bf16_t h) { return __uint_as_float(((unsigned)h) << 16); }
__device__ __forceinline__ bf16_t f2bf(float f) { return (bf16_t)(cvt_pk_bf16(f, 0.f) & 0xffffu); }

namespace pg8 {
constexpr int BM = 256, BK = 64, HALF = 128, HTB = HALF * BK * 2, STAGE_BYTES = 8 * HTB, NXCD = 8, WGM = 8;
__host__ __device__ __forceinline__ int lds_byte(int r, int c) { const int st = (r >> 4) * 2 + (c >> 5), rr = r & 15, cc = c & 31, ob = rr * 64 + cc * 2; return st * 1024 + (ob ^ (((ob >> 9) & 1) << 5)); }
__host__ __device__ __forceinline__ void stage_rc(int b, int& R, int& C) { const int st = b / 1024, sb = b % 1024, swz = sb ^ (((sb >> 9) & 1) << 5); R = (st >> 1) * 16 + swz / 64; C = (st & 1) * 32 + (swz % 64) / 2; }
__host__ __device__ __forceinline__ int perm32(int rho) { const int n = rho >> 4, i = rho & 15; return 8 * (i >> 2) + 4 * n + (i & 3); }

struct Unit { int pm, pn; };
struct Gemm { const bf16_t* A; const bf16_t* Bt; int lda, ldb, K, bshift; size_t bstride; const int* gather; };

struct StaticOrder {
    int nM, nN, nwg, G, c;
    __device__ void init(int M, int N, int G_, int c_) { nM = M / BM; nN = N / BM; nwg = nM * nN; G = G_; c = c_; }
    __device__ bool next(int i, Unit& u) const {
        const long L = (long)i * G + c; if (L >= nwg) return false;
        int wgid = (int)L; { const int q = nwg / NXCD, r = nwg % NXCD, xcd = wgid % NXCD, off = wgid / NXCD; wgid = (xcd < r ? xcd * (q + 1) : r * (q + 1) + (xcd - r) * q) + off; }
        const int nig = WGM * nN, gid = wgid / nig, fm = gid * WGM, gsz = (nM - fm) < WGM ? (nM - fm) : WGM;
        u.pm = fm + ((wgid % nig) % gsz); u.pn = (wgid % nig) / gsz; return true;
    }
};

typedef int v8i_t __attribute__((ext_vector_type(8)));
typedef short s16x16_t __attribute__((ext_vector_type(16)));
__device__ __forceinline__ v8i_t cat16(bf16x8 a, bf16x8 b) { const s16x16_t t = __builtin_shufflevector(a, b, 0, 1, 2, 3, 4, 5, 6, 7, 8, 9, 10, 11, 12, 13, 14, 15); return __builtin_bit_cast(v8i_t, t); }
template <class Epi, bool GATHER, bool F8 = false, int WSC = 0x79797979, int ASC = 0x7F7F7F7F>
__device__ __forceinline__ void gemm_phase(LAS unsigned char* lds, const Gemm g, const StaticOrder& S, const Epi& E) {
    int tid_ = threadIdx.x; asm volatile("" : "+v"(tid_));
    const int tid = tid_, wid = __builtin_amdgcn_readfirstlane(tid >> 6), lane = tid & 63, wr = wid >> 2, wc = wid & 3, fr = lane & 15, fq = lane >> 4;
    const int K = g.K, nt = K / BK;
    unsigned voffA[2], voffB[2]; int RA[2], CA[2];
#pragma unroll
    for (int i = 0; i < 2; ++i) { int R, C; stage_rc(tid * 16 + i * 8192, R, C); const int Rb = Epi::PERM ? ((R & ~31) + perm32(R & 31)) : R;
        RA[i] = R; CA[i] = C; voffA[i] = (unsigned)(R * g.lda + C) * 2u; voffB[i] = (unsigned)(Rb * g.ldb + C) * 2u; }
    const size_t kstep = (size_t)(BK * 2);
    const size_t hstepA = (size_t)HALF * g.lda * 2, hstepB = (size_t)HALF * g.ldb * 2;
    const size_t tstepA = 2 * hstepA, tstepB = 2 * hstepB;
    const unsigned ldsw = (unsigned)wid * 1024u;
    int aoffk[2], boffk[2];
#pragma unroll
    for (int k = 0; k < 2; ++k) { const int col = F8 ? ((fq >> 1) * 32 + (fq & 1) * 16 + 8 * k) : (k * 32 + fq * 8); aoffk[k] = lds_byte(wr * 64 + fr, col); boffk[k] = lds_byte(wc * 32 + fr, col); }
#define PG8_SA(b, h) (((b) * 2 + (h)) * HTB)
#define PG8_SB(b, h) ((4 + (b) * 2 + (h)) * HTB)
#define PG8_STAGE(bufoff, gbase, voff) do { const char* _gb = (const char*)(gbase); asm volatile("" : "+s"(_gb));     \
        _Pragma("unroll") for (int _i = 0; _i < 2; ++_i) \
        __builtin_amdgcn_global_load_lds((const unsigned*)(_gb + (voff)[_i]), (LAS unsigned*)(lds + (bufoff) + ldsw + _i * 8192), 16, 0, 0); } while (0)
#define PG8_STAGE_A(bufoff, gptr, h, vg) do { if constexpr (GATHER) { PG8_STAGE(bufoff, gptr, vg[h]); } else { PG8_STAGE(bufoff, (gptr) + (h) * hstepA, voffA); } } while (0)
#define PG8_LDA(dst, b, h) do { if constexpr (F8) { _Pragma("unroll") for (int m = 0; m < 4; ++m) dst##8[m] = *(const LAS v8i_t*)(lds + PG8_SA(b, h) + aoffk[0] + m * 2048); } \
    else { _Pragma("unroll") for (int m = 0; m < 4; ++m) _Pragma("unroll") for (int k = 0; k < 2; ++k) dst[m][k] = *(const LAS bf16x8*)(lds + PG8_SA(b, h) + aoffk[k] + m * 2048); } } while (0)
#define PG8_LDB(dst, b, h) do { if constexpr (F8) { _Pragma("unroll") for (int n = 0; n < 2; ++n) dst##8[n] = *(const LAS v8i_t*)(lds + PG8_SB(b, h) + boffk[0] + n * 2048); } \
    else { _Pragma("unroll") for (int n = 0; n < 2; ++n) _Pragma("unroll") for (int k = 0; k < 2; ++k) dst[n][k] = *(const LAS bf16x8*)(lds + PG8_SB(b, h) + boffk[k] + n * 2048); } } while (0)
#define PG8_MMA(ai, bj, At, Bt) do { __builtin_amdgcn_s_setprio(1); \
    if constexpr (F8) { _Pragma("unroll") for (int m = 0; m < 4; ++m) _Pragma("unroll") for (int n = 0; n < 2; ++n) \
        acc[ai][bj][m][n] = __builtin_amdgcn_mfma_scale_f32_16x16x128_f8f6f4(Bt##8[n], At##8[m], acc[ai][bj][m][n], 0, 0, 0, WSC, 0, ASC); } \
    else { _Pragma("unroll") for (int m = 0; m < 4; ++m) _Pragma("unroll") for (int n = 0; n < 2; ++n) _Pragma("unroll") for (int k = 0; k < 2; ++k) \
        acc[ai][bj][m][n] = __builtin_amdgcn_mfma_f32_16x16x32_bf16(Bt[n][k], At[m][k], acc[ai][bj][m][n], 0, 0, 0); } __builtin_amdgcn_s_setprio(0); } while (0)
#define PG8_WAIT_V(n) asm volatile("s_waitcnt vmcnt(" #n ")" ::: "memory")
#define PG8_WAIT_L(n) asm volatile("s_waitcnt lgkmcnt(" #n ")" ::: "memory")
#define PG8_BAR __builtin_amdgcn_s_barrier()
#define PG8_SCHED __builtin_amdgcn_sched_barrier(0)
    Unit cur, nxt; int ui = 0;
    if (!S.next(0, cur)) return;
    f32x4 acc[2][2][4][2];
#pragma unroll
    for (int a = 0; a < 2; ++a)
#pragma unroll
        for (int b = 0; b < 2; ++b)
#pragma unroll
            for (int m = 0; m < 4; ++m)
#pragma unroll
                for (int n = 0; n < 2; ++n) acc[a][b][m][n] = (f32x4){0.f, 0.f, 0.f, 0.f};
    bf16x8 At[4][2], B0[2][2], B1[2][2]; v8i_t At8[4], B08[2], B18[2];
    unsigned vgc[2][2], vgn[2][2];
    if constexpr (GATHER) {
#pragma unroll
        for (int h = 0; h < 2; ++h)
#pragma unroll
            for (int i = 0; i < 2; ++i) { const int gr = g.gather[cur.pm * BM + h * HALF + RA[i]]; vgc[h][i] = (unsigned)(gr * g.lda + CA[i]) * 2u; vgn[h][i] = vgc[h][i]; }
    }
    const char* cA = GATHER ? (const char*)g.A : (const char*)g.A + (size_t)cur.pm * tstepA;
    const char* cB = (const char*)g.Bt + (size_t)(cur.pm >> g.bshift) * g.bstride * 2 + (size_t)cur.pn * tstepB;
    PG8_STAGE(PG8_SB(0, 0), cB, voffB); PG8_STAGE(PG8_SB(0, 1), cB + hstepB, voffB); PG8_STAGE_A(PG8_SA(0, 0), cA, 0, vgc); PG8_STAGE_A(PG8_SA(0, 1), cA, 1, vgc);
    if (wr == 1) PG8_BAR;
    PG8_WAIT_V(2); PG8_BAR;
    PG8_STAGE(PG8_SB(1, 0), cB + kstep, voffB); PG8_STAGE_A(PG8_SA(1, 0), cA + kstep, 0, vgc); PG8_STAGE(PG8_SB(1, 1), cB + hstepB + kstep, voffB);
    PG8_WAIT_V(6); PG8_BAR;
    for (;;) {
        const bool has_next = S.next(ui + 1, nxt);
        if constexpr (GATHER) {
            if (has_next) { int t2 = tid; asm volatile("" : "+v"(t2));
#pragma unroll
                for (int i = 0; i < 2; ++i) { int R, C; stage_rc(t2 * 16 + i * 8192, R, C);
#pragma unroll
                    for (int h = 0; h < 2; ++h) { const int gr = g.gather[nxt.pm * BM + h * HALF + R]; vgn[h][i] = (unsigned)(gr * g.lda + C) * 2u; } }
            }
        }
        const char* nA = has_next ? (GATHER ? (const char*)g.A : (const char*)g.A + (size_t)nxt.pm * tstepA) : cA;
        const char* nB = has_next ? (const char*)g.Bt + (size_t)(nxt.pm >> g.bshift) * g.bstride * 2 + (size_t)nxt.pn * tstepB : cB;
#pragma nounroll
        for (int t = 0; t < nt; t += 2) {
            const bool last = (t == nt - 2);
            asm volatile("" : "+v"(voffB[0]), "+v"(voffB[1]));
            if constexpr (GATHER) asm volatile("" : "+v"(vgc[0][0]), "+v"(vgc[0][1]), "+v"(vgc[1][0]), "+v"(vgc[1][1]), "+v"(vgn[0][0]), "+v"(vgn[0][1]), "+v"(vgn[1][0]), "+v"(vgn[1][1]));
            else asm volatile("" : "+v"(voffA[0]), "+v"(voffA[1]));
            const char* a1 = cA + (size_t)(t + 1) * kstep;
            const char* a2 = last ? nA : cA + (size_t)(t + 2) * kstep; const char* b2 = last ? nB : cB + (size_t)(t + 2) * kstep;
            const char* a3 = a2 + kstep; const char* b3 = b2 + kstep;
            PG8_LDB(B0, 0, 0); PG8_LDB(B1, 0, 1); PG8_SCHED; PG8_LDA(At, 0, 0); PG8_STAGE_A(PG8_SA(1, 1), a1, 1, vgc);
            if constexpr (GATHER) { if (last && has_next) {
#pragma unroll
                for (int h = 0; h < 2; ++h)
#pragma unroll
                    for (int i = 0; i < 2; ++i) vgc[h][i] = vgn[h][i]; } }
            PG8_WAIT_V(8); PG8_WAIT_L(0); PG8_BAR; PG8_MMA(0, 0, At, B0); PG8_MMA(0, 1, At, B1); PG8_BAR; PG8_SCHED;
            PG8_LDA(At, 0, 1); PG8_STAGE(PG8_SB(0, 0), b2, voffB); PG8_STAGE(PG8_SB(0, 1), b2 + hstepB, voffB); PG8_STAGE_A(PG8_SA(0, 0), a2, 0, vgc);
            PG8_WAIT_V(8); PG8_WAIT_L(0); PG8_BAR; PG8_MMA(1, 0, At, B0); PG8_MMA(1, 1, At, B1); PG8_BAR; PG8_SCHED;
            PG8_LDB(B0, 1, 0); PG8_LDB(B1, 1, 1); PG8_SCHED; PG8_LDA(At, 1, 0); PG8_STAGE_A(PG8_SA(0, 1), a2, 1, vgc);
            PG8_WAIT_V(8); PG8_WAIT_L(0); PG8_BAR; PG8_MMA(0, 0, At, B0); PG8_MMA(0, 1, At, B1); PG8_BAR; PG8_SCHED;
            PG8_LDA(At, 1, 1); PG8_STAGE(PG8_SB(1, 0), b3, voffB); PG8_STAGE(PG8_SB(1, 1), b3 + hstepB, voffB); PG8_STAGE_A(PG8_SA(1, 0), a3, 0, vgc);
            PG8_WAIT_V(8); PG8_WAIT_L(0); PG8_BAR; PG8_MMA(1, 0, At, B0); PG8_MMA(1, 1, At, B1); PG8_BAR; PG8_SCHED;
        }
        if (wr == 0) PG8_BAR;
        { int te = threadIdx.x; asm volatile("" : "+v"(te)); E(acc, cur, wr, wc, te & 15, (te >> 4) & 3); }
        if (!has_next) break;
#pragma unroll
        for (int a = 0; a < 2; ++a)
#pragma unroll
            for (int b = 0; b < 2; ++b)
#pragma unroll
                for (int m = 0; m < 4; ++m)
#pragma unroll
                    for (int n = 0; n < 2; ++n) acc[a][b][m][n] = (f32x4){0.f, 0.f, 0.f, 0.f};
        cur = nxt; cA = nA; cB = nB; ++ui;
        if (wr == 1) PG8_BAR;
    }
    PG8_WAIT_V(0);
    PG8_BAR;
#undef PG8_SA
#undef PG8_SB
#undef PG8_STAGE
#undef PG8_STAGE_A
#undef PG8_LDA
#undef PG8_LDB
#undef PG8_MMA
#undef PG8_WAIT_V
#undef PG8_WAIT_L
#undef PG8_BAR
#undef PG8_SCHED
}
}
namespace pg8 {
struct EpiStoreBf16 {
    static constexpr bool PERM = true;
    bf16_t* O; int ldc;
    __device__ __forceinline__ void operator()(const f32x4 (&acc)[2][2][4][2], const Unit& u, int wr, int wc, int fr, int fq) const {
        const int row0 = u.pm * BM + wr * 64 + fr, col0 = u.pn * BM + wc * 32 + 8 * fq;
#pragma unroll
        for (int ai = 0; ai < 2; ++ai)
#pragma unroll
            for (int m = 0; m < 4; ++m) { bf16_t* rowp = O + (size_t)(row0 + ai * HALF + m * 16) * ldc + col0;
#pragma unroll
                for (int bj = 0; bj < 2; ++bj) { const f32x4 v0 = acc[ai][bj][m][0], v1 = acc[ai][bj][m][1];
                    u32x4 w; w.x = cvt_pk_bf16(v0[0], v0[1]); w.y = cvt_pk_bf16(v0[2], v0[3]); w.z = cvt_pk_bf16(v1[0], v1[1]); w.w = cvt_pk_bf16(v1[2], v1[3]);
                    *(u32x4*)(rowp + bj * HALF) = w; } }
    }
};
struct EpiQRope {
    static constexpr bool PERM = true;
    bf16_t* O; const f32x2* tab;
    __device__ __forceinline__ void operator()(const f32x4 (&acc)[2][2][4][2], const Unit& u, int wr, int wc, int fr, int fq) const {
        const int row0 = u.pm * BM + wr * 64 + fr, col0 = u.pn * BM + wc * 32 + 8 * fq;
#pragma unroll
        for (int bj = 0; bj < 2; ++bj) {
            const int col = col0 + bj * HALF, within = col % 192;
            const bool pe = within >= 128; const int p0 = (within - 128) >> 1;
#pragma unroll
            for (int ai = 0; ai < 2; ++ai)
#pragma unroll
                for (int m = 0; m < 4; ++m) { const int row = row0 + ai * HALF + m * 16;
                    f32x4 v0 = acc[ai][bj][m][0], v1 = acc[ai][bj][m][1];
                    if (pe) { const f32x2* tp = tab + (size_t)(row & 4095) * 32 + p0; const f32x4 t01 = *(const f32x4*)tp, t23 = *(const f32x4*)(tp + 2);
                        const f32x4 a = v0, b = v1;
                        v0[0] = a[0] * t01[0] - a[1] * t01[1]; v0[1] = a[0] * t01[1] + a[1] * t01[0]; v0[2] = a[2] * t01[2] - a[3] * t01[3]; v0[3] = a[2] * t01[3] + a[3] * t01[2];
                        v1[0] = b[0] * t23[0] - b[1] * t23[1]; v1[1] = b[0] * t23[1] + b[1] * t23[0]; v1[2] = b[2] * t23[2] - b[3] * t23[3]; v1[3] = b[2] * t23[3] + b[3] * t23[2]; }
                    u32x4 w; w.x = cvt_pk_bf16(v0[0], v0[1]); w.y = cvt_pk_bf16(v0[2], v0[3]); w.z = cvt_pk_bf16(v1[0], v1[1]); w.w = cvt_pk_bf16(v1[2], v1[3]);
                    *(u32x4*)(O + (size_t)row * 1536 + col) = w; asm volatile("" ::: "memory"); }
        }
    }
};
struct EpiKV {
    static constexpr bool PERM = true;
    bf16_t* Km; bf16_t* Vm;
    __device__ __forceinline__ void operator()(const f32x4 (&acc)[2][2][4][2], const Unit& u, int wr, int wc, int fr, int fq) const {
        const int row0 = u.pm * BM + wr * 64 + fr, c = wc * 32 + 8 * fq;
#pragma unroll
        for (int ai = 0; ai < 2; ++ai)
#pragma unroll
            for (int m = 0; m < 4; ++m) { const size_t row = (size_t)(row0 + ai * HALF + m * 16);
#pragma unroll
                for (int bj = 0; bj < 2; ++bj) { const f32x4 v0 = acc[ai][bj][m][0], v1 = acc[ai][bj][m][1];
                    u32x4 w; w.x = cvt_pk_bf16(v0[0], v0[1]); w.y = cvt_pk_bf16(v0[2], v0[3]); w.z = cvt_pk_bf16(v1[0], v1[1]); w.w = cvt_pk_bf16(v1[2], v1[3]);
                    if (bj == 0) *(u32x4*)(Km + row * 1536 + u.pn * 192 + c) = w; else *(u32x4*)(Vm + row * 1024 + u.pn * 128 + c) = w; }
                asm volatile("" ::: "memory"); }
    }
};
struct EpiResid {
    static constexpr bool PERM = false;
    const float* X; float* Y; float alpha;
    __device__ __forceinline__ void operator()(const f32x4 (&acc)[2][2][4][2], const Unit& u, int wr, int wc, int fr, int fq) const {
        const int row0 = u.pm * BM + wr * 64 + fr, col0 = u.pn * BM + wc * 32 + 4 * fq;
#pragma unroll
        for (int ai = 0; ai < 2; ++ai)
#pragma unroll
            for (int m = 0; m < 4; ++m) { const size_t off = (size_t)(row0 + ai * HALF + m * 16) * 2048 + col0;
#pragma unroll
                for (int bj = 0; bj < 2; ++bj)
#pragma unroll
                    for (int n = 0; n < 2; ++n) { const f32x4 xv = *(const f32x4*)(X + off + bj * HALF + n * 16); *(f32x4*)(Y + off + bj * HALF + n * 16) = xv * alpha + acc[ai][bj][m][n]; }
                if (m & 1) asm volatile("" ::: "memory"); }
    }
};
struct EpiSwiglu {
    static constexpr bool PERM = true;
    bf16_t* O;
    __device__ __forceinline__ void operator()(const f32x4 (&acc)[2][2][4][2], const Unit& u, int wr, int wc, int fr, int fq) const {
        const int row0 = u.pm * BM + wr * 64 + fr, col0 = u.pn * HALF + wc * 32 + 8 * fq;
#pragma unroll
        for (int ai = 0; ai < 2; ++ai)
#pragma unroll
            for (int m = 0; m < 4; ++m) { float h[8];
#pragma unroll
                for (int n = 0; n < 2; ++n)
#pragma unroll
                    for (int j = 0; j < 4; ++j) { const float a = acc[ai][0][m][n][j], b = acc[ai][1][m][n][j]; h[n * 4 + j] = a * __builtin_amdgcn_rcpf(1.f + __expf(-a)) * b; }
                u32x4 w; w.x = cvt_pk_bf16(h[0], h[1]); w.y = cvt_pk_bf16(h[2], h[3]); w.z = cvt_pk_bf16(h[4], h[5]); w.w = cvt_pk_bf16(h[6], h[7]);
                *(u32x4*)(O + (size_t)(row0 + ai * HALF + m * 16) * 1536 + col0) = w; }
    }
};
struct EpiSwigluF8 {
    static constexpr bool PERM = true;
    unsigned char* O;
    __device__ __forceinline__ void operator()(const f32x4 (&acc)[2][2][4][2], const Unit& u, int wr, int wc, int fr, int fq) const {
        const int row0 = u.pm * BM + wr * 64 + fr, col0 = u.pn * HALF + wc * 32 + 8 * fq;
#pragma unroll
        for (int ai = 0; ai < 2; ++ai)
#pragma unroll
            for (int m = 0; m < 4; ++m) { float h[8];
#pragma unroll
                for (int n = 0; n < 2; ++n)
#pragma unroll
                    for (int j = 0; j < 4; ++j) { const float a = acc[ai][0][m][n][j], b = acc[ai][1][m][n][j]; h[n * 4 + j] = a * __builtin_amdgcn_rcpf(1.f + __expf(-a)) * b; }
                int w0 = __builtin_amdgcn_cvt_pk_fp8_f32(h[0], h[1], 0, false); w0 = __builtin_amdgcn_cvt_pk_fp8_f32(h[2], h[3], w0, true);
                int w1 = __builtin_amdgcn_cvt_pk_fp8_f32(h[4], h[5], 0, false); w1 = __builtin_amdgcn_cvt_pk_fp8_f32(h[6], h[7], w1, true);
                u32x2 w; w.x = (unsigned)w0; w.y = (unsigned)w1;
                *(u32x2*)(O + (size_t)(row0 + ai * HALF + m * 16) * 1536 + col0) = w; }
    }
};
struct EpiGate {
    static constexpr bool PERM = true;
    bf16_t* O; const float* gate;
    __device__ __forceinline__ void operator()(const f32x4 (&acc)[2][2][4][2], const Unit& u, int wr, int wc, int fr, int fq) const {
        const int row0 = u.pm * BM + wr * 64 + fr, col0 = u.pn * BM + wc * 32 + 8 * fq;
#pragma unroll
        for (int ai = 0; ai < 2; ++ai)
#pragma unroll
            for (int m = 0; m < 4; ++m) { const int row = row0 + ai * HALF + m * 16; const float gt = gate[row]; bf16_t* rowp = O + (size_t)row * 2048 + col0;
#pragma unroll
                for (int bj = 0; bj < 2; ++bj) { const f32x4 v0 = acc[ai][bj][m][0] * gt, v1 = acc[ai][bj][m][1] * gt;
                    u32x4 w; w.x = cvt_pk_bf16(v0[0], v0[1]); w.y = cvt_pk_bf16(v0[2], v0[3]); w.z = cvt_pk_bf16(v1[0], v1[1]); w.w = cvt_pk_bf16(v1[2], v1[3]);
                    *(u32x4*)(rowp + bj * HALF) = w; } }
    }
};
}
namespace attn {
constexpr int NW = 8, QBLK = 32, KVBLK = 64, DV = 128;
#define SBAR() __builtin_amdgcn_sched_barrier(0)
__device__ __forceinline__ int crow(int r, int hi) { return (r & 3) + 8 * (r >> 2) + 4 * hi; }
template <int DQK> __device__ __forceinline__ int kswz(int row, int colB) {
    if constexpr (DQK == 128) return row * 256 + (colB ^ ((row & 15) << 4));
    else return row * (DQK * 2) + (colB ^ (((row >> 1) & 7) << 4));
}
template <int DQK> struct Shm { static constexpr int V = KVBLK * DV * 2, K = KVBLK * DQK * 2, TOTAL = 3 * V + 3 * K + NW * 64 * 4; };

template <float const& CREF> struct Dummy {};
__device__ __forceinline__ void partialSM(f32x16& p0, f32x16& p1, float& m_reg, float& mn, float& alpha, const float C, const float thr) {
  float pmax = p0[0];
#pragma unroll
  for (int r = 1; r < 16; ++r) pmax = fmaxf(pmax, p0[r]);
#pragma unroll
  for (int r = 0; r < 16; ++r) pmax = fmaxf(pmax, p1[r]);
  { auto rr = __builtin_amdgcn_permlane32_swap(__float_as_uint(pmax), __float_as_uint(pmax), false, false);
    pmax = fmaxf(__uint_as_float(rr[0]), __uint_as_float(rr[1])); }
  if (__builtin_expect(__all(pmax - m_reg <= thr), 1)) { mn = m_reg; alpha = 1.f; }
  else { mn = fmaxf(m_reg, pmax); alpha = __builtin_amdgcn_exp2f((m_reg - mn) * C); m_reg = mn; }
  float mnC = -mn * C;
#pragma unroll
  for (int r = 0; r < 16; ++r) p0[r] = fmaf(p0[r], C, mnC);
#pragma unroll
  for (int r = 0; r < 16; ++r) p1[r] = fmaf(p1[r], C, mnC);
#pragma unroll
  for (int r = 0; r < 16; ++r) p0[r] = __builtin_amdgcn_exp2f(p0[r]);
}
__device__ __forceinline__ void finishSM(f32x16& p0, f32x16& p1, float alpha, float& l_reg, bf16x8& pa0, bf16x8& pa1, bf16x8& pa2, bf16x8& pa3) {
#pragma unroll
  for (int r = 0; r < 16; ++r) p1[r] = __builtin_amdgcn_exp2f(p1[r]);
  float ps = 0;
#pragma unroll
  for (int r = 0; r < 16; ++r) ps += p0[r];
#pragma unroll
  for (int r = 0; r < 16; ++r) ps += p1[r];
  { auto rr = __builtin_amdgcn_permlane32_swap(__float_as_uint(ps), __float_as_uint(ps), false, false);
    ps = __uint_as_float(rr[0]) + __uint_as_float(rr[1]); }
  l_reg = l_reg * alpha + ps;
#define PK4(P, BASE, OUT) do { unsigned a0 = cvt_pk_bf16(P[BASE + 0], P[BASE + 1]), a1 = cvt_pk_bf16(P[BASE + 2], P[BASE + 3]);   \
    unsigned b0 = cvt_pk_bf16(P[BASE + 4], P[BASE + 5]), b1 = cvt_pk_bf16(P[BASE + 6], P[BASE + 7]);                              \
    auto r0 = __builtin_amdgcn_permlane32_swap(a0, b0, false, false); auto r1 = __builtin_amdgcn_permlane32_swap(a1, b1, false, false); \
    u32x4 w = {r0[0], r1[0], r0[1], r1[1]}; OUT = *reinterpret_cast<bf16x8*>(&w); } while (0)
  PK4(p0, 0, pa0); PK4(p0, 8, pa1); PK4(p1, 0, pa2); PK4(p1, 8, pa3);
#undef PK4
}
template <int DQK>
__device__ __forceinline__ void qkt(f32x16& p0, f32x16& p1, const char* Ks, const bf16x8* qr, int r32, int hi) {
  p0 = f32x16{}; p1 = f32x16{};
#pragma unroll
  for (int d0 = 0; d0 < DQK / 16; ++d0) { int cb = (d0 * 16 + hi * 8) * 2;
    bf16x8 b0 = *reinterpret_cast<const bf16x8*>(Ks + kswz<DQK>(r32, cb));
    bf16x8 b1 = *reinterpret_cast<const bf16x8*>(Ks + kswz<DQK>(32 + r32, cb));
    p0 = __builtin_amdgcn_mfma_f32_32x32x16_bf16(b0, qr[d0], p0, 0, 0, 0);
    p1 = __builtin_amdgcn_mfma_f32_32x32x16_bf16(b1, qr[d0], p1, 0, 0, 0); }
}
__device__ __forceinline__ int v_st(int k, int c) { const int kk = (k & ~0xC) | ((k & 4) << 1) | ((k & 8) >> 1); return ((kk >> 3) * 4 + (c >> 5)) * 512 + ((kk & 7) * 32 + (c & 31)) * 2; }
__device__ __forceinline__ int v_rd_base(int lane) { return ((lane & 3) << 3) | (((lane >> 2) & 3) << 6) | (((lane >> 4) & 1) << 5) | (((lane >> 5) & 1) << 8); }
constexpr int v_rd_off(int d0, int ks, int half) { return d0 * 512 + ks * 4096 + half * 2048; }
template <int OFF> __device__ __forceinline__ s16x4 tr_read(int vb) {
  s16x4 r; asm volatile("ds_read_b64_tr_b16 %0, %1 offset:%2" : "=&v"(r) : "v"(vb), "i"(OFF) : "memory"); return r;
}
template <int D0> __device__ __forceinline__ void pv_one(f32x16& od, int vb, bf16x8 pa0, bf16x8 pa1, bf16x8 pa2, bf16x8 pa3) {
  const s16x4 l0 = tr_read<v_rd_off(D0, 0, 0)>(vb), h0 = tr_read<v_rd_off(D0, 0, 1)>(vb), l1 = tr_read<v_rd_off(D0, 1, 0)>(vb), h1 = tr_read<v_rd_off(D0, 1, 1)>(vb);
  const s16x4 l2 = tr_read<v_rd_off(D0, 2, 0)>(vb), h2 = tr_read<v_rd_off(D0, 2, 1)>(vb), l3 = tr_read<v_rd_off(D0, 3, 0)>(vb), h3 = tr_read<v_rd_off(D0, 3, 1)>(vb);
  asm volatile("s_waitcnt lgkmcnt(0)" ::: "memory"); SBAR();
#define PK(L, H) (bf16x8){L[0], L[1], L[2], L[3], H[0], H[1], H[2], H[3]}
  od = __builtin_amdgcn_mfma_f32_32x32x16_bf16(pa0, PK(l0, h0), od, 0, 0, 0);
  od = __builtin_amdgcn_mfma_f32_32x32x16_bf16(pa1, PK(l1, h1), od, 0, 0, 0);
  od = __builtin_amdgcn_mfma_f32_32x32x16_bf16(pa2, PK(l2, h2), od, 0, 0, 0);
  od = __builtin_amdgcn_mfma_f32_32x32x16_bf16(pa3, PK(l3, h3), od, 0, 0, 0);
#undef PK
}
__device__ __forceinline__ void pv_d0(f32x16* o, int vb, bf16x8 pa0, bf16x8 pa1, bf16x8 pa2, bf16x8 pa3) {
  pv_one<0>(o[0], vb, pa0, pa1, pa2, pa3); pv_one<1>(o[1], vb, pa0, pa1, pa2, pa3); pv_one<2>(o[2], vb, pa0, pa1, pa2, pa3); pv_one<3>(o[3], vb, pa0, pa1, pa2, pa3);
}

__device__ __forceinline__ void glds16(const void* gsrc, unsigned lds_dst) { unsigned keep;
  asm volatile("s_mov_b32 %0, m0\n\ts_mov_b32 m0, %2\n\ts_nop 0\n\tglobal_load_lds_dwordx4 %1, off\n\ts_mov_b32 m0, %0" : "=&s"(keep) : "v"(gsrc), "s"(lds_dst) : "memory"); }
#define ATT_WAIT_BAR(N) asm volatile("s_waitcnt vmcnt(" #N ") lgkmcnt(0)\n\ts_barrier" ::: "memory")
__device__ __forceinline__ int nx3(int s) { return s == 2 ? 0 : s + 1; }
template <int DQK, int LDQ, int LDK, int LDV, int LDO>
__device__ __forceinline__ void attn_unit(const bf16_t* __restrict__ Qb, const bf16_t* __restrict__ Kh, const bf16_t* __restrict__ Vh, unsigned char* __restrict__ Ob, int seq, char* lds) {
  constexpr float scale = (DQK == 128) ? 0.08838834764831845f : 0.07216878364870323f;
  constexpr int SHM_V = KVBLK * DV * 2, SHM_K = KVBLK * DQK * 2, NQ = DQK / 16, NKP = SHM_K / 8192;
  constexpr int KRING = 0, VRING = 3 * SHM_K, WSOFF = 3 * SHM_K + 3 * SHM_V;
  constexpr float C = scale * 1.4426950408889634f, thr = 8.f / scale;
  int tid_ = threadIdx.x; asm volatile("" : "+v"(tid_));
  const int tid = tid_, lane = tid & 63, r32 = lane & 31, hi = lane >> 5; const int wid = __builtin_amdgcn_readfirstlane(tid >> 6);
  const unsigned lds0 = (unsigned)(uintptr_t)lds;
  float* ws = (float*)(lds + WSOFF) + wid * 64; float* li_l = ws; float* al_l = ws + 32;
  float m_reg = -1e30f, l_reg = 0; f32x16 o[4] = {}; bf16x8 qr[NQ];
  const bf16_t* Qw = Qb + (long)(wid * QBLK + r32) * LDQ + hi * 8;
#pragma unroll
  for (int d0 = 0; d0 < NQ; ++d0) qr[d0] = *reinterpret_cast<const bf16x8*>(Qw + d0 * 16);
  int koff[NKP], voff[2];
#pragma unroll
  for (int p = 0; p < NKP; ++p) { const int P = (p * 8 + wid) * 1024 + lane * 16, row = P / (DQK * 2), cs = P % (DQK * 2);
    const int colB = (DQK == 128) ? (cs ^ ((row & 15) << 4)) : (cs ^ (((row >> 1) & 7) << 4)); koff[p] = row * LDK + (colB >> 1); }
#pragma unroll
  for (int p = 0; p < 2; ++p) { const int P = (p * 8 + wid) * 1024 + lane * 16, sub = P >> 9, w5 = P & 511, kk = (sub >> 2) * 8 + (w5 >> 6), c = (sub & 3) * 32 + ((w5 & 63) >> 1);
    const int k = (kk & ~0xC) | ((kk & 4) << 1) | ((kk & 8) >> 1); voff[p] = k * LDV + c; }
#define DMA_K(t, slot) do { _Pragma("unroll") for (int p = 0; p < NKP; ++p) glds16(Kh + (long)(t) * KVBLK * LDK + koff[p], (unsigned)__builtin_amdgcn_readfirstlane((int)(lds0 + KRING + (slot) * SHM_K + (p * 8 + wid) * 1024))); } while (0)
#define DMA_V(t, slot) do { _Pragma("unroll") for (int p = 0; p < 2; ++p) glds16(Vh + (long)(t) * KVBLK * LDV + voff[p], (unsigned)__builtin_amdgcn_readfirstlane((int)(lds0 + VRING + (slot) * SHM_V + (p * 8 + wid) * 1024))); } while (0)
#define RESC(a) do { if (__any((a) < 1.f)) { if (hi == 0) al_l[r32] = (a); asm volatile("s_waitcnt lgkmcnt(0)" ::: "memory"); \
    _Pragma("unroll") for (int d = 0; d < 4; ++d) _Pragma("unroll") for (int r = 0; r < 16; ++r) o[d][r] *= al_l[crow(r, hi)]; } } while (0)
#define CLOSE(t) do { if ((t) + 2 < NT) { if constexpr (NKP == 2) ATT_WAIT_BAR(4); else ATT_WAIT_BAR(5); } else ATT_WAIT_BAR(0); } while (0)
  const int vb0 = (int)(lds0 + VRING) + v_rd_base(lane);
  const char* Kr = lds + KRING;
  f32x16 pA0, pA1, pB0, pB1; float mnA, mnB, alA, alB; bf16x8 pa0, pa1, pa2, pa3; const int NT = seq / KVBLK;
  DMA_K(0, 0); DMA_V(0, 0); DMA_K(1, 1);
  if constexpr (NKP == 2) ATT_WAIT_BAR(2); else ATT_WAIT_BAR(3);
  DMA_K(2, 2); DMA_V(1, 1);
  qkt<DQK>(pA0, pA1, Kr, qr, r32, hi); partialSM(pA0, pA1, m_reg, mnA, alA, C, thr);
  CLOSE(0);
  int sk = 1;
  for (int j = 1; j + 1 < NT; j += 2) {
    { const int s1 = nx3(sk), s2 = nx3(s1);
      if (j + 2 < NT) DMA_K(j + 2, s2); DMA_V(j + 1, s1);
      SBAR(); qkt<DQK>(pB0, pB1, Kr + sk * SHM_K, qr, r32, hi);
      finishSM(pA0, pA1, alA, l_reg, pa0, pa1, pa2, pa3); SBAR();
      pv_d0(o, vb0 + s2 * SHM_V, pa0, pa1, pa2, pa3); partialSM(pB0, pB1, m_reg, mnB, alB, C, thr);
      RESC(alB); CLOSE(j); sk = s1; }
    { const int s1 = nx3(sk), s2 = nx3(s1);
      if (j + 3 < NT) DMA_K(j + 3, s2); if (j + 2 < NT) DMA_V(j + 2, s1);
      SBAR(); qkt<DQK>(pA0, pA1, Kr + sk * SHM_K, qr, r32, hi);
      finishSM(pB0, pB1, alB, l_reg, pa0, pa1, pa2, pa3); SBAR();
      pv_d0(o, vb0 + s2 * SHM_V, pa0, pa1, pa2, pa3); partialSM(pA0, pA1, m_reg, mnA, alA, C, thr);
      RESC(alA); CLOSE(j + 1); sk = s1; }
  }
  { const int s1 = nx3(sk), s2 = nx3(s1);
    SBAR(); qkt<DQK>(pB0, pB1, Kr + sk * SHM_K, qr, r32, hi);
    finishSM(pA0, pA1, alA, l_reg, pa0, pa1, pa2, pa3); SBAR();
    pv_d0(o, vb0 + s2 * SHM_V, pa0, pa1, pa2, pa3); partialSM(pB0, pB1, m_reg, mnB, alB, C, thr);
    RESC(alB);
    finishSM(pB0, pB1, alB, l_reg, pa0, pa1, pa2, pa3); SBAR();
    pv_d0(o, vb0 + sk * SHM_V, pa0, pa1, pa2, pa3); (void)s1; }
  if (hi == 0) li_l[r32] = l_reg; asm volatile("s_waitcnt lgkmcnt(0)" ::: "memory");
  float rli[16];
#pragma unroll
  for (int r = 0; r < 16; ++r) rli[r] = __builtin_amdgcn_rcpf(li_l[crow(r, hi)]);
  unsigned char* Ow = Ob + (long)(wid * QBLK) * LDO;
#pragma unroll
  for (int r = 0; r < 16; ++r) { int orow = crow(r, hi); const float sc = rli[r] * 32.f;
#pragma unroll
    for (int d0 = 0; d0 < 4; ++d0) { const float v = o[d0][r] * sc; Ow[(long)orow * LDO + d0 * 32 + r32] = (unsigned char)__builtin_amdgcn_cvt_pk_fp8_f32(v, v, 0, false); } }
  ATT_WAIT_BAR(0);
#undef DMA_K
#undef DMA_V
#undef RESC
#undef CLOSE
}
}
constexpr int BATCH = 4, SEQ = 4096, DM = 2048, M = BATCH * SEQ, DEPTH = 4;
constexpr int NEXP = 16, FF = 1536, CAP = 512, MX = NEXP * BATCH * CAP;
constexpr int HW = 4096;
constexpr int C_CQ = 0, C_CKV = 512, C_GQ = 768, C_GK = 1280, C_GV = 1792, C_GR = 2816, C_KR = 3840, C_LAT = 3904;
constexpr float LN_EPS = 1e-5f, RMS_EPS = 1e-6f;
constexpr float DN_ALPHA = 1.681792830507429f;
constexpr float MLA_SCALE = 0.07216878364870323f;
constexpr float GQA_SCALE = 0.08838834764831845f;

constexpr size_t MiB = 1u << 20;
constexpr size_t WS_CTL = 0, CTL_ZERO_BYTES = 1 * MiB;
constexpr size_t WS_ROPER = 1 * MiB, WS_ROPEG = 2 * MiB, WS_AFF = 4 * MiB, WS_IDX = 5 * MiB, WS_GATE = 5 * MiB + 512 * 1024, WS_SLOT = 6 * MiB, WS_DECAY = 7 * MiB;
constexpr size_t WS_WIN = 8 * MiB, WS_WUQ = 40 * MiB, WS_WUKV = 43 * MiB, WS_WMO = 48 * MiB, WS_WQKV = 64 * MiB, WS_WGO = 88 * MiB, WS_W13 = 104 * MiB, WS_W2 = 872 * MiB;
constexpr size_t WS_XB = 1256 * MiB, WS_X1 = 1320 * MiB, WS_X1B = 1448 * MiB, WS_H = 1512 * MiB, WS_QM = 1640 * MiB, WS_KM = 1688 * MiB, WS_VM = 1736 * MiB, WS_OCAT = 1768 * MiB;
constexpr size_t WS_QIN = 1832 * MiB, WS_KIN = 1864 * MiB, WS_KST = 1896 * MiB, WS_VT = 1928 * MiB, WS_OF = 1960 * MiB, WS_OB = 2024 * MiB, WS_HDN = 2088 * MiB, WS_Y = 2184 * MiB, WS_END = 2312 * MiB;
constexpr int CW_TMO = 0, CW_DBG = 2, CW_BAR = 4096;

constexpr int RING_BYTES = 131072, MISC_OFF = RING_BYTES + 320, LDS_BYTES = 147456;
constexpr int NWAVES = 8, NTHR = 512;

#define RLX_AGENT __ATOMIC_RELAXED, __HIP_MEMORY_SCOPE_AGENT
#define LDS_WAIT() asm volatile("s_waitcnt lgkmcnt(0)" ::: "memory")
#define VM_WAIT() asm volatile("s_waitcnt vmcnt(0)" ::: "memory")

#define XB_TMO      128
#define XB_XCNT(j)  (256  + 64 * (j))
#define XB_XSUB(j)  (1280 + 64 * (j))
#define XB_XGEN(j)  (2304 + 64 * (j))
#define XB_TOP      3328
#define XB_TOPGEN   3392
#define XCD_BAR_WORDS 3456
#define XB_SPIN_CAP (1u << 22)
__device__ __forceinline__ unsigned xb_ld(unsigned* p)              { return __hip_atomic_load(p, __ATOMIC_RELAXED, __HIP_MEMORY_SCOPE_AGENT); }
__device__ __forceinline__ unsigned xb_add(unsigned* p, unsigned v) { return __hip_atomic_fetch_add(p, v, __ATOMIC_RELAXED, __HIP_MEMORY_SCOPE_AGENT); }
__device__ __forceinline__ unsigned xb_xcc_id() { return (unsigned)__builtin_amdgcn_s_getreg((3 << 11) | 20) & 0xFu; }
#define XB_SPIN(cond, bar) do { unsigned _sp = 0; while (cond) { __builtin_amdgcn_s_sleep(1); \
    if ((++_sp & 255u) == 0u) { if (xb_ld(&(bar)[XB_TMO])) break; if (_sp > XB_SPIN_CAP) { atomicAdd(&(bar)[XB_TMO], 1u); break; } } } } while (0)
struct XcdBarrier { unsigned* bar; unsigned x; volatile LAS unsigned* st; };
__device__ __forceinline__ XcdBarrier xcd_barrier_post(unsigned* bar, volatile LAS unsigned* st) {
    XcdBarrier b; b.bar = bar; b.x = xb_xcc_id(); b.st = st;
    if (threadIdx.x == 0) (void)xb_add(&bar[XB_XCNT(b.x)], 1u);
    return b;
}
__device__ __forceinline__ void xcd_barrier_complete(unsigned* bar, unsigned x, unsigned& nloc, unsigned& nx) {
    const unsigned G = gridDim.x * gridDim.y * gridDim.z;
    unsigned sum, cnt, mine, sp = 0u;
    for (;;) {
        sum = 0u; cnt = 0u; mine = 0u;
#pragma unroll
        for (unsigned j = 0; j < 16; ++j) { const unsigned c = xb_ld(&bar[XB_XCNT(j)]); sum += c; cnt += (c > 0u) ? 1u : 0u; mine = (j == x) ? c : mine; }
        if (sum == G) break;
        __builtin_amdgcn_s_sleep(1);
        if ((++sp & 255u) == 0u) { if (xb_ld(&bar[XB_TMO])) break; if (sp > XB_SPIN_CAP) { atomicAdd(&bar[XB_TMO], 1u); break; } }
    }
    nloc = mine > 0u ? mine : 1u; nx = cnt > 0u ? cnt : 1u;
}
__device__ __forceinline__ void xcd_barrier(const XcdBarrier& b) {
    asm volatile("s_waitcnt vmcnt(0)" ::: "memory");
    __syncthreads();
    if (threadIdx.x == 0) {
        unsigned* bar = b.bar;
        __builtin_amdgcn_s_waitcnt(0);
        unsigned nloc = b.st[0], nx = b.st[1];
        if (nloc == 0u) { xcd_barrier_complete(bar, b.x, nloc, nx); b.st[0] = nloc; b.st[1] = nx; }
        const unsigned old = xb_add(&bar[XB_XSUB(b.x)], 1u);
        const unsigned gen = old / nloc;
        if (old + 1u == (gen + 1u) * nloc) {
            __builtin_amdgcn_fence(__ATOMIC_RELEASE, "agent");
            asm volatile("s_waitcnt vmcnt(0)" ::: "memory");
            const unsigned og = xb_add(&bar[XB_TOP], 1u);
            const unsigned tg = og / nx;
            if (og + 1u == (tg + 1u) * nx) xb_add(&bar[XB_TOPGEN], 1u);
            else XB_SPIN(xb_ld(&bar[XB_TOPGEN]) == tg, bar);
            __builtin_amdgcn_fence(__ATOMIC_ACQUIRE, "agent");
            xb_add(&bar[XB_XGEN(b.x)], 1u);
            asm volatile("s_waitcnt vmcnt(0)" ::: "memory");
        } else {
            XB_SPIN(xb_ld(&bar[XB_XGEN(b.x)]) == gen, bar);
            __builtin_amdgcn_fence(__ATOMIC_ACQUIRE, "agent");
            asm volatile("s_waitcnt vmcnt(0)" ::: "memory");
        }
    }
    __syncthreads();
}

template <int CTRL, int ROWMASK> __device__ __forceinline__ float dpp_addf(float x) { return x + __int_as_float(__builtin_amdgcn_update_dpp(0, __float_as_int(x), CTRL, ROWMASK, 0xF, true)); }
template <int CTRL, int ROWMASK> __device__ __forceinline__ int dpp_addi(int x) { return x + __builtin_amdgcn_update_dpp(0, x, CTRL, ROWMASK, 0xF, true); }
__device__ __forceinline__ float row16_sum(float v) { v = dpp_addf<0xB1, 0xF>(v); v = dpp_addf<0x4E, 0xF>(v); v = dpp_addf<0x141, 0xF>(v); v = dpp_addf<0x140, 0xF>(v); return v; }
__device__ __forceinline__ float wave_sum(float v) {
    v = row16_sum(v); v = dpp_addf<0x142, 0xA>(v); v = dpp_addf<0x143, 0xC>(v);
    return __int_as_float(__builtin_amdgcn_readlane(__float_as_int(v), 63));
}
__device__ __forceinline__ int wave_sum_i(int v) {
    v = dpp_addi<0xB1, 0xF>(v); v = dpp_addi<0x4E, 0xF>(v); v = dpp_addi<0x141, 0xF>(v); v = dpp_addi<0x140, 0xF>(v); v = dpp_addi<0x142, 0xA>(v); v = dpp_addi<0x143, 0xC>(v);
    return __builtin_amdgcn_readlane(v, 63);
}
#define WG_BAR() do { asm volatile("s_waitcnt lgkmcnt(0)" ::: "memory"); __builtin_amdgcn_s_barrier(); asm volatile("" ::: "memory"); } while (0)

struct Ctx { LAS unsigned char* lds; int tid, lane, wave, vcu, G; };
__device__ __forceinline__ Ctx opaque_ctx(const Ctx& c) { Ctx d = c; asm volatile("" : "+v"(d.tid)); d.lane = d.tid & 63; d.wave = __builtin_amdgcn_readfirstlane(d.tid >> 6); return d; }

__device__ __forceinline__ void transpose_item(const float* W, int K, int N, bf16_t* WT, int dst_row0, int k0, int n0, LAS unsigned* scr, int lane) {
    const int r2 = lane >> 4, c4 = lane & 15; const bool ok = (n0 + 4 * c4) < N;
    const float* src = W + (size_t)(k0 + 2 * r2) * N + n0 + 4 * c4;
#pragma unroll
    for (int i = 0; i < 8; ++i) { f32x4 a = {0.f, 0.f, 0.f, 0.f}, b = {0.f, 0.f, 0.f, 0.f};
        if (ok) { a = __builtin_nontemporal_load((const f32x4*)(src + (size_t)(8 * i) * N)); b = __builtin_nontemporal_load((const f32x4*)(src + (size_t)(8 * i + 1) * N)); }
        const int p = 4 * i + r2;
#pragma unroll
        for (int j = 0; j < 4; ++j) scr[(4 * c4 + j) * 33 + p] = cvt_pk_bf16(a[j], b[j]); }
    LDS_WAIT(); asm volatile("" ::: "memory");
    const int nvalid = (N - n0) < 64 ? (N - n0) : 64;
#pragma unroll
    for (int q = 0; q < 8; ++q) { const int ci = lane + 64 * q, n = ci >> 3, ch = ci & 7; const LAS unsigned* s = scr + n * 33 + ch * 4;
        const u32x4 o = {s[0], s[1], s[2], s[3]};
        if (n < nvalid) __builtin_nontemporal_store(o, (u32x4*)(WT + (size_t)(dst_row0 + n) * K + k0 + 8 * ch)); }
    LDS_WAIT(); asm volatile("" ::: "memory");
}
__device__ __forceinline__ int map_row(int map, int n0) {
    if (map == 1) return (n0 < 768) ? n0 : (n0 < 832 ? n0 + 3072 : (n0 < 3904 ? n0 - 64 : n0));
    if (map == 2) return (n0 >> 7) * 256 + (n0 & 127);
    if (map == 3) return (n0 >> 7) * 256 + 128 + (n0 & 127);
    return n0;
}
__device__ __forceinline__ void transpose_batch(const Ctx& c, const float* src, bf16_t* dst, int K, int N, int nmat, size_t src_ms, size_t dst_ms, int map, int wg_rank = -1, int wg_count = 0) {
    LAS unsigned* scr = (LAS unsigned*)(c.lds + c.wave * 16384);
    const int gw = (wg_rank < 0 ? c.vcu : wg_rank) * NWAVES + c.wave, NGW = (wg_rank < 0 ? c.G : wg_count) * NWAVES;
    const int nblk = (N + 63) / 64, per = (K / 64) * nblk; const long total = (long)per * nmat;
    for (long it = gw; it < total; it += NGW) {
        const int mat = (int)(it / per), r = (int)(it % per), kb = r / nblk, nb = r % nblk;
        transpose_item(src + (size_t)mat * src_ms, K, N, dst + (size_t)mat * dst_ms, map_row(map, nb * 64), kb * 64, nb * 64, scr, c.lane);
    }
}

__device__ __forceinline__ void transpose_item_f8(const float* W, int K, int N, unsigned char* WT, int dst_row0, int k0, int n0, float mul, LAS unsigned* scr, int lane) {
    const int r2 = lane >> 4, c4 = lane & 15;
    const float* src = W + (size_t)(k0 + 4 * r2) * N + n0 + 4 * c4;
#pragma unroll
    for (int i = 0; i < 4; ++i) { const float* s_ = src + (size_t)(16 * i) * N;
        const f32x4 a = __builtin_nontemporal_load((const f32x4*)s_), b = __builtin_nontemporal_load((const f32x4*)(s_ + N)), cc = __builtin_nontemporal_load((const f32x4*)(s_ + 2 * (size_t)N)), d = __builtin_nontemporal_load((const f32x4*)(s_ + 3 * (size_t)N));
        const int p = 4 * i + r2;
#pragma unroll
        for (int j = 0; j < 4; ++j) { int w = __builtin_amdgcn_cvt_pk_fp8_f32(a[j] * mul, b[j] * mul, 0, false); w = __builtin_amdgcn_cvt_pk_fp8_f32(cc[j] * mul, d[j] * mul, w, true); scr[(4 * c4 + j) * 17 + p] = (unsigned)w; } }
    LDS_WAIT(); asm volatile("" ::: "memory");
#pragma unroll
    for (int q = 0; q < 4; ++q) { const int ci = lane + 64 * q, n = ci >> 2, ch = ci & 3; const LAS unsigned* s = scr + n * 17 + ch * 4;
        const u32x4 o = {s[0], s[1], s[2], s[3]};
        __builtin_nontemporal_store(o, (u32x4*)(WT + (size_t)(dst_row0 + n) * K + k0 + 16 * ch)); }
    LDS_WAIT(); asm volatile("" ::: "memory");
}
__device__ __forceinline__ void transpose_batch_f8(const Ctx& c, const float* src, unsigned char* dst, int K, int N, int nmat, size_t src_ms, size_t dst_ms, int map, float mul, int wg_rank = -1, int wg_count = 0, int ksplit = 1 << 30, float mul_hi = 0.f) {
    LAS unsigned* scr = (LAS unsigned*)(c.lds + c.wave * 16384);
    const int gw = (wg_rank < 0 ? c.vcu : wg_rank) * NWAVES + c.wave, NGW = (wg_rank < 0 ? c.G : wg_count) * NWAVES;
    const int nblk = N / 64, per = (K / 64) * nblk; const long total = (long)per * nmat;
    for (long it = gw; it < total; it += NGW) {
        const int mat = (int)(it / per), r = (int)(it % per), kb = r / nblk, nb = r % nblk;
        transpose_item_f8(src + (size_t)mat * src_ms, K, N, dst + (size_t)mat * dst_ms, map_row(map, nb * 64), kb * 64, nb * 64, (kb * 64 >= ksplit) ? mul_hi : mul, scr, c.lane);
    }
}

__device__ __forceinline__ void fill_rope(const Ctx& c, f32x2* tabR, f32x2* tabG) {
    const int gt = (c.vcu * NTHR + c.tid), NT = c.G * NTHR;
    for (int i = gt; i < SEQ * 32; i += NT) { const int t = i >> 5, p = i & 31, j = p & 15; const float inv = exp2f(-(float)(2 * j) * (13.287712379549449f / 32.f));
        const float pos = (float)(p < 16 ? (t >> 6) : (t & 63)); const float a = pos * inv; tabR[i] = (f32x2){cosf(a), sinf(a)}; }
    for (int i = gt; i < SEQ * 64; i += NT) { const int t = i >> 6, p = i & 63, j = p & 31; const float inv = exp2f(-(float)(2 * j) * (13.287712379549449f / 64.f));
        const float pos = (float)(p < 32 ? (t >> 6) : (t & 63)); const float a = pos * inv; tabG[i] = (f32x2){cosf(a), sinf(a)}; }
}
__device__ __forceinline__ void cvt_rows_bf16(const Ctx& c, const float* x, bf16_t* xb) {
    const long gt = (long)c.vcu * NTHR + c.tid, NT = (long)c.G * NTHR, n8 = (long)M * DM / 8;
    for (long i = gt; i < n8; i += NT) { const f32x4 a = *(const f32x4*)(x + i * 8), b = *(const f32x4*)(x + i * 8 + 4);
        u32x4 w; w.x = cvt_pk_bf16(a[0], a[1]); w.y = cvt_pk_bf16(a[2], a[3]); w.z = cvt_pk_bf16(b[0], b[1]); w.w = cvt_pk_bf16(b[2], b[3]); *(u32x4*)(xb + i * 8) = w; }
}

__device__ __forceinline__ void mla_prep_rows(const Ctx& c, bf16_t* H, bf16_t* Hd, bf16_t* Km, const float* qn, const float* kvn, const f32x2* tabR) {
    const int gw = c.vcu * NWAVES + c.wave, NGW = c.G * NWAVES, lane = c.lane;
    for (int r = gw; r < M; r += NGW) {
        bf16_t* h = H + (size_t)r * HW; bf16_t* hd = Hd + (size_t)r * HW;
        { u32x4 w = *(const u32x4*)(h + C_CQ + lane * 8); float f[8] = {bf_lo(w.x), bf_hi(w.x), bf_lo(w.y), bf_hi(w.y), bf_lo(w.z), bf_hi(w.z), bf_lo(w.w), bf_hi(w.w)};
          float s = 0.f;
#pragma unroll
          for (int i = 0; i < 8; ++i) s += f[i] * f[i];
          const float rs = rsqrtf(wave_sum(s) * (1.f / 512.f) + RMS_EPS);
          const f32x4 g0 = *(const f32x4*)(qn + lane * 8), g1 = *(const f32x4*)(qn + lane * 8 + 4);
          u32x4 o; o.x = cvt_pk_bf16(f[0] * rs * g0[0], f[1] * rs * g0[1]); o.y = cvt_pk_bf16(f[2] * rs * g0[2], f[3] * rs * g0[3]);
          o.z = cvt_pk_bf16(f[4] * rs * g1[0], f[5] * rs * g1[1]); o.w = cvt_pk_bf16(f[6] * rs * g1[2], f[7] * rs * g1[3]);
          *(u32x4*)(hd + C_CQ + lane * 8) = o; }
        { u32x2 w = *(const u32x2*)(h + C_CKV + lane * 4); float f[4] = {bf_lo(w.x), bf_hi(w.x), bf_lo(w.y), bf_hi(w.y)};
          const float s = f[0] * f[0] + f[1] * f[1] + f[2] * f[2] + f[3] * f[3];
          const float rs = rsqrtf(wave_sum(s) * (1.f / 256.f) + RMS_EPS);
          const f32x4 g0 = *(const f32x4*)(kvn + lane * 4);
          u32x2 o; o.x = cvt_pk_bf16(f[0] * rs * g0[0], f[1] * rs * g0[1]); o.y = cvt_pk_bf16(f[2] * rs * g0[2], f[3] * rs * g0[3]);
          *(u32x2*)(hd + C_CKV + lane * 4) = o; }
        if (lane < 32) { const unsigned w = *(const unsigned*)(h + C_KR + 2 * lane); const float x1 = bf_lo(w), x2 = bf_hi(w); const f32x2 cs = tabR[(size_t)(r & (SEQ - 1)) * 32 + lane];
          const unsigned o = cvt_pk_bf16(x1 * cs.x - x2 * cs.y, x1 * cs.y + x2 * cs.x);
#pragma unroll
          for (int hh = 0; hh < 8; ++hh) *(unsigned*)(Km + (size_t)r * 1536 + hh * 192 + 128 + 2 * lane) = o; }
    }
}

__device__ __forceinline__ float log_sigmoid(float z) { const float e = __expf(-fabsf(z)); return fminf(z, 0.f) - __logf(1.f + e); }
constexpr int GREC_QT = 0, GREC_AT = 16384, GREC_KT = 24576, GREC_DT = 40960, GREC_BYTES = 41984;
__device__ __forceinline__ void gla_prep(const Ctx& c, const bf16_t* H, const float* w2  , const float* gb  , unsigned char* rec, bf16_t* vT) {
    constexpr int TP = 66, QP = 136;
    LAS float* cum = (LAS float*)c.lds;
    LAS bf16_t* vt_l = (LAS bf16_t*)c.lds;
    LAS bf16_t* kst_l = (LAS bf16_t*)(c.lds + 32768);
    LAS bf16_t* Ql = (LAS bf16_t*)(c.lds + 49664);
    LAS bf16_t* Kl = (LAS bf16_t*)(c.lds + 67072);
    LAS float* tot = (LAS float*)(c.lds + 84480);
    LAS bf16_t* qg = (LAS bf16_t*)(c.lds + 86528);
    LAS bf16_t* kg = (LAS bf16_t*)(c.lds + 102912);
    LAS bf16_t* latl = (LAS bf16_t*)(c.lds + 119296);
    const int tid = c.tid, qtr = tid >> 7, dk = tid & 127, lane = c.lane, w = c.wave, fr = lane & 15, fq = lane >> 4;
    for (int item = c.vcu; item < BATCH * 64 * 4; item += c.G) {
        const int hh = item & 3, bc = item >> 2;
        const size_t row0 = (size_t)bc * 64;
        const int col = hh * 128 + dk;
        u32x4 qv[2], kv[2], vv[4], lv;
#pragma unroll
        for (int q2 = 0; q2 < 2; ++q2) { const int ci = tid + 512 * q2, t = ci >> 4, ch = ci & 15; const bf16_t* hp = H + (row0 + t) * HW + hh * 128 + ch * 8;
            qv[q2] = *(const u32x4*)(hp + C_GQ); kv[q2] = *(const u32x4*)(hp + C_GK); }
#pragma unroll
        for (int q4 = 0; q4 < 4; ++q4) { const int ci = tid + 512 * q4, t = ci >> 5, ch = ci & 31; vv[q4] = *(const u32x4*)(H + (row0 + t) * HW + C_GV + hh * 256 + ch * 8); }
        if (tid < 256) lv = *(const u32x4*)(H + (row0 + (tid >> 2)) * HW + C_LAT + (tid & 3) * 8);
#pragma unroll
        for (int q2 = 0; q2 < 2; ++q2) { const int ci = tid + 512 * q2; *(LAS u32x4*)(qg + ci * 8) = qv[q2]; *(LAS u32x4*)(kg + ci * 8) = kv[q2]; }
        if (tid < 256) *(LAS u32x4*)(latl + tid * 8) = lv;
        WG_BAR();
#pragma nounroll
        for (int dir = 0; dir < 2; ++dir) {
            unsigned char* rp = rec + ((((size_t)dir * 256 + bc) * 4 + hh) * GREC_BYTES);
            float wv[16];
#pragma unroll
            for (int j = 0; j < 16; ++j) wv[j] = w2[(dir * 16 + j) * 512 + col];
            const float bias = gb[dir * 512 + col];
            float run = 0.f;
#pragma unroll 4
            for (int i = 0; i < 16; ++i) { const int t = qtr * 16 + (dir ? 15 - i : i); const LAS bf16_t* lp = latl + t * 32 + dir * 16;
                const u32x4 a = *(const LAS u32x4*)lp, b = *(const LAS u32x4*)(lp + 8);
                float z = bias;
                z += bf_lo(a.x) * wv[0] + bf_hi(a.x) * wv[1] + bf_lo(a.y) * wv[2] + bf_hi(a.y) * wv[3] + bf_lo(a.z) * wv[4] + bf_hi(a.z) * wv[5] + bf_lo(a.w) * wv[6] + bf_hi(a.w) * wv[7];
                z += bf_lo(b.x) * wv[8] + bf_hi(b.x) * wv[9] + bf_lo(b.y) * wv[10] + bf_hi(b.y) * wv[11] + bf_lo(b.z) * wv[12] + bf_hi(b.z) * wv[13] + bf_lo(b.w) * wv[14] + bf_hi(b.w) * wv[15];
                run += log_sigmoid(z) * (1.f / 16.f); cum[t * 128 + dk] = run; }
            tot[dk * 4 + qtr] = run;
            WG_BAR();
            const f32x4 tq = *(const LAS f32x4*)(tot + dk * 4);
            const float blast = (tq[0] + tq[1]) + (tq[2] + tq[3]);
            float off = 0.f;
#pragma unroll
            for (int q = 0; q < 4; ++q) off += ((dir == 0) ? (q < qtr) : (q > qtr)) ? tq[q] : 0.f;
#pragma unroll 4
            for (int i = 0; i < 16; ++i) { const int t = qtr * 16 + i;
                const float bcum = cum[t * 128 + dk] + off;
                const float q = bf2f(qg[t * 128 + dk]) * 0.08838834764831845f, k = bf2f(kg[t * 128 + dk]);
                const bf16_t qb = f2bf(q * __expf(bcum));
                { const int r5 = dk & 31, chq = 4 * (dk >> 5) + ((r5 & 15) >> 2), e8 = (r5 & 3) + ((r5 >> 4) << 2);
                  *(bf16_t*)(rp + GREC_QT + t * 256 + (((chq ^ (t & 15)) << 4) | (e8 * 2))) = qb; } Ql[t * QP + dk] = qb;
                Kl[t * QP + dk] = f2bf(k * __expf(-bcum));
                kst_l[dk * TP + t] = f2bf(k * __expf(blast - bcum)); }
            if (qtr == 0) *(float*)(rp + GREC_DT + dk * 4) = __expf(blast);
            WG_BAR();
            { const int ib = w >> 1, par = w & 1;
              const LAS bf16_t* qp = Ql + (ib * 16 + fr) * QP + 8 * fq; const LAS bf16_t* kp = Kl + (2 * par * 16 + fr) * QP + 8 * fq;
              f32x4 a0 = {0.f, 0.f, 0.f, 0.f}, a1 = {0.f, 0.f, 0.f, 0.f};
#pragma unroll
              for (int kk = 0; kk < 4; ++kk) { const bf16x8 qf = *(const LAS bf16x8*)(qp + kk * 32), k0 = *(const LAS bf16x8*)(kp + kk * 32), k1 = *(const LAS bf16x8*)(kp + 16 * QP + kk * 32);
                  a0 = __builtin_amdgcn_mfma_f32_16x16x32_bf16(k0, qf, a0, 0, 0, 0); a1 = __builtin_amdgcn_mfma_f32_16x16x32_bf16(k1, qf, a1, 0, 0, 0); }
              const int i = ib * 16 + fr, j0 = 2 * par * 16 + 4 * fq;
#pragma unroll
              for (int r = 0; r < 4; ++r) { const int j = j0 + r; a0[r] = (dir ? (j >= i) : (j <= i)) ? a0[r] : 0.f; a1[r] = (dir ? (j + 16 >= i) : (j + 16 <= i)) ? a1[r] : 0.f; }
              u32x2 w0, w1; w0.x = cvt_pk_bf16(a0[0], a0[1]); w0.y = cvt_pk_bf16(a0[2], a0[3]); w1.x = cvt_pk_bf16(a1[0], a1[1]); w1.y = cvt_pk_bf16(a1[2], a1[3]);
              unsigned char* ap = rp + GREC_AT + i * 128; const int sw = (i >> 1) & 7;
              *(u32x2*)(ap + ((((j0 >> 3) ^ sw) << 4) | ((j0 & 7) * 2))) = w0; *(u32x2*)(ap + (((((j0 + 16) >> 3) ^ sw) << 4) | ((j0 & 7) * 2))) = w1; }
#pragma unroll
            for (int q2 = 0; q2 < 2; ++q2) { const int ci = tid + 512 * q2, rowid = ci >> 3, ch = ci & 7; const LAS unsigned* sp = (const LAS unsigned*)(kst_l + rowid * TP + ch * 8);
                const u32x4 wd = {sp[0], sp[1], sp[2], sp[3]};
                *(u32x4*)(rp + GREC_KT + rowid * 128 + ((ch ^ ((rowid >> 1) & 7)) << 4)) = wd; }
            WG_BAR();
        }
#pragma unroll
        for (int q4 = 0; q4 < 4; ++q4) { const int ci = tid + 512 * q4, t = ci >> 5, d0 = (ci & 31) * 8; const u32x4 x = vv[q4];
            vt_l[(d0 + 0) * TP + t] = (bf16_t)(x.x & 0xffffu); vt_l[(d0 + 1) * TP + t] = (bf16_t)(x.x >> 16); vt_l[(d0 + 2) * TP + t] = (bf16_t)(x.y & 0xffffu); vt_l[(d0 + 3) * TP + t] = (bf16_t)(x.y >> 16);
            vt_l[(d0 + 4) * TP + t] = (bf16_t)(x.z & 0xffffu); vt_l[(d0 + 5) * TP + t] = (bf16_t)(x.z >> 16); vt_l[(d0 + 6) * TP + t] = (bf16_t)(x.w & 0xffffu); vt_l[(d0 + 7) * TP + t] = (bf16_t)(x.w >> 16); }
        WG_BAR();
#pragma unroll
        for (int q4 = 0; q4 < 4; ++q4) { const int ci = tid + 512 * q4, rowid = ci >> 3, ch = ci & 7; const LAS unsigned* sp = (const LAS unsigned*)(vt_l + rowid * TP + ch * 8);
            const u32x4 wd = {sp[0], sp[1], sp[2], sp[3]};
            *(u32x4*)(vT + ((((size_t)bc * 4 + hh) * 256 + rowid) * 64 + ch * 8)) = wd; }
        WG_BAR();
    }
}

namespace pg8 {
struct EpiQKNorm {
    static constexpr bool PERM = true;
    bf16_t* O; const float* qn; const float* kn; const f32x2* tab; LAS float* P;
    __device__ __forceinline__ void operator()(const f32x4 (&acc)[2][2][4][2], const Unit& u, int wr, int wc, int fr, int fq) const {
        const int rl0 = wr * 64 + fr, row0 = u.pm * BM + rl0, colh = wc * 32 + 8 * fq;
        const bool nrm = u.pn < 10;
        float rs[2][4][2];
        if (nrm) {
#pragma unroll
            for (int ai = 0; ai < 2; ++ai)
#pragma unroll
                for (int m = 0; m < 4; ++m)
#pragma unroll
                    for (int bj = 0; bj < 2; ++bj) { const f32x4 v0 = acc[ai][bj][m][0], v1 = acc[ai][bj][m][1];
                        float ss = (v0[0] * v0[0] + v0[1] * v0[1]) + (v0[2] * v0[2] + v0[3] * v0[3]) + (v1[0] * v1[0] + v1[1] * v1[1]) + (v1[2] * v1[2] + v1[3] * v1[3]);
                        ss += __shfl_xor(ss, 16); ss += __shfl_xor(ss, 32);
                        if (fq == 0) P[((rl0 + ai * HALF + m * 16) * 2 + bj) * 4 + wc] = ss; }
            asm volatile("s_waitcnt lgkmcnt(0)\n\ts_barrier" ::: "memory");
#pragma unroll
            for (int ai = 0; ai < 2; ++ai)
#pragma unroll
                for (int m = 0; m < 4; ++m)
#pragma unroll
                    for (int bj = 0; bj < 2; ++bj) { const f32x4 p = *(const LAS f32x4*)(P + ((rl0 + ai * HALF + m * 16) * 2 + bj) * 4); rs[ai][m][bj] = rsqrtf(((p[0] + p[1]) + (p[2] + p[3])) * (1.f / 128.f) + RMS_EPS); }
        }
        const float* gp = (u.pn < 8 ? qn : kn) + colh; f32x4 g0 = {1.f, 1.f, 1.f, 1.f}, g1 = g0; if (nrm) { g0 = *(const f32x4*)gp; g1 = *(const f32x4*)(gp + 4); }
#pragma unroll
        for (int ai = 0; ai < 2; ++ai)
#pragma unroll
            for (int m = 0; m < 4; ++m) { const int row = row0 + ai * HALF + m * 16; bf16_t* rowp = O + (size_t)row * 3072 + u.pn * BM + colh;
                f32x4 t01 = {1.f, 0.f, 1.f, 0.f}, t23 = t01; if (nrm) { const f32x2* tp = tab + (size_t)(row & (SEQ - 1)) * 64 + (colh >> 1); t01 = *(const f32x4*)tp; t23 = *(const f32x4*)(tp + 2); }
#pragma unroll
                for (int bj = 0; bj < 2; ++bj) { const f32x4 v0 = acc[ai][bj][m][0], v1 = acc[ai][bj][m][1]; u32x4 o;
                    if (nrm) { const float r_ = rs[ai][m][bj];
                        const float y0 = v0[0] * r_ * g0[0], y1 = v0[1] * r_ * g0[1], y2 = v0[2] * r_ * g0[2], y3 = v0[3] * r_ * g0[3], y4 = v1[0] * r_ * g1[0], y5 = v1[1] * r_ * g1[1], y6 = v1[2] * r_ * g1[2], y7 = v1[3] * r_ * g1[3];
                        o.x = cvt_pk_bf16(y0 * t01[0] - y1 * t01[1], y0 * t01[1] + y1 * t01[0]); o.y = cvt_pk_bf16(y2 * t01[2] - y3 * t01[3], y2 * t01[3] + y3 * t01[2]);
                        o.z = cvt_pk_bf16(y4 * t23[0] - y5 * t23[1], y4 * t23[1] + y5 * t23[0]); o.w = cvt_pk_bf16(y6 * t23[2] - y7 * t23[3], y6 * t23[3] + y7 * t23[2]); }
                    else { o.x = cvt_pk_bf16(v0[0], v0[1]); o.y = cvt_pk_bf16(v0[2], v0[3]); o.z = cvt_pk_bf16(v1[0], v1[1]); o.w = cvt_pk_bf16(v1[2], v1[3]); }
                    *(u32x4*)(rowp + bj * HALF) = o; } }
    }
};
}
__device__ __forceinline__ void gla_out_rows(const Ctx& c, const float* of, const float* ob, const bf16_t* H, const float* gn, unsigned char* Ocat) {
    const int gw = c.vcu * NWAVES + c.wave, NGW = c.G * NWAVES, lane = c.lane;
    for (int r = gw; r < M; r += NGW) {
#pragma unroll
        for (int hh = 0; hh < 4; ++hh) { const int j0 = hh * 256 + lane * 4;
            const f32x4 a = *(const f32x4*)(of + (size_t)r * 1024 + j0), b = *(const f32x4*)(ob + (size_t)r * 1024 + j0); const f32x4 s = a + b;
            const float ss = s[0] * s[0] + s[1] * s[1] + s[2] * s[2] + s[3] * s[3];
            const float rs = rsqrtf(wave_sum(ss) * (1.f / 256.f) + RMS_EPS);
            const f32x4 g = *(const f32x4*)(gn + j0); const u32x2 gw2 = *(const u32x2*)(H + (size_t)r * HW + C_GR + j0);
            const float gr[4] = {bf_lo(gw2.x), bf_hi(gw2.x), bf_lo(gw2.y), bf_hi(gw2.y)}; float o[4];
#pragma unroll
            for (int i = 0; i < 4; ++i) { const float sg = gr[i] * __builtin_amdgcn_rcpf(1.f + __expf(-gr[i])); o[i] = s[i] * rs * g[i] * sg; }
            int w = __builtin_amdgcn_cvt_pk_fp8_f32(o[0] * 4.f, o[1] * 4.f, 0, false); w = __builtin_amdgcn_cvt_pk_fp8_f32(o[2] * 4.f, o[3] * 4.f, w, true);
            *(unsigned*)(Ocat + (size_t)r * 2048 + 1024 + j0) = (unsigned)w; }
    }
}

__device__ __forceinline__ void gqa_qknorm_rows(const Ctx& c, bf16_t* H, bf16_t* Hd, const float* qn, const float* kn, const f32x2* tabG) {
    const int gw = c.vcu * NWAVES + c.wave, NGW = c.G * NWAVES, lane = c.lane, l16 = lane & 15, hg = lane >> 4;
    const f32x4 q0 = *(const f32x4*)(qn + l16 * 8), q1 = *(const f32x4*)(qn + l16 * 8 + 4), k0 = *(const f32x4*)(kn + l16 * 8), k1 = *(const f32x4*)(kn + l16 * 8 + 4);
    for (int r = gw; r < M; r += NGW) {
        const bf16_t* h = H + (size_t)r * 3072; bf16_t* hd = Hd + (size_t)r * 3072;
        const f32x2* tp = tabG + (size_t)(r & (SEQ - 1)) * 64 + l16 * 4; const f32x4 t01 = *(const f32x4*)tp, t23 = *(const f32x4*)(tp + 2);
        u32x4 wv[5];
#pragma unroll
        for (int p = 0; p < 5; ++p) wv[p] = *(const u32x4*)(h + (p * 4 + hg) * 128 + l16 * 8);
#pragma unroll
        for (int p = 0; p < 5; ++p) { const u32x4 w = wv[p];
            float f[8] = {bf_lo(w.x), bf_hi(w.x), bf_lo(w.y), bf_hi(w.y), bf_lo(w.z), bf_hi(w.z), bf_lo(w.w), bf_hi(w.w)};
            float ss = 0.f;
#pragma unroll
            for (int i = 0; i < 8; ++i) ss += f[i] * f[i];
            ss = row16_sum(ss);
            const float rs = rsqrtf(ss * (1.f / 128.f) + RMS_EPS);
            const bool isq = (p < 4);
            const f32x4 g0 = isq ? q0 : k0, g1 = isq ? q1 : k1;
            const float y0 = f[0] * rs * g0[0], y1 = f[1] * rs * g0[1], y2 = f[2] * rs * g0[2], y3 = f[3] * rs * g0[3], y4 = f[4] * rs * g1[0], y5 = f[5] * rs * g1[1], y6 = f[6] * rs * g1[2], y7 = f[7] * rs * g1[3];
            u32x4 o; o.x = cvt_pk_bf16(y0 * t01[0] - y1 * t01[1], y0 * t01[1] + y1 * t01[0]); o.y = cvt_pk_bf16(y2 * t01[2] - y3 * t01[3], y2 * t01[3] + y3 * t01[2]);
            o.z = cvt_pk_bf16(y4 * t23[0] - y5 * t23[1], y4 * t23[1] + y5 * t23[0]); o.w = cvt_pk_bf16(y6 * t23[2] - y7 * t23[3], y6 * t23[3] + y7 * t23[2]);
            *(u32x4*)(hd + (p * 4 + hg) * 128 + l16 * 8) = o; }
    }
}

__device__ __forceinline__ void ln_router_rows(const Ctx& c, const bf16_t* Xres, const bf16_t* Mb, bf16_t* X1b, unsigned char* X1f8, const float* g, const float* bb, const float* wr  , float* aff) {
    LAS float* Wl = (LAS float*)c.lds;
#pragma unroll
    for (int it = 0; it < 16; ++it) { const int i = c.tid + it * NTHR; const f32x4 w = *(const f32x4*)(wr + (size_t)i * 4); const int k = i >> 2, e0 = (i & 3) * 4;
        Wl[(e0 + 0) * 2048 + k] = w[0]; Wl[(e0 + 1) * 2048 + k] = w[1]; Wl[(e0 + 2) * 2048 + k] = w[2]; Wl[(e0 + 3) * 2048 + k] = w[3]; }
    WG_BAR();
    const int gw = c.vcu * NWAVES + c.wave, NGW = c.G * NWAVES, lane = c.lane;
    u32x2 xr[2][8];
#define M1_LOAD(r0_) do { const int a0_ = (r0_), a1_ = ((r0_) + NGW < M) ? (r0_) + NGW : (r0_); \
    _Pragma("unroll") for (int j = 0; j < 8; ++j) { xr[0][j] = *(const u32x2*)(Xres + (size_t)a0_ * DM + j * 256 + lane * 4); xr[1][j] = *(const u32x2*)(Xres + (size_t)a1_ * DM + j * 256 + lane * 4); } } while (0)
    if (gw < M) M1_LOAD(gw);
    for (int rr = gw; rr < M; rr += 2 * NGW) {
        const int rw[2] = {rr, (rr + NGW < M) ? rr + NGW : rr};
        f32x4 v[2][8];
#pragma unroll
        for (int q = 0; q < 2; ++q)
#pragma unroll
            for (int j = 0; j < 8; ++j) { const u32x2 mw = *(const u32x2*)(Mb + (size_t)rw[q] * DM + j * 256 + lane * 4);
                v[q][j] = (f32x4){bf_lo(xr[q][j].x), bf_hi(xr[q][j].x), bf_lo(xr[q][j].y), bf_hi(xr[q][j].y)} * DN_ALPHA + (f32x4){bf_lo(mw.x), bf_hi(mw.x), bf_lo(mw.y), bf_hi(mw.y)}; }
        __builtin_amdgcn_sched_barrier(0);
        if (rr + 2 * NGW < M) M1_LOAD(rr + 2 * NGW);
        __builtin_amdgcn_sched_barrier(0);
#pragma unroll
        for (int q = 0; q < 2; ++q) { float s = 0.f;
#pragma unroll
            for (int j = 0; j < 8; ++j) s += (v[q][j][0] + v[q][j][1]) + (v[q][j][2] + v[q][j][3]);
            const float mean = wave_sum(s) * (1.f / DM); float s2 = 0.f;
#pragma unroll
            for (int j = 0; j < 8; ++j) { v[q][j] = v[q][j] - mean; s2 += (v[q][j][0] * v[q][j][0] + v[q][j][1] * v[q][j][1]) + (v[q][j][2] * v[q][j][2] + v[q][j][3] * v[q][j][3]); }
            const float rstd = rsqrtf(wave_sum(s2) * (1.f / DM) + LN_EPS);
#pragma unroll
            for (int j = 0; j < 8; ++j) { const f32x4 gg = *(const f32x4*)(g + j * 256 + lane * 4), b4 = *(const f32x4*)(bb + j * 256 + lane * 4);
                v[q][j] = v[q][j] * rstd * gg + b4;
                if (q == 0 || rw[1] != rw[0]) { u32x2 w; w.x = cvt_pk_bf16(v[q][j][0], v[q][j][1]); w.y = cvt_pk_bf16(v[q][j][2], v[q][j][3]); *(u32x2*)(X1b + (size_t)rw[q] * DM + j * 256 + lane * 4) = w;
                    int w8 = __builtin_amdgcn_cvt_pk_fp8_f32(v[q][j][0], v[q][j][1], 0, false); w8 = __builtin_amdgcn_cvt_pk_fp8_f32(v[q][j][2], v[q][j][3], w8, true); *(int*)(X1f8 + (size_t)rw[q] * DM + j * 256 + lane * 4) = w8; } } }
        float lg[2][16];
#pragma unroll
        for (int e = 0; e < 16; ++e) { f32x2 p0 = {0.f, 0.f}, p1 = {0.f, 0.f};
#pragma unroll
            for (int j = 0; j < 8; ++j) { const f32x4 w = *(const LAS f32x4*)(Wl + e * 2048 + j * 256 + lane * 4); const f32x2 wl = {w[0], w[1]}, wh = {w[2], w[3]};
                p0 = (f32x2){v[0][j][0], v[0][j][1]} * wl + p0; p0 = (f32x2){v[0][j][2], v[0][j][3]} * wh + p0; p1 = (f32x2){v[1][j][0], v[1][j][1]} * wl + p1; p1 = (f32x2){v[1][j][2], v[1][j][3]} * wh + p1; }
            lg[0][e] = wave_sum(p0.x + p0.y); lg[1][e] = wave_sum(p1.x + p1.y); }
#pragma unroll
        for (int q = 0; q < 2; ++q) { float mx = lg[q][0];
#pragma unroll
            for (int e = 1; e < 16; ++e) mx = fmaxf(mx, lg[q][e]);
            float den = 0.f;
#pragma unroll
            for (int e = 0; e < 16; ++e) { lg[q][e] = __expf(lg[q][e] - mx); den += lg[q][e]; }
            const float inv = 1.f / den; float mine = 0.f;
#pragma unroll
            for (int e = 0; e < 16; ++e) mine = (lane == e) ? lg[q][e] * inv : mine;
            if (lane < 16 && (q == 0 || rw[1] != rw[0])) aff[((size_t)(rw[q] >> 12) * 16 + lane) * SEQ + (rw[q] & (SEQ - 1))] = mine; }
    }
#undef M1_LOAD
    WG_BAR();
}

__device__ __forceinline__ void topk_units(const Ctx& c, const float* aff, int* idx, float* gate, unsigned short* slotmap) {
    LAS unsigned* sm = (LAS unsigned*)c.lds;
    const int tid = c.tid, lane = c.lane, wid = c.wave;
    for (int be = c.vcu; be < BATCH * NEXP; be += c.G) {
        const int b = be >> 4, e = be & 15;
        const float* a = aff + (size_t)be * SEQ + tid * 8;
        const u32x4 k0 = *(const u32x4*)a, k1 = *(const u32x4*)(a + 4);
        const unsigned key[8] = {k0.x, k0.y, k0.z, k0.w, k1.x, k1.y, k1.z, k1.w};
        unsigned prefix = 0u; int par = 0;
        for (int bit = 30; bit >= 0; --bit) {
            const unsigned cand = prefix | (1u << bit); int cnt = 0;
#pragma unroll
            for (int i = 0; i < 8; ++i) cnt += (key[i] >= cand) ? 1 : 0;
            cnt = wave_sum_i(cnt);
            if (lane == 0) sm[par * 8 + wid] = (unsigned)cnt;
            WG_BAR();
            unsigned total = 0u;
#pragma unroll
            for (int w = 0; w < 8; ++w) total += sm[par * 8 + w];
            if (total >= (unsigned)CAP) prefix = cand;
            par ^= 1;
        }
        const unsigned T = prefix;
        int cgt = 0, ceq = 0;
#pragma unroll
        for (int i = 0; i < 8; ++i) { cgt += (key[i] > T) ? 1 : 0; ceq += (key[i] == T) ? 1 : 0; }
        unsigned pk = (unsigned)cgt | ((unsigned)ceq << 16), inc = pk;
#pragma unroll
        for (int o = 1; o < 64; o <<= 1) { const unsigned nb = __shfl_up(inc, o); if (lane >= o) inc += nb; }
        if (lane == 63) sm[32 + wid] = inc;
        WG_BAR();
        unsigned wpre = 0u, gtot = 0u;
#pragma unroll
        for (int w = 0; w < 8; ++w) { const unsigned v = sm[32 + w]; if (w < wid) wpre += v; gtot += v; }
        const unsigned ex = wpre + inc - pk;
        int pre_gt = (int)(ex & 0xffffu), pre_eq = (int)(ex >> 16);
        const int need_eq = CAP - (int)(gtot & 0xffffu);
        const size_t obase = ((size_t)e * BATCH + b) * CAP;
#pragma unroll
        for (int i = 0; i < 8; ++i) { const int t = tid * 8 + i; const bool gt = key[i] > T, eq = key[i] == T; const bool sel = gt || (eq && pre_eq < need_eq);
            const int slot = pre_gt + (pre_eq < need_eq ? pre_eq : need_eq);
            if (sel) { idx[obase + slot] = b * SEQ + t; gate[obase + slot] = __uint_as_float(key[i]); }
            slotmap[((size_t)b * SEQ + t) * 16 + e] = sel ? (unsigned short)slot : (unsigned short)0xFFFF;
            pre_gt += gt ? 1 : 0; pre_eq += eq ? 1 : 0; }
        WG_BAR();
    }
}

__device__ __forceinline__ void combine_ln_rows(const Ctx& c, const bf16_t* X1b, const bf16_t* Y, const unsigned short* slotmap, const float* g, const float* bb, float* outf, bf16_t* Xb) {
    const int gw = c.vcu * NWAVES + c.wave, NGW = c.G * NWAVES, lane = c.lane;
    for (int rr = gw; rr < M; rr += 2 * NGW) {
        const int rw[2] = {rr, (rr + NGW < M) ? rr + NGW : rr};
        f32x4 v[2][8]; int slotv[2]; unsigned msk[2];
#pragma unroll
        for (int q = 0; q < 2; ++q) { slotv[q] = (lane < 16) ? (int)slotmap[(size_t)rw[q] * 16 + lane] : 0xFFFF;
#pragma unroll
            for (int j = 0; j < 8; ++j) { const u32x2 xw = *(const u32x2*)(X1b + (size_t)rw[q] * DM + j * 256 + lane * 4); v[q][j] = (f32x4){bf_lo(xw.x), bf_hi(xw.x), bf_lo(xw.y), bf_hi(xw.y)} * DN_ALPHA; } }
#pragma unroll
        for (int q = 0; q < 2; ++q) msk[q] = (unsigned)__builtin_amdgcn_readfirstlane((int)(unsigned)(__ballot(slotv[q] != 0xFFFF) & 0xFFFFull));
        while (msk[0] | msk[1]) {
            u32x2 t[4][8]; bool ok[4];
#pragma unroll
            for (int k = 0; k < 4; ++k) { const int q = k >> 1; ok[k] = msk[q] != 0u;
                if (ok[k]) { const int e = __builtin_ctz(msk[q]); msk[q] &= msk[q] - 1u; const unsigned sl = (unsigned)__builtin_amdgcn_readlane(slotv[q], e);
                    const bf16_t* yr = Y + (((size_t)e * BATCH + (rw[q] >> 12)) * CAP + sl) * DM + lane * 4;
#pragma unroll
                    for (int j = 0; j < 8; ++j) t[k][j] = *(const u32x2*)(yr + j * 256); } }
#pragma unroll
            for (int k = 0; k < 4; ++k) { const int q = k >> 1;
                if (ok[k]) {
#pragma unroll
                    for (int j = 0; j < 8; ++j) { v[q][j][0] += bf_lo(t[k][j].x); v[q][j][1] += bf_hi(t[k][j].x); v[q][j][2] += bf_lo(t[k][j].y); v[q][j][3] += bf_hi(t[k][j].y); } } }
        }
#pragma unroll
        for (int q = 0; q < 2; ++q) { float s = 0.f;
#pragma unroll
            for (int j = 0; j < 8; ++j) s += (v[q][j][0] + v[q][j][1]) + (v[q][j][2] + v[q][j][3]);
            const float mean = wave_sum(s) * (1.f / DM); float s2 = 0.f;
#pragma unroll
            for (int j = 0; j < 8; ++j) { v[q][j] = v[q][j] - mean; s2 += (v[q][j][0] * v[q][j][0] + v[q][j][1] * v[q][j][1]) + (v[q][j][2] * v[q][j][2] + v[q][j][3] * v[q][j][3]); }
            const float rstd = rsqrtf(wave_sum(s2) * (1.f / DM) + LN_EPS);
            if (q == 0 || rw[1] != rw[0]) {
#pragma unroll
                for (int j = 0; j < 8; ++j) { const f32x4 gg = *(const f32x4*)(g + j * 256 + lane * 4), b4 = *(const f32x4*)(bb + j * 256 + lane * 4);
                    const f32x4 o = v[q][j] * rstd * gg + b4; if (outf) { *(f32x4*)(outf + (size_t)rw[q] * DM + j * 256 + lane * 4) = o; continue; }
                    u32x2 w; w.x = cvt_pk_bf16(o[0], o[1]); w.y = cvt_pk_bf16(o[2], o[3]); *(u32x2*)(Xb + (size_t)rw[q] * DM + j * 256 + lane * 4) = w; } } }
    }
}
namespace gla {
constexpr int QT = 0, AT = 16384, KT = 24576, DT = 40960, SLOT = 41984, NSLOT = 3;
__device__ __forceinline__ void unit(const Ctx& c, int u, const unsigned char* rec, const bf16_t* vT, float* of, float* ob) {
    const int half = u & 1, dir = (u >> 1) & 1, hh = (u >> 2) & 3, b = u >> 4;
    int tid_ = c.tid; asm volatile("" : "+v"(tid_));
    const int w = __builtin_amdgcn_readfirstlane(tid_ >> 6), lane = tid_ & 63, fr = lane & 15, fq = lane >> 4;
    LAS unsigned char* L = c.lds;
    float* outp = (dir ? ob : of) + hh * 256 + half * 128 + w * 16 + 4 * fq;
    const int qrd = QT + fr * 256;
    const int swz7 = (fr >> 1) & 7;
    const int ard = AT + fr * 128;
    const int krd = KT + fr * 128;
    const int drd = DT + fq * 16;
    f32x4 S0 = {0.f, 0.f, 0.f, 0.f}, S1 = S0, S2 = S0, S3 = S0, S4 = S0, S5 = S0, S6 = S0, S7 = S0;
#ifndef GLA_TP
#define GLA_TP 0
#endif
    unsigned long long tw_ = 0ull, ta_ = 0ull;
#define GLA_T0(id) do { if (GLA_TP == (id)) ta_ = __builtin_amdgcn_s_memrealtime(); } while (0)
#define GLA_T1(id) do { if (GLA_TP == (id)) tw_ += __builtin_amdgcn_s_memrealtime() - ta_; } while (0)
    bf16x8 va0, va1, vb0, vb1, vc0, vc1;
#define GLA_CH(n) (b * 64 + (dir ? 63 - ((n) < 64 ? (n) : 63) : ((n) < 64 ? (n) : 63)))
#define GLA_VLOAD(V0, V1, n) do { const bf16_t* vp_ = vT + (((size_t)GLA_CH(n) * 4 + hh) * 256 + half * 128 + w * 16 + fr) * 64 + 8 * fq; \
    asm volatile("global_load_dwordx4 %0, %1, off" : "=&v"(V0) : "v"(vp_) : "memory"); asm volatile("global_load_dwordx4 %0, %1, off offset:64" : "=&v"(V1) : "v"(vp_) : "memory"); } while (0)
#define GLA_G(gp, off) __builtin_amdgcn_global_load_lds((const unsigned*)(gp), (LAS unsigned*)(L + (off)), 16, 0, 0)
#define GLA_DMA(n, SL) do { const unsigned char* rp_ = rec + ((((size_t)dir * 256 + GLA_CH(n)) * 4 + hh) * SLOT) + lane * 16;     \
    GLA_G(rp_ + (w) * 1024, (SL) * SLOT + (w) * 1024); GLA_G(rp_ + (w + 8) * 1024, (SL) * SLOT + (w + 8) * 1024); GLA_G(rp_ + (w + 16) * 1024, (SL) * SLOT + (w + 16) * 1024); \
    GLA_G(rp_ + (w + 24) * 1024, (SL) * SLOT + (w + 24) * 1024); GLA_G(rp_ + (w + 32) * 1024, (SL) * SLOT + (w + 32) * 1024); \
    GLA_G(rp_ + 40 * 1024, (w == 0) ? (SL) * SLOT + 40 * 1024 : NSLOT * SLOT); } while (0)
#define GLA_PK(a, bq) __builtin_bit_cast(bf16x8, (u32x4){cvt_pk_bf16(a[0], a[1]), cvt_pk_bf16(a[2], a[3]), cvt_pk_bf16(bq[0], bq[1]), cvt_pk_bf16(bq[2], bq[3])})
#define GLA_SCHED __builtin_amdgcn_sched_barrier(0)
#define GLA_MF __builtin_amdgcn_mfma_f32_16x16x32_bf16
#define GLA_RDQ(f, sb, ib) do { const LAS unsigned char* q_ = (sb) + qrd + (ib) * 4096; const LAS unsigned char* a_ = (sb) + ard + (ib) * 2048; \
    f[0] = *(const LAS bf16x8*)(q_ + (((0 + fq) ^ fr) << 4)); f[1] = *(const LAS bf16x8*)(q_ + (((4 + fq) ^ fr) << 4)); f[2] = *(const LAS bf16x8*)(q_ + (((8 + fq) ^ fr) << 4)); f[3] = *(const LAS bf16x8*)(q_ + (((12 + fq) ^ fr) << 4)); \
    f[4] = *(const LAS bf16x8*)(a_ + (((0 + fq) ^ swz7) << 4)); f[5] = *(const LAS bf16x8*)(a_ + (((4 + fq) ^ swz7) << 4)); } while (0)
#define GLA_RDK(f, sb, p) do { const LAS unsigned char* k_ = (sb) + krd + (p) * 4096; const LAS unsigned char* d_ = (sb) + drd + (p) * 128; \
    f[0] = *(const LAS bf16x8*)(k_ + (((0 + fq) ^ swz7) << 4)); f[1] = *(const LAS bf16x8*)(k_ + (((4 + fq) ^ swz7) << 4)); f[2] = *(const LAS bf16x8*)(k_ + 2048 + (((0 + fq) ^ swz7) << 4)); f[3] = *(const LAS bf16x8*)(k_ + 2048 + (((4 + fq) ^ swz7) << 4)); \
    f[4] = *(const LAS bf16x8*)(d_); f[5] = *(const LAS bf16x8*)(d_ + 64); } while (0)
#define GLA_MMAO(f, ib, VC0, VC1) do { f32x4 o1_ = {0.f, 0.f, 0.f, 0.f}, o2_ = {0.f, 0.f, 0.f, 0.f}; \
    o1_ = GLA_MF(sf0, f[0], o1_, 0, 0, 0); o2_ = GLA_MF(sf2, f[2], o2_, 0, 0, 0); o1_ = GLA_MF(sf1, f[1], o1_, 0, 0, 0); o2_ = GLA_MF(sf3, f[3], o2_, 0, 0, 0); \
    o1_ = GLA_MF(VC0, f[4], o1_, 0, 0, 0); o2_ = GLA_MF(VC1, f[5], o2_, 0, 0, 0); *(f32x4*)(outp + ro_ + (size_t)(ib) * 16 * 1024) = o1_ + o2_; } while (0)
#define GLA_MMAS(f, Sa, Sb, VC0, VC1) do { Sa = Sa * __builtin_bit_cast(f32x4, f[4]); Sb = Sb * __builtin_bit_cast(f32x4, f[5]); \
    Sa = GLA_MF(f[0], VC0, Sa, 0, 0, 0); Sb = GLA_MF(f[2], VC0, Sb, 0, 0, 0); Sa = GLA_MF(f[1], VC1, Sa, 0, 0, 0); Sb = GLA_MF(f[3], VC1, Sb, 0, 0, 0); } while (0)
#define GLA_STEP(n, SC, SL, VC0, VC1, VL0, VL1) do { \
    GLA_T0(2); GLA_VLOAD(VL0, VL1, (n) + 2); GLA_DMA((n) + 2, SL); GLA_T1(2); GLA_T0(3); \
    const LAS unsigned char* sb_ = L + (SC) * SLOT; \
    const bf16x8 sf0 = GLA_PK(S0, S1), sf1 = GLA_PK(S2, S3), sf2 = GLA_PK(S4, S5), sf3 = GLA_PK(S6, S7); \
    const size_t ro_ = ((size_t)GLA_CH(n) * 64 + fr) * 1024; \
    bf16x8 fa_[6], fb_[6]; \
    GLA_RDQ(fa_, sb_, 0); GLA_SCHED; \
    GLA_RDQ(fb_, sb_, 1); GLA_SCHED; GLA_MMAO(fa_, 0, VC0, VC1); GLA_SCHED; \
    GLA_RDQ(fa_, sb_, 2); GLA_SCHED; GLA_MMAO(fb_, 1, VC0, VC1); GLA_SCHED; \
    GLA_RDQ(fb_, sb_, 3); GLA_SCHED; GLA_MMAO(fa_, 2, VC0, VC1); GLA_SCHED; \
    GLA_RDK(fa_, sb_, 0); GLA_SCHED; GLA_MMAO(fb_, 3, VC0, VC1); GLA_SCHED; \
    GLA_RDK(fb_, sb_, 1); GLA_SCHED; GLA_MMAS(fa_, S0, S1, VC0, VC1); GLA_SCHED; \
    GLA_RDK(fa_, sb_, 2); GLA_SCHED; GLA_MMAS(fb_, S2, S3, VC0, VC1); GLA_SCHED; \
    GLA_RDK(fb_, sb_, 3); GLA_SCHED; GLA_MMAS(fa_, S4, S5, VC0, VC1); GLA_SCHED; \
    GLA_MMAS(fb_, S6, S7, VC0, VC1); \
    GLA_T1(3); GLA_T0(1); asm volatile("s_waitcnt vmcnt(16) lgkmcnt(0)" ::: "memory"); GLA_T1(1); GLA_T0(4); asm volatile("s_barrier" ::: "memory"); GLA_T1(4); } while (0)
    GLA_VLOAD(va0, va1, 0); GLA_DMA(0, 0); GLA_VLOAD(vb0, vb1, 1); GLA_DMA(1, 1);
    asm volatile("s_waitcnt vmcnt(8) lgkmcnt(0)\n\ts_barrier" ::: "memory");
#pragma nounroll
    for (int n = 0; n < 63; n += 3) {
        GLA_STEP(n, 0, 2, va0, va1, vc0, vc1);
        GLA_STEP(n + 1, 1, 0, vb0, vb1, va0, va1);
        GLA_STEP(n + 2, 2, 1, vc0, vc1, vb0, vb1);
    }
    GLA_STEP(63, 0, 2, va0, va1, vc0, vc1);
    asm volatile("s_waitcnt vmcnt(0) lgkmcnt(0)\n\ts_barrier" ::: "memory");
    asm volatile("" :: "v"(va0), "v"(va1), "v"(vb0), "v"(vb1), "v"(vc0), "v"(vc1));
    if (GLA_TP != 0 && tid_ == 0 && u == 0) *(volatile LAS unsigned long long*)(L + MISC_OFF + 64) = tw_;
#undef GLA_CH
#undef GLA_VLOAD
#undef GLA_G
#undef GLA_DMA
#undef GLA_PK
#undef GLA_SCHED
#undef GLA_MF
#undef GLA_RDQ
#undef GLA_RDK
#undef GLA_MMAO
#undef GLA_MMAS
#undef GLA_STEP
}
}
#ifndef MK_SPLIT
#define MK_SPLIT 0
#endif
constexpr int NPH_LAYER = 11, NPHASE = 1 + DEPTH * NPH_LAYER;
struct Args { const float* in[22]; float* out; unsigned char* ws; int ph_lo, ph_hi, li, pad; };

__global__ void __launch_bounds__(NTHR, 2) hybrid_fwd(Args args) {
    extern __shared__ __attribute__((aligned(16))) unsigned char lds_raw[];
    Ctx c; c.lds = (LAS unsigned char*)lds_raw; c.tid = threadIdx.x; c.lane = c.tid & 63; c.wave = __builtin_amdgcn_readfirstlane(c.tid >> 6);
    c.G = gridDim.x; { const int bx = blockIdx.x; c.vcu = (c.G % 8 == 0) ? (bx % 8) * (c.G / 8) + bx / 8 : bx; }
    typedef const Args __attribute__((address_space(4))) CArgs;
    CArgs* const ap0 = (CArgs*)__builtin_amdgcn_kernarg_segment_ptr();
    unsigned char* ws = ap0->ws;
    gu32* ctl = (gu32*)(ws + WS_CTL);
    volatile LAS unsigned* MISC = (volatile LAS unsigned*)(c.lds + MISC_OFF);
    for (int u = c.tid; u < (LDS_BYTES - RING_BYTES) / 4; u += NTHR) ((LAS unsigned*)(c.lds + RING_BYTES))[u] = 0u;
    __syncthreads();
    const int lo = ap0->ph_lo, hi = ap0->ph_hi;
    XcdBarrier bar; bar.bar = (unsigned*)(ctl + CW_BAR) + ap0->li * XCD_BAR_WORDS; bar.x = 0; bar.st = nullptr;
    if (hi - lo > 1) bar = xcd_barrier_post((unsigned*)(ctl + CW_BAR) + ap0->li * XCD_BAR_WORDS, MISC + 8);
#ifndef PHASE_MASK
#define PHASE_MASK 0xFFF
#endif
#define PHM(j) (((PHASE_MASK) >> (j)) & 1)
#ifndef DUP_PHASE
#define DUP_PHASE (-1)
#endif
#ifndef DUP_SUB
#define DUP_SUB 3
#endif
#ifndef DUP_PAR
#define DUP_PAR 2
#endif
#define NREP(k) ((DUP_PHASE == (k) && (DUP_PAR == 2 || DUP_PAR == (layer & 1))) ? 2 : 1)
#define IN(k) (lo <= (k) && (k) < hi)
#ifndef TPROBE
#define TPROBE 0
#endif
#ifndef TPROBE_SEAM
#define TPROBE_SEAM (-1)
#endif
#ifndef TPROBE_LAYER
#define TPROBE_LAYER 0
#endif
#ifndef TPROBE_BLOCK
#define TPROBE_BLOCK 0
#endif
    unsigned long long tpr_acc = 0ull, tpr_t0 = 0ull, tph0 = 0ull;
#define SEAM(k) do { if (TPROBE == 6 && (k) > 0 && ((k) - 1) % NPH_LAYER == TPROBE_SEAM && ((k) - 1) / NPH_LAYER == TPROBE_LAYER) tpr_acc += __builtin_amdgcn_s_memrealtime() - tph0; if (hi > (k) + 1) { const bool tp_ = (TPROBE == 5) && (TPROBE_SEAM < 0 || ((k) > 0 && ((k) - 1) % NPH_LAYER == TPROBE_SEAM) || ((k) == 0 && TPROBE_SEAM == 11)); \
    if (tp_) tpr_t0 = __builtin_amdgcn_s_memrealtime(); xcd_barrier(bar); if (tp_) tpr_acc += __builtin_amdgcn_s_memrealtime() - tpr_t0; } } while (0)

#define tabR ((f32x2*)(wsb + WS_ROPER))
#define tabG ((f32x2*)(wsb + WS_ROPEG))
#define aff ((float*)(wsb + WS_AFF))
#define idx ((int*)(wsb + WS_IDX))
#define gate ((float*)(wsb + WS_GATE))
#define slotmap ((unsigned short*)(wsb + WS_SLOT))
#define Win_t ((bf16_t*)(wsb + WS_WIN))
#define Wuq_t ((bf16_t*)(wsb + WS_WUQ))
#define Wukv_t ((bf16_t*)(wsb + WS_WUKV))
#define Wmo_t ((bf16_t*)(wsb + WS_WMO))
#define Wqkv_t ((bf16_t*)(wsb + WS_WQKV))
#define Wgo_t ((bf16_t*)(wsb + WS_WGO))
#define W13_t ((bf16_t*)(wsb + WS_W13))
#define W2_t ((bf16_t*)(wsb + WS_W2))
#define Xb ((bf16_t*)(wsb + WS_XB))
#define X1b ((bf16_t*)(wsb + WS_X1B))
#define X1f8 ((unsigned char*)(wsb + WS_X1))
#define W13f8 ((unsigned char*)(wsb + WS_W13))
#define W2f8 ((unsigned char*)(wsb + WS_W2))
#define hdn8 ((unsigned char*)(wsb + WS_HDN))
#define iota ((int*)(wsb + WS_IDX + 262144))
#define Ocat8 ((unsigned char*)(wsb + WS_OCAT))
#define Wmo8 ((unsigned char*)(wsb + WS_WMO))
#define Wgo8 ((unsigned char*)(wsb + WS_WGO))
#define H ((bf16_t*)(wsb + WS_H))
#define Qm ((bf16_t*)(wsb + WS_QM))
#define Km ((bf16_t*)(wsb + WS_KM))
#define Vm ((bf16_t*)(wsb + WS_VM))
#define Ocat ((bf16_t*)(wsb + WS_OCAT))
#define qin ((bf16_t*)(wsb + WS_QIN))
#define vT ((bf16_t*)(wsb + WS_VT))
#define of ((float*)(wsb + WS_OF))
#define ob ((float*)(wsb + WS_OB))
#define hdn ((bf16_t*)(wsb + WS_HDN))
#define Yb ((bf16_t*)(wsb + WS_Y))
#define Mb ((bf16_t*)(wsb + WS_OF))
#define X2 (apx->out)
#define WSB_OPAQUE() CArgs* apx = ap0; asm volatile("" : "+s"(apx)); unsigned char* wsb = apx->ws

    if (PHM(11) && IN(0)) for (int rep_ = 0; rep_ < ((DUP_PHASE == 11) ? 2 : 1); ++rep_) { WSB_OPAQUE();
        fill_rope(c, tabR, tabG);
        cvt_rows_bf16(c, apx->in[0], Xb);
        const int nl = (c.G == 256) ? 2 : DEPTH;
        transpose_batch_f8(c, apx->in[15], W13f8, DM, FF, nl * NEXP, (size_t)DM * FF, (size_t)2 * FF * DM, 2, 64.f);
        transpose_batch_f8(c, apx->in[16], W13f8, DM, FF, nl * NEXP, (size_t)DM * FF, (size_t)2 * FF * DM, 3, 512.f);
        transpose_batch_f8(c, apx->in[17], W2f8, FF, DM, (c.G == 256 ? 1 : nl) * NEXP, (size_t)FF * DM, (size_t)DM * FF, 0, 128.f);
        transpose_batch(c, apx->in[1], Win_t, DM, 3936, 2, (size_t)DM * 3936, (size_t)4096 * DM, 1);
        transpose_batch(c, apx->in[10], Wqkv_t, DM, 3072, 2, (size_t)DM * 3072, (size_t)3072 * DM, 0);
        transpose_batch_f8(c, apx->in[9], Wmo8, DM, DM, 2, (size_t)DM * DM, (size_t)DM * DM, 0, 128.f, -1, 0, 1024, 1024.f);
        transpose_batch_f8(c, apx->in[13], Wgo8, DM, DM, 2, (size_t)DM * DM, (size_t)DM * DM, 0, 128.f);
        transpose_batch(c, apx->in[3], Wuq_t, 512, 1536, 2, (size_t)512 * 1536, (size_t)1536 * 512, 0);
        transpose_batch(c, apx->in[5], Wukv_t, 256, 2048, 2, (size_t)256 * 2048, (size_t)2048 * 256, 0);
        { const long gt = (long)c.vcu * NTHR + c.tid, NT = (long)c.G * NTHR;
          for (long i = gt; i < 2L * 160 * DM / 8; i += NT) { const long l2 = i / (160 * DM / 8), rr = i % (160 * DM / 8); *(u32x4*)(Win_t + (size_t)l2 * 4096 * DM + (size_t)3936 * DM + rr * 8) = (u32x4){0u, 0u, 0u, 0u}; } }
        for (int i = c.vcu * NTHR + c.tid; i < BATCH * NEXP * CAP; i += c.G * NTHR) iota[i] = i;
        SEAM(0);
    }

    const Ctx c0 = c;
#ifndef TPROBE_BLOCK
#define TPROBE_BLOCK 0
#endif
#ifndef TPROBE_LAYER
#define TPROBE_LAYER 0
#endif
#define TP_BEGIN(id) do { if (TPROBE == (id) && layer == TPROBE_LAYER) tpr_t0 = __builtin_amdgcn_s_memrealtime(); } while (0)
#define TP_END(id) do { if (TPROBE == (id) && layer == TPROBE_LAYER) tpr_acc += __builtin_amdgcn_s_memrealtime() - tpr_t0; } while (0)
    for (int layer = 0; layer < DEPTH; ++layer) {
        const int pb = 1 + layer * NPH_LAYER, i2 = layer >> 1; const bool even = (layer & 1) == 0;
        if (PHM(0) && IN(pb + 0)) _Pragma("nounroll") for (int rep_ = 0; rep_ < NREP(0); ++rep_) { const Ctx c = opaque_ctx(c0); WSB_OPAQUE(); if (TPROBE == 6) tph0 = __builtin_amdgcn_s_memrealtime();
            const int N = even ? 4096 : 3072;
            pg8::Gemm g{Xb, even ? Win_t + (size_t)i2 * 4096 * DM : Wqkv_t + (size_t)i2 * 3072 * DM, DM, DM, DM, 0, 0, nullptr};
            pg8::StaticOrder S; S.init(M, N, c.G, (int)blockIdx.x);
            if (even) { pg8::EpiStoreBf16 E{H, N}; pg8::gemm_phase<pg8::EpiStoreBf16, false>(c.lds, g, S, E); }
            else { pg8::EpiQKNorm E{H, apx->in[11] + i2 * 128, apx->in[12] + i2 * 128, tabG, (LAS float*)(c.lds + RING_BYTES + 2048)};
                   pg8::gemm_phase<pg8::EpiQKNorm, false>(c.lds, g, S, E); }
            SEAM(pb + 0);
        }
        if (PHM(1) && IN(pb + 1) && even) _Pragma("nounroll") for (int rep_ = 0; rep_ < NREP(1); ++rep_) { const Ctx c = opaque_ctx(c0); WSB_OPAQUE(); if (TPROBE == 6) tph0 = __builtin_amdgcn_s_memrealtime();
            if (even) { if (rep_ == 0 || (DUP_SUB & 4)) mla_prep_rows(c, H, rep_ == 0 ? H : (bf16_t*)(ws + WS_HDN), Km, apx->in[2] + i2 * 512, apx->in[4] + i2 * 256, tabR);
                        if (rep_ == 0 || !(DUP_SUB & 4)) gla_prep(c, H, apx->in[6] + (size_t)i2 * 2 * 16 * 512, apx->in[7] + i2 * 2 * 512, (unsigned char*)qin  , vT); }
            SEAM(pb + 1);
        }
        if (PHM(2) && IN(pb + 2) && even) _Pragma("nounroll") for (int rep_ = 0; rep_ < NREP(2); ++rep_) { const Ctx c = opaque_ctx(c0); WSB_OPAQUE(); if (TPROBE == 6) tph0 = __builtin_amdgcn_s_memrealtime();
#ifndef SUBM
#define SUBM 0x1F
#endif
            if (SUBM & 1) { pg8::Gemm g{H + C_CQ, Wuq_t + (size_t)i2 * 1536 * 512, HW, 512, 512, 0, 0, nullptr}; pg8::StaticOrder S; S.init(M, 1536, c.G, (int)blockIdx.x);
              pg8::EpiQRope E{Qm, tabR}; pg8::gemm_phase<pg8::EpiQRope, false>(c.lds, g, S, E); }
            if (SUBM & 2) { pg8::Gemm g{H + C_CKV, Wukv_t + (size_t)i2 * 2048 * 256, HW, 256, 256, 0, 0, nullptr}; pg8::StaticOrder S; S.init(M, 2048, c.G, (int)blockIdx.x);
              pg8::EpiKV E{Km, Vm}; pg8::gemm_phase<pg8::EpiKV, false>(c.lds, g, S, E); }
            SEAM(pb + 2);
        }
        if (PHM(3) && IN(pb + 3)) _Pragma("nounroll") for (int rep_ = 0; rep_ < NREP(3); ++rep_) { const Ctx c = opaque_ctx(c0); WSB_OPAQUE(); if (TPROBE == 6) tph0 = __builtin_amdgcn_s_memrealtime();
            if (even) {
                TP_BEGIN(1); if ((SUBM & 4) && (rep_ == 0 || (DUP_SUB & 1))) for (int v4 = c.vcu; v4 < 256; v4 += c.G) if ((v4 & 3) == 0) { const Ctx cg = opaque_ctx(c0); gla::unit(cg, v4 >> 2, (const unsigned char*)qin  , vT, of, ob); } TP_END(1); TP_BEGIN(2);
                const bool lpt = (c.G == 256); const int cls = c.vcu & 3, idx4 = c.vcu >> 2;
                const int u0 = ((cls == 0) ? 0 : (cls == 1) ? 64 : (cls == 2) ? 256 : 384) + idx4, un = (cls == 0) ? 1 : (cls == 1) ? 3 : 2;
                if ((SUBM & 8) && (rep_ == 0 || (DUP_SUB & 2))) _Pragma("nounroll") for (int k = 0;; ++k) { int uid; if (lpt) { if (k >= un) break; uid = u0 + k * 64; } else { uid = c.vcu + k * c.G; if (uid >= 512) break; }
                    const int b = uid >> 7, h = (uid >> 4) & 7, qb = uid & 15; const size_t r0 = (size_t)b * SEQ;
                    attn::attn_unit<192, 1536, 1536, 1024, 2048>(Qm + (r0 + qb * 256) * 1536 + h * 192, Km + r0 * 1536 + h * 192, Vm + r0 * 1024 + h * 128, Ocat8 + (r0 + qb * 256) * 2048 + h * 128, SEQ, (char*)lds_raw); }
                TP_END(2);
                if (rep_ == 0 && lpt) {
                    const int tl = (layer == 0) ? 2 : 3; const size_t lo_ = (size_t)tl * NEXP; const Ctx ct = opaque_ctx(c0);
                    const int rk = (cls < 2) ? idx4 : idx4 * 2 + (cls - 2), cnt = (cls < 2) ? 64 : 128;
                    const int m0 = (cls == 0) ? 0 : (cls == 1) ? 10 : 12, nm = (cls == 0) ? 10 : (cls == 1) ? 2 : 4; const size_t l1_ = lo_ + m0;
                    transpose_batch_f8(ct, apx->in[15] + l1_ * DM * FF, W13f8 + l1_ * 2 * FF * DM, DM, FF, nm, (size_t)DM * FF, (size_t)2 * FF * DM, 2, 64.f, rk, cnt);
                    if (cls >= 2) {
                        transpose_batch_f8(ct, apx->in[16] + lo_ * DM * FF, W13f8 + lo_ * 2 * FF * DM, DM, FF, NEXP, (size_t)DM * FF, (size_t)2 * FF * DM, 3, 512.f, rk, cnt);
                        transpose_batch_f8(ct, apx->in[17] + lo_ * FF * DM, W2f8 + lo_ * DM * FF, FF, DM, NEXP / 2, (size_t)FF * DM, (size_t)DM * FF, 0, 128.f, rk, cnt); }
                }
            } else {
                TP_BEGIN(3);
                if (SUBM & 16) for (int uid = c.vcu; uid < 1024; uid += c.G) { const int b = uid >> 8, kvh = (uid >> 6) & 3, gq = (uid >> 4) & 3, qb = uid & 15, h = kvh * 4 + gq; const size_t r0 = (size_t)b * SEQ;
                    attn::attn_unit<128, 3072, 3072, 3072, 2048>(H + (r0 + qb * 256) * 3072 + h * 128, H + r0 * 3072 + 2048 + kvh * 128, H + r0 * 3072 + 2560 + kvh * 128, Ocat8 + (r0 + qb * 256) * 2048 + h * 128, SEQ, (char*)lds_raw); }
                TP_END(3);
            }
            TP_BEGIN(4); SEAM(pb + 3); TP_END(4);
        }
        if (PHM(4) && IN(pb + 4) && even) _Pragma("nounroll") for (int rep_ = 0; rep_ < NREP(4); ++rep_) { const Ctx c = opaque_ctx(c0); WSB_OPAQUE(); if (TPROBE == 6) tph0 = __builtin_amdgcn_s_memrealtime(); gla_out_rows(c, of, ob, H, apx->in[8] + i2 * 1024, Ocat8); SEAM(pb + 4); }
        if (PHM(5) && IN(pb + 5)) _Pragma("nounroll") for (int rep_ = 0; rep_ < NREP(5); ++rep_) { const Ctx c = opaque_ctx(c0); WSB_OPAQUE(); if (TPROBE == 6) tph0 = __builtin_amdgcn_s_memrealtime();
            pg8::Gemm g{(const bf16_t*)Ocat8, (const bf16_t*)((even ? Wmo8 : Wgo8) + (size_t)i2 * DM * DM), DM / 2, DM / 2, DM / 2, 0, 0, iota};
            pg8::StaticOrder S; S.init(M, DM, c.G, (int)blockIdx.x);
            pg8::EpiStoreBf16 E{Mb, DM};
            pg8::gemm_phase<pg8::EpiStoreBf16, true, true, 0x78787878, 0x7A7A7A7A>(c.lds, g, S, E);
            SEAM(pb + 5);
        }
        if (PHM(6) && IN(pb + 6)) _Pragma("nounroll") for (int rep_ = 0; rep_ < NREP(6); ++rep_) { const Ctx c = opaque_ctx(c0); WSB_OPAQUE(); if (TPROBE == 6) tph0 = __builtin_amdgcn_s_memrealtime(); ln_router_rows(c, Xb, Mb, X1b, X1f8, apx->in[18] + layer * DM, apx->in[19] + layer * DM, apx->in[14] + (size_t)layer * DM * NEXP, aff); SEAM(pb + 6); }
        if (PHM(7) && IN(pb + 7)) _Pragma("nounroll") for (int rep_ = 0; rep_ < NREP(7); ++rep_) { const Ctx c = opaque_ctx(c0); WSB_OPAQUE(); if (TPROBE == 6) tph0 = __builtin_amdgcn_s_memrealtime(); topk_units(c, aff, idx, gate, slotmap);
            if (c.G == 256 && c.vcu >= 64) { const size_t m0 = (layer < 2) ? (size_t)NEXP + (size_t)layer * 8 : (size_t)layer * NEXP + 8;
                transpose_batch_f8(c, apx->in[17] + m0 * FF * DM, W2f8 + m0 * DM * FF, FF, DM, 8, (size_t)FF * DM, (size_t)DM * FF, 0, 128.f, c.vcu - 64, 192); }
            SEAM(pb + 7); }
        if (PHM(8) && IN(pb + 8)) _Pragma("nounroll") for (int rep_ = 0; rep_ < NREP(8); ++rep_) { const Ctx c = opaque_ctx(c0); WSB_OPAQUE(); if (TPROBE == 6) tph0 = __builtin_amdgcn_s_memrealtime();
            pg8::Gemm g{(const bf16_t*)X1f8, (const bf16_t*)(W13f8 + (size_t)layer * NEXP * 2 * FF * DM), DM / 2, DM / 2, DM / 2, 3, (size_t)FF * DM, idx};
            pg8::StaticOrder S; S.init(MX, 2 * FF, c.G, (int)blockIdx.x);
            pg8::EpiSwigluF8 E{hdn8};
            pg8::gemm_phase<pg8::EpiSwigluF8, true, true>(c.lds, g, S, E);
            SEAM(pb + 8);
        }
        if (PHM(9) && IN(pb + 9)) _Pragma("nounroll") for (int rep_ = 0; rep_ < NREP(9); ++rep_) { const Ctx c = opaque_ctx(c0); WSB_OPAQUE(); if (TPROBE == 6) tph0 = __builtin_amdgcn_s_memrealtime();
            pg8::Gemm g{(const bf16_t*)hdn8, (const bf16_t*)(W2f8 + (size_t)layer * NEXP * DM * FF), FF / 2, FF / 2, FF / 2, 3, (size_t)DM * FF / 2, iota};
            pg8::StaticOrder S; S.init(MX, DM, c.G, (int)blockIdx.x);
            pg8::EpiGate E{Yb, gate};
            pg8::gemm_phase<pg8::EpiGate, true, true, 0x78787878, 0x7C7C7C7C>(c.lds, g, S, E);
            SEAM(pb + 9);
        }
        if (PHM(10) && IN(pb + 10)) _Pragma("nounroll") for (int rep_ = 0; rep_ < NREP(10); ++rep_) { const Ctx c = opaque_ctx(c0); WSB_OPAQUE(); if (TPROBE == 6) tph0 = __builtin_amdgcn_s_memrealtime(); combine_ln_rows(c, X1b, Yb, slotmap, apx->in[20] + layer * DM, apx->in[21] + layer * DM, (layer == DEPTH - 1) ? X2 : (float*)nullptr, Xb); SEAM(pb + 10); }
    }
    if (TPROBE == 9 && threadIdx.x == 0) tpr_acc = *(volatile LAS unsigned long long*)(c.lds + MISC_OFF + 64);
    if (TPROBE != 0 && blockIdx.x == TPROBE_BLOCK) { const unsigned long long tgt = __builtin_amdgcn_s_memrealtime() + 16ull * tpr_acc; while (__builtin_amdgcn_s_memrealtime() < tgt) __builtin_amdgcn_s_sleep(20); }
#undef IN
#undef SEAM
#undef tabR
#undef tabG
#undef aff
#undef idx
#undef gate
#undef slotmap
#undef Win_t
#undef Wuq_t
#undef Wukv_t
#undef Wmo_t
#undef Wqkv_t
#undef Wgo_t
#undef W13_t
#undef W2_t
#undef Xb
#undef X1b
#undef X1f8
#undef W13f8
#undef W2f8
#undef hdn8
#undef iota
#undef Ocat8
#undef Wmo8
#undef Wgo8
#undef H
#undef Qm
#undef Km
#undef Vm
#undef Ocat
#undef qin
#undef vT
#undef of
#undef ob
#undef hdn
#undef Yb
#undef Mb
#undef X2
#undef WSB_OPAQUE
}

extern "C" void kernel_launch(void* const* d_in, const int* in_sizes, int n_in, void* d_out, int out_size, void* d_ws, size_t ws_size, hipStream_t stream) {
    static int grid = 0;
    if (grid == 0) {
        if (n_in != 22 || in_sizes[0] != M * DM || out_size != M * DM || ws_size < WS_END) { fprintf(stderr, "kernel_launch: unexpected shapes (n_in %d, in0 %d, out %d, ws %zu < %zu); nothing launched\n", n_in, n_in > 0 ? in_sizes[0] : -1, out_size, ws_size, (size_t)WS_END); grid = -1; return; }
        int dev = 0, cus = 0, per_cu = 0;
        if (hipGetDevice(&dev) != hipSuccess || hipDeviceGetAttribute(&cus, hipDeviceAttributeMultiprocessorCount, dev) != hipSuccess) { grid = -1; return; }
        if (hipFuncSetAttribute((const void*)hybrid_fwd, hipFuncAttributeMaxDynamicSharedMemorySize, LDS_BYTES) != hipSuccess) { fprintf(stderr, "kernel_launch: hipFuncSetAttribute failed\n"); grid = -1; return; }
        if (hipOccupancyMaxActiveBlocksPerMultiprocessor(&per_cu, (const void*)hybrid_fwd, NTHR, LDS_BYTES) != hipSuccess || per_cu < 1) fprintf(stderr, "kernel_launch: occupancy query reports %d\n", per_cu);
        (void)hipGetLastError();
        grid = cus;
    }
    if (grid < 0) return;
    if (hipMemsetAsync((char*)d_ws + WS_CTL, 0, CTL_ZERO_BYTES, stream) != hipSuccess) return;
    Args a{};
    for (int i = 0; i < 22; ++i) a.in[i] = (const float*)d_in[i];
    a.out = (float*)d_out; a.ws = (unsigned char*)d_ws; a.pad = 0;
#if MK_SPLIT
    for (int p = 0; p < NPHASE; ++p) {
        if (p > 0) { const int layer = (p - 1) / NPH_LAYER, k = (p - 1) % NPH_LAYER; if ((layer & 1) && (k == 2 || k == 4)) continue; }
        a.ph_lo = p; a.ph_hi = p + 1; a.li = 0;
        hipLaunchKernelGGL(hybrid_fwd, dim3(grid), dim3(NTHR), LDS_BYTES, stream, a);
    }
#elif defined(RELAUNCH_PHASE)
    a.ph_lo = 0; a.ph_hi = RELAUNCH_PHASE + 1; a.li = 0; hipLaunchKernelGGL(hybrid_fwd, dim3(grid), dim3(NTHR), LDS_BYTES, stream, a);
    a.ph_lo = RELAUNCH_PHASE; a.ph_hi = RELAUNCH_PHASE + 1; a.li = 1; hipLaunchKernelGGL(hybrid_fwd, dim3(grid), dim3(NTHR), LDS_BYTES, stream, a);
    a.ph_lo = RELAUNCH_PHASE + 1; a.ph_hi = NPHASE; a.li = 2; hipLaunchKernelGGL(hybrid_fwd, dim3(grid), dim3(NTHR), LDS_BYTES, stream, a);
#else
    a.ph_lo = 0; a.ph_hi = NPHASE; a.li = 0;
    hipLaunchKernelGGL(hybrid_fwd, dim3(grid), dim3(NTHR), LDS_BYTES, stream, a);
#endif
    const hipError_t le = hipPeekAtLastError();
    if (le != hipSuccess) fprintf(stderr, "kernel_launch: launch failed: %s\n", hipGetErrorName(le));
}
```

```cpp
#include <hip/hip_runtime.h>
#include <hip/hip_bf16.h>
#include <cstdio>
#include <cstdint>
#include <cmath>

#define GAS __attribute__((address_space(1)))
#define LAS __attribute__((address_space(3)))
typedef unsigned short bf16_t;
typedef short bf16x8 __attribute__((ext_vector_type(8)));
typedef short s16x4 __attribute__((ext_vector_type(4)));
typedef float f32x4 __attribute__((ext_vector_type(4)));
typedef float f32x2 __attribute__((ext_vector_type(2)));
typedef float f32x16 __attribute__((ext_vector_type(16)));
typedef unsigned u32x4 __attribute__((ext_vector_type(4)));
typedef unsigned u32x2 __attribute__((ext_vector_type(2)));
typedef GAS unsigned gu32;

__device__ __forceinline__ unsigned cvt_pk_bf16(float lo, float hi) { unsigned r; asm volatile("v_cvt_pk_bf16_f32 %0, %1, %2" : "=v"(r) : "v"(lo), "v"(hi)); return r; }
__device__ __forceinline__ float bf_lo(unsigned w) { return __uint_as_float(w << 16); }
__device__ __forceinline__ float bf_hi(unsigned w) { return __uint_as_float(w & 0xffff0000u); }
__device__ __forceinline__ float bf2f(bf16_t h) { return __uint_as_float(((unsigned)h) << 16); }
__device__ __forceinline__ bf16_t f2bf(float f) { return (bf16_t)(cvt_pk_bf16(f, 0.f) & 0xffffu); }

namespace pg8 {
constexpr int BM = 256, BK = 64, HALF = 128, HTB = HALF * BK * 2, STAGE_BYTES = 8 * HTB, NXCD = 8, WGM = 8;
__host__ __device__ __forceinline__ int lds_byte(int r, int c) { const int st = (r >> 4) * 2 + (c >> 5), rr = r & 15, cc = c & 31, ob = rr * 64 + cc * 2; return st * 1024 + (ob ^ (((ob >> 9) & 1) << 5)); }
__host__ __device__ __forceinline__ void stage_rc(int b, int& R, int& C) { const int st = b / 1024, sb = b % 1024, swz = sb ^ (((sb >> 9) & 1) << 5); R = (st >> 1) * 16 + swz / 64; C = (st & 1) * 32 + (swz % 64) / 2; }
__host__ __device__ __forceinline__ int perm32(int rho) { const int n = rho >> 4, i = rho & 15; return 8 * (i >> 2) + 4 * n + (i & 3); }

struct Unit { int pm, pn; };
struct Gemm { const bf16_t* A; const bf16_t* Bt; int lda, ldb, K, bshift; size_t bstride; const int* gather; };

struct StaticOrder {
    int nM, nN, nwg, G, c;
    __device__ void init(int M, int N, int G_, int c_) { nM = M / BM; nN = N / BM; nwg = nM * nN; G = G_; c = c_; }
    __device__ bool next(int i, Unit& u) const {
        const long L = (long)i * G + c; if (L >= nwg) return false;
        int wgid = (int)L; { const int q = nwg / NXCD, r = nwg % NXCD, xcd = wgid % NXCD, off = wgid / NXCD; wgid = (xcd < r ? xcd * (q + 1) : r * (q + 1) + (xcd - r) * q) + off; }
        const int nig = WGM * nN, gid = wgid / nig, fm = gid * WGM, gsz = (nM - fm) < WGM ? (nM - fm) : WGM;
        u.pm = fm + ((wgid % nig) % gsz); u.pn = (wgid % nig) / gsz; return true;
    }
};

typedef int v8i_t __attribute__((ext_vector_type(8)));
typedef short s16x16_t __attribute__((ext_vector_type(16)));
__device__ __forceinline__ v8i_t cat16(bf16x8 a, bf16x8 b) { const s16x16_t t = __builtin_shufflevector(a, b, 0, 1, 2, 3, 4, 5, 6, 7, 8, 9, 10, 11, 12, 13, 14, 15); return __builtin_bit_cast(v8i_t, t); }
template <class Epi, bool GATHER, bool F8 = false, int WSC = 0x79797979, int ASC = 0x7F7F7F7F>
__device__ __forceinline__ void gemm_phase(LAS unsigned char* lds, const Gemm g, const StaticOrder& S, const Epi& E) {
    int tid_ = threadIdx.x; asm volatile("" : "+v"(tid_));
    const int tid = tid_, wid = __builtin_amdgcn_readfirstlane(tid >> 6), lane = tid & 63, wr = wid >> 2, wc = wid & 3, fr = lane & 15, fq = lane >> 4;
    const int K = g.K, nt = K / BK;
    unsigned voffA[2], voffB[2]; int RA[2], CA[2];
#pragma unroll
    for (int i = 0; i < 2; ++i) { int R, C; stage_rc(tid * 16 + i * 8192, R, C); const int Rb = Epi::PERM ? ((R & ~31) + perm32(R & 31)) : R;
        RA[i] = R; CA[i] = C; voffA[i] = (unsigned)(R * g.lda + C) * 2u; voffB[i] = (unsigned)(Rb * g.ldb + C) * 2u; }
    const size_t kstep = (size_t)(BK * 2);
    const size_t hstepA = (size_t)HALF * g.lda * 2, hstepB = (size_t)HALF * g.ldb * 2;
    const size_t tstepA = 2 * hstepA, tstepB = 2 * hstepB;
    const unsigned ldsw = (unsigned)wid * 1024u;
    int aoffk[2], boffk[2];
#pragma unroll
    for (int k = 0; k < 2; ++k) { const int col = F8 ? ((fq >> 1) * 32 + (fq & 1) * 16 + 8 * k) : (k * 32 + fq * 8); aoffk[k] = lds_byte(wr * 64 + fr, col); boffk[k] = lds_byte(wc * 32 + fr, col); }
#define PG8_SA(b, h) (((b) * 2 + (h)) * HTB)
#define PG8_SB(b, h) ((4 + (b) * 2 + (h)) * HTB)
#define PG8_STAGE(bufoff, gbase, voff) do { const char* _gb = (const char*)(gbase); asm volatile("" : "+s"(_gb));     \
        _Pragma("unroll") for (int _i = 0; _i < 2; ++_i) \
        __builtin_amdgcn_global_load_lds((const unsigned*)(_gb + (voff)[_i]), (LAS unsigned*)(lds + (bufoff) + ldsw + _i * 8192), 16, 0, 0); } while (0)
#define PG8_STAGE_A(bufoff, gptr, h, vg) do { if constexpr (GATHER) { PG8_STAGE(bufoff, gptr, vg[h]); } else { PG8_STAGE(bufoff, (gptr) + (h) * hstepA, voffA); } } while (0)
#define PG8_LDA(dst, b, h) do { if constexpr (F8) { _Pragma("unroll") for (int m = 0; m < 4; ++m) dst##8[m] = *(const LAS v8i_t*)(lds + PG8_SA(b, h) + aoffk[0] + m * 2048); } \
    else { _Pragma("unroll") for (int m = 0; m < 4; ++m) _Pragma("unroll") for (int k = 0; k < 2; ++k) dst[m][k] = *(const LAS bf16x8*)(lds + PG8_SA(b, h) + aoffk[k] + m * 2048); } } while (0)
#define PG8_LDB(dst, b, h) do { if constexpr (F8) { _Pragma("unroll") for (int n = 0; n < 2; ++n) dst##8[n] = *(const LAS v8i_t*)(lds + PG8_SB(b, h) + boffk[0] + n * 2048); } \
    else { _Pragma("unroll") for (int n = 0; n < 2; ++n) _Pragma("unroll") for (int k = 0; k < 2; ++k) dst[n][k] = *(const LAS bf16x8*)(lds + PG8_SB(b, h) + boffk[k] + n * 2048); } } while (0)
#define PG8_MMA(ai, bj, At, Bt) do { __builtin_amdgcn_s_setprio(1); \
    if constexpr (F8) { _Pragma("unroll") for (int m = 0; m < 4; ++m) _Pragma("unroll") for (int n = 0; n < 2; ++n) \
        acc[ai][bj][m][n] = __builtin_amdgcn_mfma_scale_f32_16x16x128_f8f6f4(Bt##8[n], At##8[m], acc[ai][bj][m][n], 0, 0, 0, WSC, 0, ASC); } \
    else { _Pragma("unroll") for (int m = 0; m < 4; ++m) _Pragma("unroll") for (int n = 0; n < 2; ++n) _Pragma("unroll") for (int k = 0; k < 2; ++k) \
        acc[ai][bj][m][n] = __builtin_amdgcn_mfma_f32_16x16x32_bf16(Bt[n][k], At[m][k], acc[ai][bj][m][n], 0, 0, 0); } __builtin_amdgcn_s_setprio(0); } while (0)
#define PG8_WAIT_V(n) asm volatile("s_waitcnt vmcnt(" #n ")" ::: "memory")
#define PG8_WAIT_L(n) asm volatile("s_waitcnt lgkmcnt(" #n ")" ::: "memory")
#define PG8_BAR __builtin_amdgcn_s_barrier()
#define PG8_SCHED __builtin_amdgcn_sched_barrier(0)
    Unit cur, nxt; int ui = 0;
    if (!S.next(0, cur)) return;
    f32x4 acc[2][2][4][2];
#pragma unroll
    for (int a = 0; a < 2; ++a)
#pragma unroll
        for (int b = 0; b < 2; ++b)
#pragma unroll
            for (int m = 0; m < 4; ++m)
#pragma unroll
                for (int n = 0; n < 2; ++n) acc[a][b][m][n] = (f32x4){0.f, 0.f, 0.f, 0.f};
    bf16x8 At[4][2], B0[2][2], B1[2][2]; v8i_t At8[4], B08[2], B18[2];
    unsigned vgc[2][2], vgn[2][2];
    if constexpr (GATHER) {
#pragma unroll
        for (int h = 0; h < 2; ++h)
#pragma unroll
            for (int i = 0; i < 2; ++i) { const int gr = g.gather[cur.pm * BM + h * HALF + RA[i]]; vgc[h][i] = (unsigned)(gr * g.lda + CA[i]) * 2u; vgn[h][i] = vgc[h][i]; }
    }
    const char* cA = GATHER ? (const char*)g.A : (const char*)g.A + (size_t)cur.pm * tstepA;
    const char* cB = (const char*)g.Bt + (size_t)(cur.pm >> g.bshift) * g.bstride * 2 + (size_t)cur.pn * tstepB;
    PG8_STAGE(PG8_SB(0, 0), cB, voffB); PG8_STAGE(PG8_SB(0, 1), cB + hstepB, voffB); PG8_STAGE_A(PG8_SA(0, 0), cA, 0, vgc); PG8_STAGE_A(PG8_SA(0, 1), cA, 1, vgc);
    if (wr == 1) PG8_BAR;
    PG8_WAIT_V(2); PG8_BAR;
    PG8_STAGE(PG8_SB(1, 0), cB + kstep, voffB); PG8_STAGE_A(PG8_SA(1, 0), cA + kstep, 0, vgc); PG8_STAGE(PG8_SB(1, 1), cB + hstepB + kstep, voffB);
    PG8_WAIT_V(6); PG8_BAR;
    for (;;) {
        const bool has_next = S.next(ui + 1, nxt);
        if constexpr (GATHER) {
            if (has_next) { int t2 = tid; asm volatile("" : "+v"(t2));
#pragma unroll
                for (int i = 0; i < 2; ++i) { int R, C; stage_rc(t2 * 16 + i * 8192, R, C);
#pragma unroll
                    for (int h = 0; h < 2; ++h) { const int gr = g.gather[nxt.pm * BM + h * HALF + R]; vgn[h][i] = (unsigned)(gr * g.lda + C) * 2u; } }
            }
        }
        const char* nA = has_next ? (GATHER ? (const char*)g.A : (const char*)g.A + (size_t)nxt.pm * tstepA) : cA;
        const char* nB = has_next ? (const char*)g.Bt + (size_t)(nxt.pm >> g.bshift) * g.bstride * 2 + (size_t)nxt.pn * tstepB : cB;
#pragma nounroll
        for (int t = 0; t < nt; t += 2) {
            const bool last = (t == nt - 2);
            asm volatile("" : "+v"(voffB[0]), "+v"(voffB[1]));
            if constexpr (GATHER) asm volatile("" : "+v"(vgc[0][0]), "+v"(vgc[0][1]), "+v"(vgc[1][0]), "+v"(vgc[1][1]), "+v"(vgn[0][0]), "+v"(vgn[0][1]), "+v"(vgn[1][0]), "+v"(vgn[1][1]));
            else asm volatile("" : "+v"(voffA[0]), "+v"(voffA[1]));
            const char* a1 = cA + (size_t)(t + 1) * kstep;
            const char* a2 = last ? nA : cA + (size_t)(t + 2) * kstep; const char* b2 = last ? nB : cB + (size_t)(t + 2) * kstep;
            const char* a3 = a2 + kstep; const char* b3 = b2 + kstep;
            PG8_LDB(B0, 0, 0); PG8_LDB(B1, 0, 1); PG8_SCHED; PG8_LDA(At, 0, 0); PG8_STAGE_A(PG8_SA(1, 1), a1, 1, vgc);
            if constexpr (GATHER) { if (last && has_next) {
#pragma unroll
                for (int h = 0; h < 2; ++h)
#pragma unroll
                    for (int i = 0; i < 2; ++i) vgc[h][i] = vgn[h][i]; } }
            PG8_WAIT_V(8); PG8_WAIT_L(0); PG8_BAR; PG8_MMA(0, 0, At, B0); PG8_MMA(0, 1, At, B1); PG8_BAR; PG8_SCHED;
            PG8_LDA(At, 0, 1); PG8_STAGE(PG8_SB(0, 0), b2, voffB); PG8_STAGE(PG8_SB(0, 1), b2 + hstepB, voffB); PG8_STAGE_A(PG8_SA(0, 0), a2, 0, vgc);
            PG8_WAIT_V(8); PG8_WAIT_L(0); PG8_BAR; PG8_MMA(1, 0, At, B0); PG8_MMA(1, 1, At, B1); PG8_BAR; PG8_SCHED;
            PG8_LDB(B0, 1, 0); PG8_LDB(B1, 1, 1); PG8_SCHED; PG8_LDA(At, 1, 0); PG8_STAGE_A(PG8_SA(0, 1), a2, 1, vgc);
            PG8_WAIT_V(8); PG8_WAIT_L(0); PG8_BAR; PG8_MMA(0, 0, At, B0); PG8_MMA(0, 1, At, B1); PG8_BAR; PG8_SCHED;
            PG8_LDA(At, 1, 1); PG8_STAGE(PG8_SB(1, 0), b3, voffB); PG8_STAGE(PG8_SB(1, 1), b3 + hstepB, voffB); PG8_STAGE_A(PG8_SA(1, 0), a3, 0, vgc);
            PG8_WAIT_V(8); PG8_WAIT_L(0); PG8_BAR; PG8_MMA(1, 0, At, B0); PG8_MMA(1, 1, At, B1); PG8_BAR; PG8_SCHED;
        }
        if (wr == 0) PG8_BAR;
        { int te = threadIdx.x; asm volatile("" : "+v"(te)); E(acc, cur, wr, wc, te & 15, (te >> 4) & 3); }
        if (!has_next) break;
#pragma unroll
        for (int a = 0; a < 2; ++a)
#pragma unroll
            for (int b = 0; b < 2; ++b)
#pragma unroll
                for (int m = 0; m < 4; ++m)
#pragma unroll
                    for (int n = 0; n < 2; ++n) acc[a][b][m][n] = (f32x4){0.f, 0.f, 0.f, 0.f};
        cur = nxt; cA = nA; cB = nB; ++ui;
        if (wr == 1) PG8_BAR;
    }
    PG8_WAIT_V(0);
    PG8_BAR;
#undef PG8_SA
#undef PG8_SB
#undef PG8_STAGE
#undef PG8_STAGE_A
#undef PG8_LDA
#undef PG8_LDB
#undef PG8_MMA
#undef PG8_WAIT_V
#undef PG8_WAIT_L
#undef PG8_BAR
#undef PG8_SCHED
}
}
namespace pg8 {
struct EpiStoreBf16 {
    static constexpr bool PERM = true;
    bf16_t* O; int ldc;
    __device__ __forceinline__ void operator()(const f32x4 (&acc)[2][2][4][2], const Unit& u, int wr, int wc, int fr, int fq) const {
        const int row0 = u.pm * BM + wr * 64 + fr, col0 = u.pn * BM + wc * 32 + 8 * fq;
#pragma unroll
        for (int ai = 0; ai < 2; ++ai)
#pragma unroll
            for (int m = 0; m < 4; ++m) { bf16_t* rowp = O + (size_t)(row0 + ai * HALF + m * 16) * ldc + col0;
#pragma unroll
                for (int bj = 0; bj < 2; ++bj) { const f32x4 v0 = acc[ai][bj][m][0], v1 = acc[ai][bj][m][1];
                    u32x4 w; w.x = cvt_pk_bf16(v0[0], v0[1]); w.y = cvt_pk_bf16(v0[2], v0[3]); w.z = cvt_pk_bf16(v1[0], v1[1]); w.w = cvt_pk_bf16(v1[2], v1[3]);
                    *(u32x4*)(rowp + bj * HALF) = w; } }
    }
};
struct EpiQRope {
    static constexpr bool PERM = true;
    bf16_t* O; const f32x2* tab;
    __device__ __forceinline__ void operator()(const f32x4 (&acc)[2][2][4][2], const Unit& u, int wr, int wc, int fr, int fq) const {
        const int row0 = u.pm * BM + wr * 64 + fr, col0 = u.pn * BM + wc * 32 + 8 * fq;
#pragma unroll
        for (int bj = 0; bj < 2; ++bj) {
            const int col = col0 + bj * HALF, within = col % 192;
            const bool pe = within >= 128; const int p0 = (within - 128) >> 1;
#pragma unroll
            for (int ai = 0; ai < 2; ++ai)
#pragma unroll
                for (int m = 0; m < 4; ++m) { const int row = row0 + ai * HALF + m * 16;
                    f32x4 v0 = acc[ai][bj][m][0], v1 = acc[ai][bj][m][1];
                    if (pe) { const f32x2* tp = tab + (size_t)(row & 4095) * 32 + p0; const f32x4 t01 = *(const f32x4*)tp, t23 = *(const f32x4*)(tp + 2);
                        const f32x4 a = v0, b = v1;
                        v0[0] = a[0] * t01[0] - a[1] * t01[1]; v0[1] = a[0] * t01[1] + a[1] * t01[0]; v0[2] = a[2] * t01[2] - a[3] * t01[3]; v0[3] = a[2] * t01[3] + a[3] * t01[2];
                        v1[0] = b[0] * t23[0] - b[1] * t23[1]; v1[1] = b[0] * t23[1] + b[1] * t23[0]; v1[2] = b[2] * t23[2] - b[3] * t23[3]; v1[3] = b[2] * t23[3] + b[3] * t23[2]; }
                    u32x4 w; w.x = cvt_pk_bf16(v0[0], v0[1]); w.y = cvt_pk_bf16(v0[2], v0[3]); w.z = cvt_pk_bf16(v1[0], v1[1]); w.w = cvt_pk_bf16(v1[2], v1[3]);
                    *(u32x4*)(O + (size_t)row * 1536 + col) = w; asm volatile("" ::: "memory"); }
        }
    }
};
struct EpiKV {
    static constexpr bool PERM = true;
    bf16_t* Km; bf16_t* Vm;
    __device__ __forceinline__ void operator()(const f32x4 (&acc)[2][2][4][2], const Unit& u, int wr, int wc, int fr, int fq) const {
        const int row0 = u.pm * BM + wr * 64 + fr, c = wc * 32 + 8 * fq;
#pragma unroll
        for (int ai = 0; ai < 2; ++ai)
#pragma unroll
            for (int m = 0; m < 4; ++m) { const size_t row = (size_t)(row0 + ai * HALF + m * 16);
#pragma unroll
                for (int bj = 0; bj < 2; ++bj) { const f32x4 v0 = acc[ai][bj][m][0], v1 = acc[ai][bj][m][1];
                    u32x4 w; w.x = cvt_pk_bf16(v0[0], v0[1]); w.y = cvt_pk_bf16(v0[2], v0[3]); w.z = cvt_pk_bf16(v1[0], v1[1]); w.w = cvt_pk_bf16(v1[2], v1[3]);
                    if (bj == 0) *(u32x4*)(Km + row * 1536 + u.pn * 192 + c) = w; else *(u32x4*)(Vm + row * 1024 + u.pn * 128 + c) = w; }
                asm volatile("" ::: "memory"); }
    }
};
struct EpiResid {
    static constexpr bool PERM = false;
    const float* X; float* Y; float alpha;
    __device__ __forceinline__ void operator()(const f32x4 (&acc)[2][2][4][2], const Unit& u, int wr, int wc, int fr, int fq) const {
        const int row0 = u.pm * BM + wr * 64 + fr, col0 = u.pn * BM + wc * 32 + 4 * fq;
#pragma unroll
        for (int ai = 0; ai < 2; ++ai)
#pragma unroll
            for (int m = 0; m < 4; ++m) { const size_t off = (size_t)(row0 + ai * HALF + m * 16) * 2048 + col0;
#pragma unroll
                for (int bj = 0; bj < 2; ++bj)
#pragma unroll
                    for (int n = 0; n < 2; ++n) { const f32x4 xv = *(const f32x4*)(X + off + bj * HALF + n * 16); *(f32x4*)(Y + off + bj * HALF + n * 16) = xv * alpha + acc[ai][bj][m][n]; }
                if (m & 1) asm volatile("" ::: "memory"); }
    }
};
struct EpiSwiglu {
    static constexpr bool PERM = true;
    bf16_t* O;
    __device__ __forceinline__ void operator()(const f32x4 (&acc)[2][2][4][2], const Unit& u, int wr, int wc, int fr, int fq) const {
        const int row0 = u.pm * BM + wr * 64 + fr, col0 = u.pn * HALF + wc * 32 + 8 * fq;
#pragma unroll
        for (int ai = 0; ai < 2; ++ai)
#pragma unroll
            for (int m = 0; m < 4; ++m) { float h[8];
#pragma unroll
                for (int n = 0; n < 2; ++n)
#pragma unroll
                    for (int j = 0; j < 4; ++j) { const float a = acc[ai][0][m][n][j], b = acc[ai][1][m][n][j]; h[n * 4 + j] = a * __builtin_amdgcn_rcpf(1.f + __expf(-a)) * b; }
                u32x4 w; w.x = cvt_pk_bf16(h[0], h[1]); w.y = cvt_pk_bf16(h[2], h[3]); w.z = cvt_pk_bf16(h[4], h[5]); w.w = cvt_pk_bf16(h[6], h[7]);
                *(u32x4*)(O + (size_t)(row0 + ai * HALF + m * 16) * 1536 + col0) = w; }
    }
};
struct EpiSwigluF8 {
    static constexpr bool PERM = true;
    unsigned char* O;
    __device__ __forceinline__ void operator()(const f32x4 (&acc)[2][2][4][2], const Unit& u, int wr, int wc, int fr, int fq) const {
        const int row0 = u.pm * BM + wr * 64 + fr, col0 = u.pn * HALF + wc * 32 + 8 * fq;
#pragma unroll
        for (int ai = 0; ai < 2; ++ai)
#pragma unroll
            for (int m = 0; m < 4; ++m) { float h[8];
#pragma unroll
                for (int n = 0; n < 2; ++n)
#pragma unroll
                    for (int j = 0; j < 4; ++j) { const float a = acc[ai][0][m][n][j], b = acc[ai][1][m][n][j]; h[n * 4 + j] = a * __builtin_amdgcn_rcpf(1.f + __expf(-a)) * b; }
                int w0 = __builtin_amdgcn_cvt_pk_fp8_f32(h[0], h[1], 0, false); w0 = __builtin_amdgcn_cvt_pk_fp8_f32(h[2], h[3], w0, true);
                int w1 = __builtin_amdgcn_cvt_pk_fp8_f32(h[4], h[5], 0, false); w1 = __builtin_amdgcn_cvt_pk_fp8_f32(h[6], h[7], w1, true);
                u32x2 w; w.x = (unsigned)w0; w.y = (unsigned)w1;
                *(u32x2*)(O + (size_t)(row0 + ai * HALF + m * 16) * 1536 + col0) = w; }
    }
};
struct EpiGate {
    static constexpr bool PERM = true;
    bf16_t* O; const float* gate;
    __device__ __forceinline__ void operator()(const f32x4 (&acc)[2][2][4][2], const Unit& u, int wr, int wc, int fr, int fq) const {
        const int row0 = u.pm * BM + wr * 64 + fr, col0 = u.pn * BM + wc * 32 + 8 * fq;
#pragma unroll
        for (int ai = 0; ai < 2; ++ai)
#pragma unroll
            for (int m = 0; m < 4; ++m) { const int row = row0 + ai * HALF + m * 16; const float gt = gate[row]; bf16_t* rowp = O + (size_t)row * 2048 + col0;
#pragma unroll
                for (int bj = 0; bj < 2; ++bj) { const f32x4 v0 = acc[ai][bj][m][0] * gt, v1 = acc[ai][bj][m][1] * gt;
                    u32x4 w; w.x = cvt_pk_bf16(v0[0], v0[1]); w.y = cvt_pk_bf16(v0[2], v0[3]); w.z = cvt_pk_bf16(v1[0], v1[1]); w.w = cvt_pk_bf16(v1[2], v1[3]);
                    *(u32x4*)(rowp + bj * HALF) = w; } }
    }
};
}
namespace attn {
constexpr int NW = 8, QBLK = 32, KVBLK = 64, DV = 128;
#define SBAR() __builtin_amdgcn_sched_barrier(0)
__device__ __forceinline__ int crow(int r, int hi) { return (r & 3) + 8 * (r >> 2) + 4 * hi; }
template <int DQK> __device__ __forceinline__ int kswz(int row, int colB) {
    if constexpr (DQK == 128) return row * 256 + (colB ^ ((row & 15) << 4));
    else return row * (DQK * 2) + (colB ^ (((row >> 1) & 7) << 4));
}
template <int DQK> struct Shm { static constexpr int V = KVBLK * DV * 2, K = KVBLK * DQK * 2, TOTAL = 3 * V + 3 * K + NW * 64 * 4; };

template <float const& CREF> struct Dummy {};
__device__ __forceinline__ void partialSM(f32x16& p0, f32x16& p1, float& m_reg, float& mn, float& alpha, const float C, const float thr) {
  float pmax = p0[0];
#pragma unroll
  for (int r = 1; r < 16; ++r) pmax = fmaxf(pmax, p0[r]);
#pragma unroll
  for (int r = 0; r < 16; ++r) pmax = fmaxf(pmax, p1[r]);
  { auto rr = __builtin_amdgcn_permlane32_swap(__float_as_uint(pmax), __float_as_uint(pmax), false, false);
    pmax = fmaxf(__uint_as_float(rr[0]), __uint_as_float(rr[1])); }
  if (__builtin_expect(__all(pmax - m_reg <= thr), 1)) { mn = m_reg; alpha = 1.f; }
  else { mn = fmaxf(m_reg, pmax); alpha = __builtin_amdgcn_exp2f((m_reg - mn) * C); m_reg = mn; }
  float mnC = -mn * C;
#pragma unroll
  for (int r = 0; r < 16; ++r) p0[r] = fmaf(p0[r], C, mnC);
#pragma unroll
  for (int r = 0; r < 16; ++r) p1[r] = fmaf(p1[r], C, mnC);
#pragma unroll
  for (int r = 0; r < 16; ++r) p0[r] = __builtin_amdgcn_exp2f(p0[r]);
}
__device__ __forceinline__ void finishSM(f32x16& p0, f32x16& p1, float alpha, float& l_reg, bf16x8& pa0, bf16x8& pa1, bf16x8& pa2, bf16x8& pa3) {
#pragma unroll
  for (int r = 0; r < 16; ++r) p1[r] = __builtin_amdgcn_exp2f(p1[r]);
  float ps = 0;
#pragma unroll
  for (int r = 0; r < 16; ++r) ps += p0[r];
#pragma unroll
  for (int r = 0; r < 16; ++r) ps += p1[r];
  { auto rr = __builtin_amdgcn_permlane32_swap(__float_as_uint(ps), __float_as_uint(ps), false, false);
    ps = __uint_as_float(rr[0]) + __uint_as_float(rr[1]); }
  l_reg = l_reg * alpha + ps;
#define PK4(P, BASE, OUT) do { unsigned a0 = cvt_pk_bf16(P[BASE + 0], P[BASE + 1]), a1 = cvt_pk_bf16(P[BASE + 2], P[BASE + 3]);   \
    unsigned b0 = cvt_pk_bf16(P[BASE + 4], P[BASE + 5]), b1 = cvt_pk_bf16(P[BASE + 6], P[BASE + 7]);                              \
    auto r0 = __builtin_amdgcn_permlane32_swap(a0, b0, false, false); auto r1 = __builtin_amdgcn_permlane32_swap(a1, b1, false, false); \
    u32x4 w = {r0[0], r1[0], r0[1], r1[1]}; OUT = *reinterpret_cast<bf16x8*>(&w); } while (0)
  PK4(p0, 0, pa0); PK4(p0, 8, pa1); PK4(p1, 0, pa2); PK4(p1, 8, pa3);
#undef PK4
}
template <int DQK>
__device__ __forceinline__ void qkt(f32x16& p0, f32x16& p1, const char* Ks, const bf16x8* qr, int r32, int hi) {
  p0 = f32x16{}; p1 = f32x16{};
#pragma unroll
  for (int d0 = 0; d0 < DQK / 16; ++d0) { int cb = (d0 * 16 + hi * 8) * 2;
    bf16x8 b0 = *reinterpret_cast<const bf16x8*>(Ks + kswz<DQK>(r32, cb));
    bf16x8 b1 = *reinterpret_cast<const bf16x8*>(Ks + kswz<DQK>(32 + r32, cb));
    p0 = __builtin_amdgcn_mfma_f32_32x32x16_bf16(b0, qr[d0], p0, 0, 0, 0);
    p1 = __builtin_amdgcn_mfma_f32_32x32x16_bf16(b1, qr[d0], p1, 0, 0, 0); }
}
__device__ __forceinline__ int v_st(int k, int c) { const int kk = (k & ~0xC) | ((k & 4) << 1) | ((k & 8) >> 1); return ((kk >> 3) * 4 + (c >> 5)) * 512 + ((kk & 7) * 32 + (c & 31)) * 2; }
__device__ __forceinline__ int v_rd_base(int lane) { return ((lane & 3) << 3) | (((lane >> 2) & 3) << 6) | (((lane >> 4) & 1) << 5) | (((lane >> 5) & 1) << 8); }
constexpr int v_rd_off(int d0, int ks, int half) { return d0 * 512 + ks * 4096 + half * 2048; }
template <int OFF> __device__ __forceinline__ s16x4 tr_read(int vb) {
  s16x4 r; asm volatile("ds_read_b64_tr_b16 %0, %1 offset:%2" : "=&v"(r) : "v"(vb), "i"(OFF) : "memory"); return r;
}
template <int D0> __device__ __forceinline__ void pv_one(f32x16& od, int vb, bf16x8 pa0, bf16x8 pa1, bf16x8 pa2, bf16x8 pa3) {
  const s16x4 l0 = tr_read<v_rd_off(D0, 0, 0)>(vb), h0 = tr_read<v_rd_off(D0, 0, 1)>(vb), l1 = tr_read<v_rd_off(D0, 1, 0)>(vb), h1 = tr_read<v_rd_off(D0, 1, 1)>(vb);
  const s16x4 l2 = tr_read<v_rd_off(D0, 2, 0)>(vb), h2 = tr_read<v_rd_off(D0, 2, 1)>(vb), l3 = tr_read<v_rd_off(D0, 3, 0)>(vb), h3 = tr_read<v_rd_off(D0, 3, 1)>(vb);
  asm volatile("s_waitcnt lgkmcnt(0)" ::: "memory"); SBAR();
#define PK(L, H) (bf16x8){L[0], L[1], L[2], L[3], H[0], H[1], H[2], H[3]}
  od = __builtin_amdgcn_mfma_f32_32x32x16_bf16(pa0, PK(l0, h0), od, 0, 0, 0);
  od = __builtin_amdgcn_mfma_f32_32x32x16_bf16(pa1, PK(l1, h1), od, 0, 0, 0);
  od = __builtin_amdgcn_mfma_f32_32x32x16_bf16(pa2, PK(l2, h2), od, 0, 0, 0);
  od = __builtin_amdgcn_mfma_f32_32x32x16_bf16(pa3, PK(l3, h3), od, 0, 0, 0);
#undef PK
}
__device__ __forceinline__ void pv_d0(f32x16* o, int vb, bf16x8 pa0, bf16x8 pa1, bf16x8 pa2, bf16x8 pa3) {
  pv_one<0>(o[0], vb, pa0, pa1, pa2, pa3); pv_one<1>(o[1], vb, pa0, pa1, pa2, pa3); pv_one<2>(o[2], vb, pa0, pa1, pa2, pa3); pv_one<3>(o[3], vb, pa0, pa1, pa2, pa3);
}

__device__ __forceinline__ void glds16(const void* gsrc, unsigned lds_dst) { unsigned keep;
  asm volatile("s_mov_b32 %0, m0\n\ts_mov_b32 m0, %2\n\ts_nop 0\n\tglobal_load_lds_dwordx4 %1, off\n\ts_mov_b32 m0, %0" : "=&s"(keep) : "v"(gsrc), "s"(lds_dst) : "memory"); }
#define ATT_WAIT_BAR(N) asm volatile("s_waitcnt vmcnt(" #N ") lgkmcnt(0)\n\ts_barrier" ::: "memory")
__device__ __forceinline__ int nx3(int s) { return s == 2 ? 0 : s + 1; }
template <int DQK, int LDQ, int LDK, int LDV, int LDO>
__device__ __forceinline__ void attn_unit(const bf16_t* __restrict__ Qb, const bf16_t* __restrict__ Kh, const bf16_t* __restrict__ Vh, unsigned char* __restrict__ Ob, int seq, char* lds) {
  constexpr float scale = (DQK == 128) ? 0.08838834764831845f : 0.07216878364870323f;
  constexpr int SHM_V = KVBLK * DV * 2, SHM_K = KVBLK * DQK * 2, NQ = DQK / 16, NKP = SHM_K / 8192;
  constexpr int KRING = 0, VRING = 3 * SHM_K, WSOFF = 3 * SHM_K + 3 * SHM_V;
  constexpr float C = scale * 1.4426950408889634f, thr = 8.f / scale;
  int tid_ = threadIdx.x; asm volatile("" : "+v"(tid_));
  const int tid = tid_, lane = tid & 63, r32 = lane & 31, hi = lane >> 5; const int wid = __builtin_amdgcn_readfirstlane(tid >> 6);
  const unsigned lds0 = (unsigned)(uintptr_t)lds;
  float* ws = (float*)(lds + WSOFF) + wid * 64; float* li_l = ws; float* al_l = ws + 32;
  float m_reg = -1e30f, l_reg = 0; f32x16 o[4] = {}; bf16x8 qr[NQ];
  const bf16_t* Qw = Qb + (long)(wid * QBLK + r32) * LDQ + hi * 8;
#pragma unroll
  for (int d0 = 0; d0 < NQ; ++d0) qr[d0] = *reinterpret_cast<const bf16x8*>(Qw + d0 * 16);
  int koff[NKP], voff[2];
#pragma unroll
  for (int p = 0; p < NKP; ++p) { const int P = (p * 8 + wid) * 1024 + lane * 16, row = P / (DQK * 2), cs = P % (DQK * 2);
    const int colB = (DQK == 128) ? (cs ^ ((row & 15) << 4)) : (cs ^ (((row >> 1) & 7) << 4)); koff[p] = row * LDK + (colB >> 1); }
#pragma unroll
  for (int p = 0; p < 2; ++p) { const int P = (p * 8 + wid) * 1024 + lane * 16, sub = P >> 9, w5 = P & 511, kk = (sub >> 2) * 8 + (w5 >> 6), c = (sub & 3) * 32 + ((w5 & 63) >> 1);
    const int k = (kk & ~0xC) | ((kk & 4) << 1) | ((kk & 8) >> 1); voff[p] = k * LDV + c; }
#define DMA_K(t, slot) do { _Pragma("unroll") for (int p = 0; p < NKP; ++p) glds16(Kh + (long)(t) * KVBLK * LDK + koff[p], (unsigned)__builtin_amdgcn_readfirstlane((int)(lds0 + KRING + (slot) * SHM_K + (p * 8 + wid) * 1024))); } while (0)
#define DMA_V(t, slot) do { _Pragma("unroll") for (int p = 0; p < 2; ++p) glds16(Vh + (long)(t) * KVBLK * LDV + voff[p], (unsigned)__builtin_amdgcn_readfirstlane((int)(lds0 + VRING + (slot) * SHM_V + (p * 8 + wid) * 1024))); } while (0)
#define RESC(a) do { if (__any((a) < 1.f)) { if (hi == 0) al_l[r32] = (a); asm volatile("s_waitcnt lgkmcnt(0)" ::: "memory"); \
    _Pragma("unroll") for (int d = 0; d < 4; ++d) _Pragma("unroll") for (int r = 0; r < 16; ++r) o[d][r] *= al_l[crow(r, hi)]; } } while (0)
#define CLOSE(t) do { if ((t) + 2 < NT) { if constexpr (NKP == 2) ATT_WAIT_BAR(4); else ATT_WAIT_BAR(5); } else ATT_WAIT_BAR(0); } while (0)
  const int vb0 = (int)(lds0 + VRING) + v_rd_base(lane);
  const char* Kr = lds + KRING;
  f32x16 pA0, pA1, pB0, pB1; float mnA, mnB, alA, alB; bf16x8 pa0, pa1, pa2, pa3; const int NT = seq / KVBLK;
  DMA_K(0, 0); DMA_V(0, 0); DMA_K(1, 1);
  if constexpr (NKP == 2) ATT_WAIT_BAR(2); else ATT_WAIT_BAR(3);
  DMA_K(2, 2); DMA_V(1, 1);
  qkt<DQK>(pA0, pA1, Kr, qr, r32, hi); partialSM(pA0, pA1, m_reg, mnA, alA, C, thr);
  CLOSE(0);
  int sk = 1;
  for (int j = 1; j + 1 < NT; j += 2) {
    { const int s1 = nx3(sk), s2 = nx3(s1);
      if (j + 2 < NT) DMA_K(j + 2, s2); DMA_V(j + 1, s1);
      SBAR(); qkt<DQK>(pB0, pB1, Kr + sk * SHM_K, qr, r32, hi);
      finishSM(pA0, pA1, alA, l_reg, pa0, pa1, pa2, pa3); SBAR();
      pv_d0(o, vb0 + s2 * SHM_V, pa0, pa1, pa2, pa3); partialSM(pB0, pB1, m_reg, mnB, alB, C, thr);
      RESC(alB); CLOSE(j); sk = s1; }
    { const int s1 = nx3(sk), s2 = nx3(s1);
      if (j + 3 < NT) DMA_K(j + 3, s2); if (j + 2 < NT) DMA_V(j + 2, s1);
      SBAR(); qkt<DQK>(pA0, pA1, Kr + sk * SHM_K, qr, r32, hi);
      finishSM(pB0, pB1, alB, l_reg, pa0, pa1, pa2, pa3); SBAR();
      pv_d0(o, vb0 + s2 * SHM_V, pa0, pa1, pa2, pa3); partialSM(pA0, pA1, m_reg, mnA, alA, C, thr);
      RESC(alA); CLOSE(j + 1); sk = s1; }
  }
  { const int s1 = nx3(sk), s2 = nx3(s1);
    SBAR(); qkt<DQK>(pB0, pB1, Kr + sk * SHM_K, qr, r32, hi);
    finishSM(pA0, pA1, alA, l_reg, pa0, pa1, pa2, pa3); SBAR();
    pv_d0(o, vb0 + s2 * SHM_V, pa0, pa1, pa2, pa3); partialSM(pB0, pB1, m_reg, mnB, alB, C, thr);
    RESC(alB);
    finishSM(pB0, pB1, alB, l_reg, pa0, pa1, pa2, pa3); SBAR();
    pv_d0(o, vb0 + sk * SHM_V, pa0, pa1, pa2, pa3); (void)s1; }
  if (hi == 0) li_l[r32] = l_reg; asm volatile("s_waitcnt lgkmcnt(0)" ::: "memory");
  float rli[16];
#pragma unroll
  for (int r = 0; r < 16; ++r) rli[r] = __builtin_amdgcn_rcpf(li_l[crow(r, hi)]);
  unsigned char* Ow = Ob + (long)(wid * QBLK) * LDO;
#pragma unroll
  for (int r = 0; r < 16; ++r) { int orow = crow(r, hi); const float sc = rli[r] * 32.f;
#pragma unroll
    for (int d0 = 0; d0 < 4; ++d0) { const float v = o[d0][r] * sc; Ow[(long)orow * LDO + d0 * 32 + r32] = (unsigned char)__builtin_amdgcn_cvt_pk_fp8_f32(v, v, 0, false); } }
  ATT_WAIT_BAR(0);
#undef DMA_K
#undef DMA_V
#undef RESC
#undef CLOSE
}
}
constexpr int BATCH = 4, SEQ = 4096, DM = 2048, M = BATCH * SEQ, DEPTH = 4;
constexpr int NEXP = 16, FF = 1536, CAP = 512, MX = NEXP * BATCH * CAP;
constexpr int HW = 4096;
constexpr int C_CQ = 0, C_CKV = 512, C_GQ = 768, C_GK = 1280, C_GV = 1792, C_GR = 2816, C_KR = 3840, C_LAT = 3904;
constexpr float LN_EPS = 1e-5f, RMS_EPS = 1e-6f;
constexpr float DN_ALPHA = 1.681792830507429f;
constexpr float MLA_SCALE = 0.07216878364870323f;
constexpr float GQA_SCALE = 0.08838834764831845f;

constexpr size_t MiB = 1u << 20;
constexpr size_t WS_CTL = 0, CTL_ZERO_BYTES = 1 * MiB;
constexpr size_t WS_ROPER = 1 * MiB, WS_ROPEG = 2 * MiB, WS_AFF = 4 * MiB, WS_IDX = 5 * MiB, WS_GATE = 5 * MiB + 512 * 1024, WS_SLOT = 6 * MiB, WS_DECAY = 7 * MiB;
constexpr size_t WS_WIN = 8 * MiB, WS_WUQ = 40 * MiB, WS_WUKV = 43 * MiB, WS_WMO = 48 * MiB, WS_WQKV = 64 * MiB, WS_WGO = 88 * MiB, WS_W13 = 104 * MiB, WS_W2 = 872 * MiB;
constexpr size_t WS_XB = 1256 * MiB, WS_X1 = 1320 * MiB, WS_X1B = 1448 * MiB, WS_H = 1512 * MiB, WS_QM = 1640 * MiB, WS_KM = 1688 * MiB, WS_VM = 1736 * MiB, WS_OCAT = 1768 * MiB;
constexpr size_t WS_QIN = 1832 * MiB, WS_KIN = 1864 * MiB, WS_KST = 1896 * MiB, WS_VT = 1928 * MiB, WS_OF = 1960 * MiB, WS_OB = 2024 * MiB, WS_HDN = 2088 * MiB, WS_Y = 2184 * MiB, WS_END = 2312 * MiB;
constexpr int CW_TMO = 0, CW_DBG = 2, CW_BAR = 4096;

constexpr int RING_BYTES = 131072, MISC_OFF = RING_BYTES + 320, LDS_BYTES = 147456;
constexpr int NWAVES = 8, NTHR = 512;

#define RLX_AGENT __ATOMIC_RELAXED, __HIP_MEMORY_SCOPE_AGENT
#define LDS_WAIT() asm volatile("s_waitcnt lgkmcnt(0)" ::: "memory")
#define VM_WAIT() asm volatile("s_waitcnt vmcnt(0)" ::: "memory")

#define XB_TMO      128
#define XB_XCNT(j)  (256  + 64 * (j))
#define XB_XSUB(j)  (1280 + 64 * (j))
#define XB_XGEN(j)  (2304 + 64 * (j))
#define XB_TOP      3328
#define XB_TOPGEN   3392
#define XCD_BAR_WORDS 3456
#define XB_SPIN_CAP (1u << 22)
__device__ __forceinline__ unsigned xb_ld(unsigned* p)              { return __hip_atomic_load(p, __ATOMIC_RELAXED, __HIP_MEMORY_SCOPE_AGENT); }
__device__ __forceinline__ unsigned xb_add(unsigned* p, unsigned v) { return __hip_atomic_fetch_add(p, v, __ATOMIC_RELAXED, __HIP_MEMORY_SCOPE_AGENT); }
__device__ __forceinline__ unsigned xb_xcc_id() { return (unsigned)__builtin_amdgcn_s_getreg((3 << 11) | 20) & 0xFu; }
#define XB_SPIN(cond, bar) do { unsigned _sp = 0; while (cond) { __builtin_amdgcn_s_sleep(6); \
    if ((++_sp & 255u) == 0u) { if (xb_ld(&(bar)[XB_TMO])) break; if (_sp > XB_SPIN_CAP) { atomicAdd(&(bar)[XB_TMO], 1u); break; } } } } while (0)
struct XcdBarrier { unsigned* bar; unsigned x; volatile LAS unsigned* st; };
__device__ __forceinline__ XcdBarrier xcd_barrier_post(unsigned* bar, volatile LAS unsigned* st) {
    XcdBarrier b; b.bar = bar; b.x = xb_xcc_id(); b.st = st;
    if (threadIdx.x == 0) (void)xb_add(&bar[XB_XCNT(b.x)], 1u);
    return b;
}
__device__ __forceinline__ void xcd_barrier_complete(unsigned* bar, unsigned x, unsigned& nloc, unsigned& nx) {
    const unsigned G = gridDim.x * gridDim.y * gridDim.z;
    unsigned sum, cnt, mine, sp = 0u;
    for (;;) {
        sum = 0u; cnt = 0u; mine = 0u;
#pragma unroll
        for (unsigned j = 0; j < 16; ++j) { const unsigned c = xb_ld(&bar[XB_XCNT(j)]); sum += c; cnt += (c > 0u) ? 1u : 0u; mine = (j == x) ? c : mine; }
        if (sum == G) break;
        __builtin_amdgcn_s_sleep(1);
        if ((++sp & 255u) == 0u) { if (xb_ld(&bar[XB_TMO])) break; if (sp > XB_SPIN_CAP) { atomicAdd(&bar[XB_TMO], 1u); break; } }
    }
    nloc = mine > 0u ? mine : 1u; nx = cnt > 0u ? cnt : 1u;
}
__device__ __forceinline__ void xcd_barrier(const XcdBarrier& b) {
    asm volatile("s_waitcnt vmcnt(0)" ::: "memory");
    __syncthreads();
    if (threadIdx.x == 0) {
        unsigned* bar = b.bar;
        __builtin_amdgcn_s_waitcnt(0);
        unsigned nloc = b.st[0], nx = b.st[1];
        if (nloc == 0u) { xcd_barrier_complete(bar, b.x, nloc, nx); b.st[0] = nloc; b.st[1] = nx; }
        const unsigned old = xb_add(&bar[XB_XSUB(b.x)], 1u);
        const unsigned gen = old / nloc;
        if (old + 1u == (gen + 1u) * nloc) {
            __builtin_amdgcn_fence(__ATOMIC_RELEASE, "agent");
            asm volatile("s_waitcnt vmcnt(0)" ::: "memory");
            const unsigned og = xb_add(&bar[XB_TOP], 1u);
            const unsigned tg = og / nx;
            if (og + 1u == (tg + 1u) * nx) xb_add(&bar[XB_TOPGEN], 1u);
            else XB_SPIN(xb_ld(&bar[XB_TOPGEN]) == tg, bar);
            __builtin_amdgcn_fence(__ATOMIC_ACQUIRE, "agent");
            xb_add(&bar[XB_XGEN(b.x)], 1u);
            asm volatile("s_waitcnt vmcnt(0)" ::: "memory");
        } else {
            XB_SPIN(xb_ld(&bar[XB_XGEN(b.x)]) == gen, bar);
            __builtin_amdgcn_fence(__ATOMIC_ACQUIRE, "agent");
            asm volatile("s_waitcnt vmcnt(0)" ::: "memory");
        }
    }
    __syncthreads();
}

template <int CTRL, int ROWMASK> __device__ __forceinline__ float dpp_addf(float x) { return x + __int_as_float(__builtin_amdgcn_update_dpp(0, __float_as_int(x), CTRL, ROWMASK, 0xF, true)); }
template <int CTRL, int ROWMASK> __device__ __forceinline__ int dpp_addi(int x) { return x + __builtin_amdgcn_update_dpp(0, x, CTRL, ROWMASK, 0xF, true); }
__device__ __forceinline__ float row16_sum(float v) { v = dpp_addf<0xB1, 0xF>(v); v = dpp_addf<0x4E, 0xF>(v); v = dpp_addf<0x141, 0xF>(v); v = dpp_addf<0x140, 0xF>(v); return v; }
__device__ __forceinline__ float wave_sum(float v) {
    v = row16_sum(v); v = dpp_addf<0x142, 0xA>(v); v = dpp_addf<0x143, 0xC>(v);
    return __int_as_float(__builtin_amdgcn_readlane(__float_as_int(v), 63));
}
__device__ __forceinline__ int wave_sum_i(int v) {
    v = dpp_addi<0xB1, 0xF>(v); v = dpp_addi<0x4E, 0xF>(v); v = dpp_addi<0x141, 0xF>(v); v = dpp_addi<0x140, 0xF>(v); v = dpp_addi<0x142, 0xA>(v); v = dpp_addi<0x143, 0xC>(v);
    return __builtin_amdgcn_readlane(v, 63);
}
#define WG_BAR() do { asm volatile("s_waitcnt lgkmcnt(0)" ::: "memory"); __builtin_amdgcn_s_barrier(); asm volatile("" ::: "memory"); } while (0)

struct Ctx { LAS unsigned char* lds; int tid, lane, wave, vcu, G; };
__device__ __forceinline__ Ctx opaque_ctx(const Ctx& c) { Ctx d = c; asm volatile("" : "+v"(d.tid)); d.lane = d.tid & 63; d.wave = __builtin_amdgcn_readfirstlane(d.tid >> 6); return d; }

__device__ __forceinline__ void transpose_item(const float* W, int K, int N, bf16_t* WT, int dst_row0, int k0, int n0, LAS unsigned* scr, int lane) {
    const int r2 = lane >> 4, c4 = lane & 15; const bool ok = (n0 + 4 * c4) < N;
    const float* src = W + (size_t)(k0 + 2 * r2) * N + n0 + 4 * c4;
#pragma unroll
    for (int i = 0; i < 8; ++i) { f32x4 a = {0.f, 0.f, 0.f, 0.f}, b = {0.f, 0.f, 0.f, 0.f};
        if (ok) { a = __builtin_nontemporal_load((const f32x4*)(src + (size_t)(8 * i) * N)); b = __builtin_nontemporal_load((const f32x4*)(src + (size_t)(8 * i + 1) * N)); }
        const int p = 4 * i + r2;
#pragma unroll
        for (int j = 0; j < 4; ++j) scr[(4 * c4 + j) * 33 + p] = cvt_pk_bf16(a[j], b[j]); }
    LDS_WAIT(); asm volatile("" ::: "memory");
    const int nvalid = (N - n0) < 64 ? (N - n0) : 64;
#pragma unroll
    for (int q = 0; q < 8; ++q) { const int ci = lane + 64 * q, n = ci >> 3, ch = ci & 7; const LAS unsigned* s = scr + n * 33 + ch * 4;
        const u32x4 o = {s[0], s[1], s[2], s[3]};
        if (n < nvalid) __builtin_nontemporal_store(o, (u32x4*)(WT + (size_t)(dst_row0 + n) * K + k0 + 8 * ch)); }
    LDS_WAIT(); asm volatile("" ::: "memory");
}
__device__ __forceinline__ int map_row(int map, int n0) {
    if (map == 1) return (n0 < 768) ? n0 : (n0 < 832 ? n0 + 3072 : (n0 < 3904 ? n0 - 64 : n0));
    if (map == 2) return (n0 >> 7) * 256 + (n0 & 127);
    if (map == 3) return (n0 >> 7) * 256 + 128 + (n0 & 127);
    return n0;
}
__device__ __forceinline__ void transpose_batch(const Ctx& c, const float* src, bf16_t* dst, int K, int N, int nmat, size_t src_ms, size_t dst_ms, int map, int wg_rank = -1, int wg_count = 0) {
    LAS unsigned* scr = (LAS unsigned*)(c.lds + c.wave * 16384);
    const int gw = (wg_rank < 0 ? c.vcu : wg_rank) * NWAVES + c.wave, NGW = (wg_rank < 0 ? c.G : wg_count) * NWAVES;
    const int nblk = (N + 63) / 64, per = (K / 64) * nblk; const long total = (long)per * nmat;
    for (long it = gw; it < total; it += NGW) {
        const int mat = (int)(it / per), r = (int)(it % per), kb = r / nblk, nb = r % nblk;
        transpose_item(src + (size_t)mat * src_ms, K, N, dst + (size_t)mat * dst_ms, map_row(map, nb * 64), kb * 64, nb * 64, scr, c.lane);
    }
}

__device__ __forceinline__ void transpose_item_f8(const float* W, int K, int N, unsigned char* WT, int dst_row0, int k0, int n0, float mul, LAS unsigned* scr, int lane) {
    const int r2 = lane >> 4, c4 = lane & 15;
    const float* src = W + (size_t)(k0 + 4 * r2) * N + n0 + 4 * c4;
#pragma unroll
    for (int i = 0; i < 4; ++i) { const float* s_ = src + (size_t)(16 * i) * N;
        const f32x4 a = __builtin_nontemporal_load((const f32x4*)s_), b = __builtin_nontemporal_load((const f32x4*)(s_ + N)), cc = __builtin_nontemporal_load((const f32x4*)(s_ + 2 * (size_t)N)), d = __builtin_nontemporal_load((const f32x4*)(s_ + 3 * (size_t)N));
        const int p = 4 * i + r2;
#pragma unroll
        for (int j = 0; j < 4; ++j) { int w = __builtin_amdgcn_cvt_pk_fp8_f32(a[j] * mul, b[j] * mul, 0, false); w = __builtin_amdgcn_cvt_pk_fp8_f32(cc[j] * mul, d[j] * mul, w, true); scr[(4 * c4 + j) * 17 + p] = (unsigned)w; } }
    LDS_WAIT(); asm volatile("" ::: "memory");
#pragma unroll
    for (int q = 0; q < 4; ++q) { const int ci = lane + 64 * q, n = ci >> 2, ch = ci & 3; const LAS unsigned* s = scr + n * 17 + ch * 4;
        const u32x4 o = {s[0], s[1], s[2], s[3]};
        __builtin_nontemporal_store(o, (u32x4*)(WT + (size_t)(dst_row0 + n) * K + k0 + 16 * ch)); }
    LDS_WAIT(); asm volatile("" ::: "memory");
}
__device__ __forceinline__ void transpose_batch_f8(const Ctx& c, const float* src, unsigned char* dst, int K, int N, int nmat, size_t src_ms, size_t dst_ms, int map, float mul, int wg_rank = -1, int wg_count = 0, int ksplit = 1 << 30, float mul_hi = 0.f) {
    LAS unsigned* scr = (LAS unsigned*)(c.lds + c.wave * 16384);
    const int gw = (wg_rank < 0 ? c.vcu : wg_rank) * NWAVES + c.wave, NGW = (wg_rank < 0 ? c.G : wg_count) * NWAVES;
    const int nblk = N / 64, per = (K / 64) * nblk; const long total = (long)per * nmat;
    for (long it = gw; it < total; it += NGW) {
        const int mat = (int)(it / per), r = (int)(it % per), kb = r / nblk, nb = r % nblk;
        transpose_item_f8(src + (size_t)mat * src_ms, K, N, dst + (size_t)mat * dst_ms, map_row(map, nb * 64), kb * 64, nb * 64, (kb * 64 >= ksplit) ? mul_hi : mul, scr, c.lane);
    }
}

__device__ __forceinline__ void fill_rope(const Ctx& c, f32x2* tabR, f32x2* tabG) {
    const int gt = (c.vcu * NTHR + c.tid), NT = c.G * NTHR;
    for (int i = gt; i < SEQ * 32; i += NT) { const int t = i >> 5, p = i & 31, j = p & 15; const float inv = exp2f(-(float)(2 * j) * (13.287712379549449f / 32.f));
        const float pos = (float)(p < 16 ? (t >> 6) : (t & 63)); const float a = pos * inv; tabR[i] = (f32x2){cosf(a), sinf(a)}; }
    for (int i = gt; i < SEQ * 64; i += NT) { const int t = i >> 6, p = i & 63, j = p & 31; const float inv = exp2f(-(float)(2 * j) * (13.287712379549449f / 64.f));
        const float pos = (float)(p < 32 ? (t >> 6) : (t & 63)); const float a = pos * inv; tabG[i] = (f32x2){cosf(a), sinf(a)}; }
}
__device__ __forceinline__ void cvt_rows_bf16(const Ctx& c, const float* x, bf16_t* xb) {
    const long gt = (long)c.vcu * NTHR + c.tid, NT = (long)c.G * NTHR, n8 = (long)M * DM / 8;
    for (long i = gt; i < n8; i += NT) { const f32x4 a = *(const f32x4*)(x + i * 8), b = *(const f32x4*)(x + i * 8 + 4);
        u32x4 w; w.x = cvt_pk_bf16(a[0], a[1]); w.y = cvt_pk_bf16(a[2], a[3]); w.z = cvt_pk_bf16(b[0], b[1]); w.w = cvt_pk_bf16(b[2], b[3]); *(u32x4*)(xb + i * 8) = w; }
}

__device__ __forceinline__ void mla_prep_rows(const Ctx& c, bf16_t* H, bf16_t* Hd, bf16_t* Km, const float* qn, const float* kvn, const f32x2* tabR) {
    const int gw = c.vcu * NWAVES + c.wave, NGW = c.G * NWAVES, lane = c.lane;
    for (int r = gw; r < M; r += NGW) {
        bf16_t* h = H + (size_t)r * HW; bf16_t* hd = Hd + (size_t)r * HW;
        { u32x4 w = *(const u32x4*)(h + C_CQ + lane * 8); float f[8] = {bf_lo(w.x), bf_hi(w.x), bf_lo(w.y), bf_hi(w.y), bf_lo(w.z), bf_hi(w.z), bf_lo(w.w), bf_hi(w.w)};
          float s = 0.f;
#pragma unroll
          for (int i = 0; i < 8; ++i) s += f[i] * f[i];
          const float rs = rsqrtf(wave_sum(s) * (1.f / 512.f) + RMS_EPS);
          const f32x4 g0 = *(const f32x4*)(qn + lane * 8), g1 = *(const f32x4*)(qn + lane * 8 + 4);
          u32x4 o; o.x = cvt_pk_bf16(f[0] * rs * g0[0], f[1] * rs * g0[1]); o.y = cvt_pk_bf16(f[2] * rs * g0[2], f[3] * rs * g0[3]);
          o.z = cvt_pk_bf16(f[4] * rs * g1[0], f[5] * rs * g1[1]); o.w = cvt_pk_bf16(f[6] * rs * g1[2], f[7] * rs * g1[3]);
          *(u32x4*)(hd + C_CQ + lane * 8) = o; }
        { u32x2 w = *(const u32x2*)(h + C_CKV + lane * 4); float f[4] = {bf_lo(w.x), bf_hi(w.x), bf_lo(w.y), bf_hi(w.y)};
          const float s = f[0] * f[0] + f[1] * f[1] + f[2] * f[2] + f[3] * f[3];
          const float rs = rsqrtf(wave_sum(s) * (1.f / 256.f) + RMS_EPS);
          const f32x4 g0 = *(const f32x4*)(kvn + lane * 4);
          u32x2 o; o.x = cvt_pk_bf16(f[0] * rs * g0[0], f[1] * rs * g0[1]); o.y = cvt_pk_bf16(f[2] * rs * g0[2], f[3] * rs * g0[3]);
          *(u32x2*)(hd + C_CKV + lane * 4) = o; }
        if (lane < 32) { const unsigned w = *(const unsigned*)(h + C_KR + 2 * lane); const float x1 = bf_lo(w), x2 = bf_hi(w); const f32x2 cs = tabR[(size_t)(r & (SEQ - 1)) * 32 + lane];
          const unsigned o = cvt_pk_bf16(x1 * cs.x - x2 * cs.y, x1 * cs.y + x2 * cs.x);
#pragma unroll
          for (int hh = 0; hh < 8; ++hh) *(unsigned*)(Km + (size_t)r * 1536 + hh * 192 + 128 + 2 * lane) = o; }
    }
}

__device__ __forceinline__ float log_sigmoid(float z) { const float e = __expf(-fabsf(z)); return fminf(z, 0.f) - __logf(1.f + e); }
constexpr int GREC_QT = 0, GREC_AT = 16384, GREC_KT = 24576, GREC_DT = 40960, GREC_BYTES = 41984;
__device__ __forceinline__ void gla_prep(const Ctx& c, const bf16_t* H, const float* w2  , const float* gb  , unsigned char* rec, bf16_t* vT) {
    constexpr int TP = 66, QP = 136;
    LAS float* cum = (LAS float*)c.lds;
    LAS bf16_t* vt_l = (LAS bf16_t*)c.lds;
    LAS bf16_t* kst_l = (LAS bf16_t*)(c.lds + 32768);
    LAS bf16_t* Ql = (LAS bf16_t*)(c.lds + 49664);
    LAS bf16_t* Kl = (LAS bf16_t*)(c.lds + 67072);
    LAS float* tot = (LAS float*)(c.lds + 84480);
    LAS bf16_t* qg = (LAS bf16_t*)(c.lds + 86528);
    LAS bf16_t* kg = (LAS bf16_t*)(c.lds + 102912);
    LAS bf16_t* latl = (LAS bf16_t*)(c.lds + 119296);
    const int tid = c.tid, qtr = tid >> 7, dk = tid & 127, lane = c.lane, w = c.wave, fr = lane & 15, fq = lane >> 4;
    for (int item = c.vcu; item < BATCH * 64 * 4; item += c.G) {
        const int hh = item & 3, bc = item >> 2;
        const size_t row0 = (size_t)bc * 64;
        const int col = hh * 128 + dk;
        u32x4 qv[2], kv[2], vv[4], lv;
#pragma unroll
        for (int q2 = 0; q2 < 2; ++q2) { const int ci = tid + 512 * q2, t = ci >> 4, ch = ci & 15; const bf16_t* hp = H + (row0 + t) * HW + hh * 128 + ch * 8;
            qv[q2] = *(const u32x4*)(hp + C_GQ); kv[q2] = *(const u32x4*)(hp + C_GK); }
#pragma unroll
        for (int q4 = 0; q4 < 4; ++q4) { const int ci = tid + 512 * q4, t = ci >> 5, ch = ci & 31; vv[q4] = *(const u32x4*)(H + (row0 + t) * HW + C_GV + hh * 256 + ch * 8); }
        if (tid < 256) lv = *(const u32x4*)(H + (row0 + (tid >> 2)) * HW + C_LAT + (tid & 3) * 8);
#pragma unroll
        for (int q2 = 0; q2 < 2; ++q2) { const int ci = tid + 512 * q2; *(LAS u32x4*)(qg + ci * 8) = qv[q2]; *(LAS u32x4*)(kg + ci * 8) = kv[q2]; }
        if (tid < 256) *(LAS u32x4*)(latl + tid * 8) = lv;
        WG_BAR();
#pragma nounroll
        for (int dir = 0; dir < 2; ++dir) {
            unsigned char* rp = rec + ((((size_t)dir * 256 + bc) * 4 + hh) * GREC_BYTES);
            float wv[16];
#pragma unroll
            for (int j = 0; j < 16; ++j) wv[j] = w2[(dir * 16 + j) * 512 + col];
            const float bias = gb[dir * 512 + col];
            float run = 0.f;
#pragma unroll 4
            for (int i = 0; i < 16; ++i) { const int t = qtr * 16 + (dir ? 15 - i : i); const LAS bf16_t* lp = latl + t * 32 + dir * 16;
                const u32x4 a = *(const LAS u32x4*)lp, b = *(const LAS u32x4*)(lp + 8);
                float z = bias;
                z += bf_lo(a.x) * wv[0] + bf_hi(a.x) * wv[1] + bf_lo(a.y) * wv[2] + bf_hi(a.y) * wv[3] + bf_lo(a.z) * wv[4] + bf_hi(a.z) * wv[5] + bf_lo(a.w) * wv[6] + bf_hi(a.w) * wv[7];
                z += bf_lo(b.x) * wv[8] + bf_hi(b.x) * wv[9] + bf_lo(b.y) * wv[10] + bf_hi(b.y) * wv[11] + bf_lo(b.z) * wv[12] + bf_hi(b.z) * wv[13] + bf_lo(b.w) * wv[14] + bf_hi(b.w) * wv[15];
                run += log_sigmoid(z) * (1.f / 16.f); cum[t * 128 + dk] = run; }
            tot[dk * 4 + qtr] = run;
            WG_BAR();
            const f32x4 tq = *(const LAS f32x4*)(tot + dk * 4);
            const float blast = (tq[0] + tq[1]) + (tq[2] + tq[3]);
            float off = 0.f;
#pragma unroll
            for (int q = 0; q < 4; ++q) off += ((dir == 0) ? (q < qtr) : (q > qtr)) ? tq[q] : 0.f;
#pragma unroll 4
            for (int i = 0; i < 16; ++i) { const int t = qtr * 16 + i;
                const float bcum = cum[t * 128 + dk] + off;
                const float q = bf2f(qg[t * 128 + dk]) * 0.08838834764831845f, k = bf2f(kg[t * 128 + dk]);
                const bf16_t qb = f2bf(q * __expf(bcum));
                { const int r5 = dk & 31, chq = 4 * (dk >> 5) + ((r5 & 15) >> 2), e8 = (r5 & 3) + ((r5 >> 4) << 2);
                  *(bf16_t*)(rp + GREC_QT + t * 256 + (((chq ^ (t & 15)) << 4) | (e8 * 2))) = qb; } Ql[t * QP + dk] = qb;
                Kl[t * QP + dk] = f2bf(k * __expf(-bcum));
                kst_l[dk * TP + t] = f2bf(k * __expf(blast - bcum)); }
            if (qtr == 0) *(float*)(rp + GREC_DT + dk * 4) = __expf(blast);
            WG_BAR();
            { const int ib = w >> 1, par = w & 1;
              const LAS bf16_t* qp = Ql + (ib * 16 + fr) * QP + 8 * fq; const LAS bf16_t* kp = Kl + (2 * par * 16 + fr) * QP + 8 * fq;
              f32x4 a0 = {0.f, 0.f, 0.f, 0.f}, a1 = {0.f, 0.f, 0.f, 0.f};
#pragma unroll
              for (int kk = 0; kk < 4; ++kk) { const bf16x8 qf = *(const LAS bf16x8*)(qp + kk * 32), k0 = *(const LAS bf16x8*)(kp + kk * 32), k1 = *(const LAS bf16x8*)(kp + 16 * QP + kk * 32);
                  a0 = __builtin_amdgcn_mfma_f32_16x16x32_bf16(k0, qf, a0, 0, 0, 0); a1 = __builtin_amdgcn_mfma_f32_16x16x32_bf16(k1, qf, a1, 0, 0, 0); }
              const int i = ib * 16 + fr, j0 = 2 * par * 16 + 4 * fq;
#pragma unroll
              for (int r = 0; r < 4; ++r) { const int j = j0 + r; a0[r] = (dir ? (j >= i) : (j <= i)) ? a0[r] : 0.f; a1[r] = (dir ? (j + 16 >= i) : (j + 16 <= i)) ? a1[r] : 0.f; }
              u32x2 w0, w1; w0.x = cvt_pk_bf16(a0[0], a0[1]); w0.y = cvt_pk_bf16(a0[2], a0[3]); w1.x = cvt_pk_bf16(a1[0], a1[1]); w1.y = cvt_pk_bf16(a1[2], a1[3]);
              unsigned char* ap = rp + GREC_AT + i * 128; const int sw = (i >> 1) & 7;
              *(u32x2*)(ap + ((((j0 >> 3) ^ sw) << 4) | ((j0 & 7) * 2))) = w0; *(u32x2*)(ap + (((((j0 + 16) >> 3) ^ sw) << 4) | ((j0 & 7) * 2))) = w1; }
#pragma unroll
            for (int q2 = 0; q2 < 2; ++q2) { const int ci = tid + 512 * q2, rowid = ci >> 3, ch = ci & 7; const LAS unsigned* sp = (const LAS unsigned*)(kst_l + rowid * TP + ch * 8);
                const u32x4 wd = {sp[0], sp[1], sp[2], sp[3]};
                *(u32x4*)(rp + GREC_KT + rowid * 128 + ((ch ^ ((rowid >> 1) & 7)) << 4)) = wd; }
            WG_BAR();
        }
#pragma unroll
        for (int q4 = 0; q4 < 4; ++q4) { const int ci = tid + 512 * q4, t = ci >> 5, d0 = (ci & 31) * 8; const u32x4 x = vv[q4];
            vt_l[(d0 + 0) * TP + t] = (bf16_t)(x.x & 0xffffu); vt_l[(d0 + 1) * TP + t] = (bf16_t)(x.x >> 16); vt_l[(d0 + 2) * TP + t] = (bf16_t)(x.y & 0xffffu); vt_l[(d0 + 3) * TP + t] = (bf16_t)(x.y >> 16);
            vt_l[(d0 + 4) * TP + t] = (bf16_t)(x.z & 0xffffu); vt_l[(d0 + 5) * TP + t] = (bf16_t)(x.z >> 16); vt_l[(d0 + 6) * TP + t] = (bf16_t)(x.w & 0xffffu); vt_l[(d0 + 7) * TP + t] = (bf16_t)(x.w >> 16); }
        WG_BAR();
#pragma unroll
        for (int q4 = 0; q4 < 4; ++q4) { const int ci = tid + 512 * q4, rowid = ci >> 3, ch = ci & 7; const LAS unsigned* sp = (const LAS unsigned*)(vt_l + rowid * TP + ch * 8);
            const u32x4 wd = {sp[0], sp[1], sp[2], sp[3]};
            *(u32x4*)(vT + ((((size_t)bc * 4 + hh) * 256 + rowid) * 64 + ch * 8)) = wd; }
        WG_BAR();
    }
}

namespace pg8 {
struct EpiQKNorm {
    static constexpr bool PERM = true;
    bf16_t* O; const float* qn; const float* kn; const f32x2* tab; LAS float* P;
    __device__ __forceinline__ void operator()(const f32x4 (&acc)[2][2][4][2], const Unit& u, int wr, int wc, int fr, int fq) const {
        const int rl0 = wr * 64 + fr, row0 = u.pm * BM + rl0, colh = wc * 32 + 8 * fq;
        const bool nrm = u.pn < 10;
        float rs[2][4][2];
        if (nrm) {
#pragma unroll
            for (int ai = 0; ai < 2; ++ai)
#pragma unroll
                for (int m = 0; m < 4; ++m)
#pragma unroll
                    for (int bj = 0; bj < 2; ++bj) { const f32x4 v0 = acc[ai][bj][m][0], v1 = acc[ai][bj][m][1];
                        float ss = (v0[0] * v0[0] + v0[1] * v0[1]) + (v0[2] * v0[2] + v0[3] * v0[3]) + (v1[0] * v1[0] + v1[1] * v1[1]) + (v1[2] * v1[2] + v1[3] * v1[3]);
                        ss += __shfl_xor(ss, 16); ss += __shfl_xor(ss, 32);
                        if (fq == 0) P[((rl0 + ai * HALF + m * 16) * 2 + bj) * 4 + wc] = ss; }
            asm volatile("s_waitcnt lgkmcnt(0)\n\ts_barrier" ::: "memory");
#pragma unroll
            for (int ai = 0; ai < 2; ++ai)
#pragma unroll
                for (int m = 0; m < 4; ++m)
#pragma unroll
                    for (int bj = 0; bj < 2; ++bj) { const f32x4 p = *(const LAS f32x4*)(P + ((rl0 + ai * HALF + m * 16) * 2 + bj) * 4); rs[ai][m][bj] = rsqrtf(((p[0] + p[1]) + (p[2] + p[3])) * (1.f / 128.f) + RMS_EPS); }
        }
        const float* gp = (u.pn < 8 ? qn : kn) + colh; f32x4 g0 = {1.f, 1.f, 1.f, 1.f}, g1 = g0; if (nrm) { g0 = *(const f32x4*)gp; g1 = *(const f32x4*)(gp + 4); }
#pragma unroll
        for (int ai = 0; ai < 2; ++ai)
#pragma unroll
            for (int m = 0; m < 4; ++m) { const int row = row0 + ai * HALF + m * 16; bf16_t* rowp = O + (size_t)row * 3072 + u.pn * BM + colh;
                f32x4 t01 = {1.f, 0.f, 1.f, 0.f}, t23 = t01; if (nrm) { const f32x2* tp = tab + (size_t)(row & (SEQ - 1)) * 64 + (colh >> 1); t01 = *(const f32x4*)tp; t23 = *(const f32x4*)(tp + 2); }
#pragma unroll
                for (int bj = 0; bj < 2; ++bj) { const f32x4 v0 = acc[ai][bj][m][0], v1 = acc[ai][bj][m][1]; u32x4 o;
                    if (nrm) { const float r_ = rs[ai][m][bj];
                        const float y0 = v0[0] * r_ * g0[0], y1 = v0[1] * r_ * g0[1], y2 = v0[2] * r_ * g0[2], y3 = v0[3] * r_ * g0[3], y4 = v1[0] * r_ * g1[0], y5 = v1[1] * r_ * g1[1], y6 = v1[2] * r_ * g1[2], y7 = v1[3] * r_ * g1[3];
                        o.x = cvt_pk_bf16(y0 * t01[0] - y1 * t01[1], y0 * t01[1] + y1 * t01[0]); o.y = cvt_pk_bf16(y2 * t01[2] - y3 * t01[3], y2 * t01[3] + y3 * t01[2]);
                        o.z = cvt_pk_bf16(y4 * t23[0] - y5 * t23[1], y4 * t23[1] + y5 * t23[0]); o.w = cvt_pk_bf16(y6 * t23[2] - y7 * t23[3], y6 * t23[3] + y7 * t23[2]); }
                    else { o.x = cvt_pk_bf16(v0[0], v0[1]); o.y = cvt_pk_bf16(v0[2], v0[3]); o.z = cvt_pk_bf16(v1[0], v1[1]); o.w = cvt_pk_bf16(v1[2], v1[3]); }
                    *(u32x4*)(rowp + bj * HALF) = o; } }
    }
};
}
__device__ __forceinline__ void gla_out_rows(const Ctx& c, const float* of, const float* ob, const bf16_t* H, const float* gn, unsigned char* Ocat) {
    const int gw = c.vcu * NWAVES + c.wave, NGW = c.G * NWAVES, lane = c.lane;
    for (int r = gw; r < M; r += NGW) {
#pragma unroll
        for (int hh = 0; hh < 4; ++hh) { const int j0 = hh * 256 + lane * 4;
            const f32x4 a = *(const f32x4*)(of + (size_t)r * 1024 + j0), b = *(const f32x4*)(ob + (size_t)r * 1024 + j0); const f32x4 s = a + b;
            const float ss = s[0] * s[0] + s[1] * s[1] + s[2] * s[2] + s[3] * s[3];
            const float rs = rsqrtf(wave_sum(ss) * (1.f / 256.f) + RMS_EPS);
            const f32x4 g = *(const f32x4*)(gn + j0); const u32x2 gw2 = *(const u32x2*)(H + (size_t)r * HW + C_GR + j0);
            const float gr[4] = {bf_lo(gw2.x), bf_hi(gw2.x), bf_lo(gw2.y), bf_hi(gw2.y)}; float o[4];
#pragma unroll
            for (int i = 0; i < 4; ++i) { const float sg = gr[i] * __builtin_amdgcn_rcpf(1.f + __expf(-gr[i])); o[i] = s[i] * rs * g[i] * sg; }
            int w = __builtin_amdgcn_cvt_pk_fp8_f32(o[0] * 4.f, o[1] * 4.f, 0, false); w = __builtin_amdgcn_cvt_pk_fp8_f32(o[2] * 4.f, o[3] * 4.f, w, true);
            *(unsigned*)(Ocat + (size_t)r * 2048 + 1024 + j0) = (unsigned)w; }
    }
}

__device__ __forceinline__ void gqa_qknorm_rows(const Ctx& c, bf16_t* H, bf16_t* Hd, const float* qn, const float* kn, const f32x2* tabG) {
    const int gw = c.vcu * NWAVES + c.wave, NGW = c.G * NWAVES, lane = c.lane, l16 = lane & 15, hg = lane >> 4;
    const f32x4 q0 = *(const f32x4*)(qn + l16 * 8), q1 = *(const f32x4*)(qn + l16 * 8 + 4), k0 = *(const f32x4*)(kn + l16 * 8), k1 = *(const f32x4*)(kn + l16 * 8 + 4);
    for (int r = gw; r < M; r += NGW) {
        const bf16_t* h = H + (size_t)r * 3072; bf16_t* hd = Hd + (size_t)r * 3072;
        const f32x2* tp = tabG + (size_t)(r & (SEQ - 1)) * 64 + l16 * 4; const f32x4 t01 = *(const f32x4*)tp, t23 = *(const f32x4*)(tp + 2);
        u32x4 wv[5];
#pragma unroll
        for (int p = 0; p < 5; ++p) wv[p] = *(const u32x4*)(h + (p * 4 + hg) * 128 + l16 * 8);
#pragma unroll
        for (int p = 0; p < 5; ++p) { const u32x4 w = wv[p];
            float f[8] = {bf_lo(w.x), bf_hi(w.x), bf_lo(w.y), bf_hi(w.y), bf_lo(w.z), bf_hi(w.z), bf_lo(w.w), bf_hi(w.w)};
            float ss = 0.f;
#pragma unroll
            for (int i = 0; i < 8; ++i) ss += f[i] * f[i];
            ss = row16_sum(ss);
            const float rs = rsqrtf(ss * (1.f / 128.f) + RMS_EPS);
            const bool isq = (p < 4);
            const f32x4 g0 = isq ? q0 : k0, g1 = isq ? q1 : k1;
            const float y0 = f[0] * rs * g0[0], y1 = f[1] * rs * g0[1], y2 = f[2] * rs * g0[2], y3 = f[3] * rs * g0[3], y4 = f[4] * rs * g1[0], y5 = f[5] * rs * g1[1], y6 = f[6] * rs * g1[2], y7 = f[7] * rs * g1[3];
            u32x4 o; o.x = cvt_pk_bf16(y0 * t01[0] - y1 * t01[1], y0 * t01[1] + y1 * t01[0]); o.y = cvt_pk_bf16(y2 * t01[2] - y3 * t01[3], y2 * t01[3] + y3 * t01[2]);
            o.z = cvt_pk_bf16(y4 * t23[0] - y5 * t23[1], y4 * t23[1] + y5 * t23[0]); o.w = cvt_pk_bf16(y6 * t23[2] - y7 * t23[3], y6 * t23[3] + y7 * t23[2]);
            *(u32x4*)(hd + (p * 4 + hg) * 128 + l16 * 8) = o; }
    }
}

__device__ __forceinline__ void ln_router_rows(const Ctx& c, const bf16_t* Xres, const bf16_t* Mb, bf16_t* X1b, unsigned char* X1f8, const float* g, const float* bb, const float* wr  , float* aff) {
    LAS float* Wl = (LAS float*)c.lds;
#pragma unroll
    for (int it = 0; it < 16; ++it) { const int i = c.tid + it * NTHR; const f32x4 w = *(const f32x4*)(wr + (size_t)i * 4); const int k = i >> 2, e0 = (i & 3) * 4;
        Wl[(e0 + 0) * 2048 + k] = w[0]; Wl[(e0 + 1) * 2048 + k] = w[1]; Wl[(e0 + 2) * 2048 + k] = w[2]; Wl[(e0 + 3) * 2048 + k] = w[3]; }
    WG_BAR();
    const int gw = c.vcu * NWAVES + c.wave, NGW = c.G * NWAVES, lane = c.lane;
    u32x2 xr[2][8];
#define M1_LOAD(r0_) do { const int a0_ = (r0_), a1_ = ((r0_) + NGW < M) ? (r0_) + NGW : (r0_); \
    _Pragma("unroll") for (int j = 0; j < 8; ++j) { xr[0][j] = *(const u32x2*)(Xres + (size_t)a0_ * DM + j * 256 + lane * 4); xr[1][j] = *(const u32x2*)(Xres + (size_t)a1_ * DM + j * 256 + lane * 4); } } while (0)
    if (gw < M) M1_LOAD(gw);
    for (int rr = gw; rr < M; rr += 2 * NGW) {
        const int rw[2] = {rr, (rr + NGW < M) ? rr + NGW : rr};
        f32x4 v[2][8];
#pragma unroll
        for (int q = 0; q < 2; ++q)
#pragma unroll
            for (int j = 0; j < 8; ++j) { const u32x2 mw = *(const u32x2*)(Mb + (size_t)rw[q] * DM + j * 256 + lane * 4);
                v[q][j] = (f32x4){bf_lo(xr[q][j].x), bf_hi(xr[q][j].x), bf_lo(xr[q][j].y), bf_hi(xr[q][j].y)} * DN_ALPHA + (f32x4){bf_lo(mw.x), bf_hi(mw.x), bf_lo(mw.y), bf_hi(mw.y)}; }
        __builtin_amdgcn_sched_barrier(0);
        if (rr + 2 * NGW < M) M1_LOAD(rr + 2 * NGW);
        __builtin_amdgcn_sched_barrier(0);
#pragma unroll
        for (int q = 0; q < 2; ++q) { float s = 0.f;
#pragma unroll
            for (int j = 0; j < 8; ++j) s += (v[q][j][0] + v[q][j][1]) + (v[q][j][2] + v[q][j][3]);
            const float mean = wave_sum(s) * (1.f / DM); float s2 = 0.f;
#pragma unroll
            for (int j = 0; j < 8; ++j) { v[q][j] = v[q][j] - mean; s2 += (v[q][j][0] * v[q][j][0] + v[q][j][1] * v[q][j][1]) + (v[q][j][2] * v[q][j][2] + v[q][j][3] * v[q][j][3]); }
            const float rstd = rsqrtf(wave_sum(s2) * (1.f / DM) + LN_EPS);
#pragma unroll
            for (int j = 0; j < 8; ++j) { const f32x4 gg = *(const f32x4*)(g + j * 256 + lane * 4), b4 = *(const f32x4*)(bb + j * 256 + lane * 4);
                v[q][j] = v[q][j] * rstd * gg + b4;
                if (q == 0 || rw[1] != rw[0]) { u32x2 w; w.x = cvt_pk_bf16(v[q][j][0], v[q][j][1]); w.y = cvt_pk_bf16(v[q][j][2], v[q][j][3]); *(u32x2*)(X1b + (size_t)rw[q] * DM + j * 256 + lane * 4) = w;
                    int w8 = __builtin_amdgcn_cvt_pk_fp8_f32(v[q][j][0], v[q][j][1], 0, false); w8 = __builtin_amdgcn_cvt_pk_fp8_f32(v[q][j][2], v[q][j][3], w8, true); *(int*)(X1f8 + (size_t)rw[q] * DM + j * 256 + lane * 4) = w8; } } }
        float lg[2][16];
#pragma unroll
        for (int e = 0; e < 16; ++e) { f32x2 p0 = {0.f, 0.f}, p1 = {0.f, 0.f};
#pragma unroll
            for (int j = 0; j < 8; ++j) { const f32x4 w = *(const LAS f32x4*)(Wl + e * 2048 + j * 256 + lane * 4); const f32x2 wl = {w[0], w[1]}, wh = {w[2], w[3]};
                p0 = (f32x2){v[0][j][0], v[0][j][1]} * wl + p0; p0 = (f32x2){v[0][j][2], v[0][j][3]} * wh + p0; p1 = (f32x2){v[1][j][0], v[1][j][1]} * wl + p1; p1 = (f32x2){v[1][j][2], v[1][j][3]} * wh + p1; }
            lg[0][e] = wave_sum(p0.x + p0.y); lg[1][e] = wave_sum(p1.x + p1.y); }
#pragma unroll
        for (int q = 0; q < 2; ++q) { float mx = lg[q][0];
#pragma unroll
            for (int e = 1; e < 16; ++e) mx = fmaxf(mx, lg[q][e]);
            float den = 0.f;
#pragma unroll
            for (int e = 0; e < 16; ++e) { lg[q][e] = __expf(lg[q][e] - mx); den += lg[q][e]; }
            const float inv = 1.f / den; float mine = 0.f;
#pragma unroll
            for (int e = 0; e < 16; ++e) mine = (lane == e) ? lg[q][e] * inv : mine;
            if (lane < 16 && (q == 0 || rw[1] != rw[0])) aff[((size_t)(rw[q] >> 12) * 16 + lane) * SEQ + (rw[q] & (SEQ - 1))] = mine; }
    }
#undef M1_LOAD
    WG_BAR();
}

__device__ __forceinline__ void topk_units(const Ctx& c, const float* aff, int* idx, float* gate, unsigned short* slotmap) {
    LAS unsigned* sm = (LAS unsigned*)c.lds;
    const int tid = c.tid, lane = c.lane, wid = c.wave;
    for (int be = c.vcu; be < BATCH * NEXP; be += c.G) {
        const int b = be >> 4, e = be & 15;
        const float* a = aff + (size_t)be * SEQ + tid * 8;
        const u32x4 k0 = *(const u32x4*)a, k1 = *(const u32x4*)(a + 4);
        const unsigned key[8] = {k0.x, k0.y, k0.z, k0.w, k1.x, k1.y, k1.z, k1.w};
        unsigned prefix = 0u; int par = 0;
        for (int bit = 30; bit >= 0; --bit) {
            const unsigned cand = prefix | (1u << bit); int cnt = 0;
#pragma unroll
            for (int i = 0; i < 8; ++i) cnt += (key[i] >= cand) ? 1 : 0;
            cnt = wave_sum_i(cnt);
            if (lane == 0) sm[par * 8 + wid] = (unsigned)cnt;
            WG_BAR();
            unsigned total = 0u;
#pragma unroll
            for (int w = 0; w < 8; ++w) total += sm[par * 8 + w];
            if (total >= (unsigned)CAP) prefix = cand;
            par ^= 1;
        }
        const unsigned T = prefix;
        int cgt = 0, ceq = 0;
#pragma unroll
        for (int i = 0; i < 8; ++i) { cgt += (key[i] > T) ? 1 : 0; ceq += (key[i] == T) ? 1 : 0; }
        unsigned pk = (unsigned)cgt | ((unsigned)ceq << 16), inc = pk;
#pragma unroll
        for (int o = 1; o < 64; o <<= 1) { const unsigned nb = __shfl_up(inc, o); if (lane >= o) inc += nb; }
        if (lane == 63) sm[32 + wid] = inc;
        WG_BAR();
        unsigned wpre = 0u, gtot = 0u;
#pragma unroll
        for (int w = 0; w < 8; ++w) { const unsigned v = sm[32 + w]; if (w < wid) wpre += v; gtot += v; }
        const unsigned ex = wpre + inc - pk;
        int pre_gt = (int)(ex & 0xffffu), pre_eq = (int)(ex >> 16);
        const int need_eq = CAP - (int)(gtot & 0xffffu);
        const size_t obase = ((size_t)e * BATCH + b) * CAP;
#pragma unroll
        for (int i = 0; i < 8; ++i) { const int t = tid * 8 + i; const bool gt = key[i] > T, eq = key[i] == T; const bool sel = gt || (eq && pre_eq < need_eq);
            const int slot = pre_gt + (pre_eq < need_eq ? pre_eq : need_eq);
            if (sel) { idx[obase + slot] = b * SEQ + t; gate[obase + slot] = __uint_as_float(key[i]); }
            slotmap[((size_t)b * SEQ + t) * 16 + e] = sel ? (unsigned short)slot : (unsigned short)0xFFFF;
            pre_gt += gt ? 1 : 0; pre_eq += eq ? 1 : 0; }
        WG_BAR();
    }
}

__device__ __forceinline__ void combine_ln_rows(const Ctx& c, const bf16_t* X1b, const bf16_t* Y, const unsigned short* slotmap, const float* g, const float* bb, float* outf, bf16_t* Xb) {
    const int gw = c.vcu * NWAVES + c.wave, NGW = c.G * NWAVES, lane = c.lane;
    for (int rr = gw; rr < M; rr += 2 * NGW) {
        const int rw[2] = {rr, (rr + NGW < M) ? rr + NGW : rr};
        f32x4 v[2][8]; int slotv[2]; unsigned msk[2];
#pragma unroll
        for (int q = 0; q < 2; ++q) { slotv[q] = (lane < 16) ? (int)slotmap[(size_t)rw[q] * 16 + lane] : 0xFFFF;
#pragma unroll
            for (int j = 0; j < 8; ++j) { const u32x2 xw = *(const u32x2*)(X1b + (size_t)rw[q] * DM + j * 256 + lane * 4); v[q][j] = (f32x4){bf_lo(xw.x), bf_hi(xw.x), bf_lo(xw.y), bf_hi(xw.y)} * DN_ALPHA; } }
#pragma unroll
        for (int q = 0; q < 2; ++q) msk[q] = (unsigned)__builtin_amdgcn_readfirstlane((int)(unsigned)(__ballot(slotv[q] != 0xFFFF) & 0xFFFFull));
        while (msk[0] | msk[1]) {
            u32x2 t[4][8]; bool ok[4];
#pragma unroll
            for (int k = 0; k < 4; ++k) { const int q = k >> 1; ok[k] = msk[q] != 0u;
                if (ok[k]) { const int e = __builtin_ctz(msk[q]); msk[q] &= msk[q] - 1u; const unsigned sl = (unsigned)__builtin_amdgcn_readlane(slotv[q], e);
                    const bf16_t* yr = Y + (((size_t)e * BATCH + (rw[q] >> 12)) * CAP + sl) * DM + lane * 4;
#pragma unroll
                    for (int j = 0; j < 8; ++j) t[k][j] = *(const u32x2*)(yr + j * 256); } }
#pragma unroll
            for (int k = 0; k < 4; ++k) { const int q = k >> 1;
                if (ok[k]) {
#pragma unroll
                    for (int j = 0; j < 8; ++j) { v[q][j][0] += bf_lo(t[k][j].x); v[q][j][1] += bf_hi(t[k][j].x); v[q][j][2] += bf_lo(t[k][j].y); v[q][j][3] += bf_hi(t[k][j].y); } } }
        }
#pragma unroll
        for (int q = 0; q < 2; ++q) { float s = 0.f;
#pragma unroll
            for (int j = 0; j < 8; ++j) s += (v[q][j][0] + v[q][j][1]) + (v[q][j][2] + v[q][j][3]);
            const float mean = wave_sum(s) * (1.f / DM); float s2 = 0.f;
#pragma unroll
            for (int j = 0; j < 8; ++j) { v[q][j] = v[q][j] - mean; s2 += (v[q][j][0] * v[q][j][0] + v[q][j][1] * v[q][j][1]) + (v[q][j][2] * v[q][j][2] + v[q][j][3] * v[q][j][3]); }
            const float rstd = rsqrtf(wave_sum(s2) * (1.f / DM) + LN_EPS);
            if (q == 0 || rw[1] != rw[0]) {
#pragma unroll
                for (int j = 0; j < 8; ++j) { const f32x4 gg = *(const f32x4*)(g + j * 256 + lane * 4), b4 = *(const f32x4*)(bb + j * 256 + lane * 4);
                    const f32x4 o = v[q][j] * rstd * gg + b4; if (outf) { *(f32x4*)(outf + (size_t)rw[q] * DM + j * 256 + lane * 4) = o; continue; }
                    u32x2 w; w.x = cvt_pk_bf16(o[0], o[1]); w.y = cvt_pk_bf16(o[2], o[3]); *(u32x2*)(Xb + (size_t)rw[q] * DM + j * 256 + lane * 4) = w; } } }
    }
}
namespace gla {
constexpr int QT = 0, AT = 16384, KT = 24576, DT = 40960, SLOT = 41984, NSLOT = 3;
__device__ __forceinline__ void unit(const Ctx& c, int u, const unsigned char* rec, const bf16_t* vT, float* of, float* ob) {
    const int half = u & 1, dir = (u >> 1) & 1, hh = (u >> 2) & 3, b = u >> 4;
    int tid_ = c.tid; asm volatile("" : "+v"(tid_));
    const int w = __builtin_amdgcn_readfirstlane(tid_ >> 6), lane = tid_ & 63, fr = lane & 15, fq = lane >> 4;
    LAS unsigned char* L = c.lds;
    float* outp = (dir ? ob : of) + hh * 256 + half * 128 + w * 16 + 4 * fq;
    const int qrd = QT + fr * 256;
    const int swz7 = (fr >> 1) & 7;
    const int ard = AT + fr * 128;
    const int krd = KT + fr * 128;
    const int drd = DT + fq * 16;
    f32x4 S0 = {0.f, 0.f, 0.f, 0.f}, S1 = S0, S2 = S0, S3 = S0, S4 = S0, S5 = S0, S6 = S0, S7 = S0;
#ifndef GLA_TP
#define GLA_TP 0
#endif
    unsigned long long tw_ = 0ull, ta_ = 0ull;
#define GLA_T0(id) do { if (GLA_TP == (id)) ta_ = __builtin_amdgcn_s_memrealtime(); } while (0)
#define GLA_T1(id) do { if (GLA_TP == (id)) tw_ += __builtin_amdgcn_s_memrealtime() - ta_; } while (0)
    bf16x8 va0, va1, vb0, vb1, vc0, vc1;
#define GLA_CH(n) (b * 64 + (dir ? 63 - ((n) < 64 ? (n) : 63) : ((n) < 64 ? (n) : 63)))
#define GLA_VLOAD(V0, V1, n) do { const bf16_t* vp_ = vT + (((size_t)GLA_CH(n) * 4 + hh) * 256 + half * 128 + w * 16 + fr) * 64 + 8 * fq; \
    asm volatile("global_load_dwordx4 %0, %1, off" : "=&v"(V0) : "v"(vp_) : "memory"); asm volatile("global_load_dwordx4 %0, %1, off offset:64" : "=&v"(V1) : "v"(vp_) : "memory"); } while (0)
#define GLA_G(gp, off) __builtin_amdgcn_global_load_lds((const unsigned*)(gp), (LAS unsigned*)(L + (off)), 16, 0, 0)
#define GLA_DMA(n, SL) do { const unsigned char* rp_ = rec + ((((size_t)dir * 256 + GLA_CH(n)) * 4 + hh) * SLOT) + lane * 16;     \
    GLA_G(rp_ + (w) * 1024, (SL) * SLOT + (w) * 1024); GLA_G(rp_ + (w + 8) * 1024, (SL) * SLOT + (w + 8) * 1024); GLA_G(rp_ + (w + 16) * 1024, (SL) * SLOT + (w + 16) * 1024); \
    GLA_G(rp_ + (w + 24) * 1024, (SL) * SLOT + (w + 24) * 1024); GLA_G(rp_ + (w + 32) * 1024, (SL) * SLOT + (w + 32) * 1024); \
    GLA_G(rp_ + 40 * 1024, (w == 0) ? (SL) * SLOT + 40 * 1024 : NSLOT * SLOT); } while (0)
#define GLA_PK(a, bq) __builtin_bit_cast(bf16x8, (u32x4){cvt_pk_bf16(a[0], a[1]), cvt_pk_bf16(a[2], a[3]), cvt_pk_bf16(bq[0], bq[1]), cvt_pk_bf16(bq[2], bq[3])})
#define GLA_SCHED __builtin_amdgcn_sched_barrier(0)
#define GLA_MF __builtin_amdgcn_mfma_f32_16x16x32_bf16
#define GLA_RDQ(f, sb, ib) do { const LAS unsigned char* q_ = (sb) + qrd + (ib) * 4096; const LAS unsigned char* a_ = (sb) + ard + (ib) * 2048; \
    f[0] = *(const LAS bf16x8*)(q_ + (((0 + fq) ^ fr) << 4)); f[1] = *(const LAS bf16x8*)(q_ + (((4 + fq) ^ fr) << 4)); f[2] = *(const LAS bf16x8*)(q_ + (((8 + fq) ^ fr) << 4)); f[3] = *(const LAS bf16x8*)(q_ + (((12 + fq) ^ fr) << 4)); \
    f[4] = *(const LAS bf16x8*)(a_ + (((0 + fq) ^ swz7) << 4)); f[5] = *(const LAS bf16x8*)(a_ + (((4 + fq) ^ swz7) << 4)); } while (0)
#define GLA_RDK(f, sb, p) do { const LAS unsigned char* k_ = (sb) + krd + (p) * 4096; const LAS unsigned char* d_ = (sb) + drd + (p) * 128; \
    f[0] = *(const LAS bf16x8*)(k_ + (((0 + fq) ^ swz7) << 4)); f[1] = *(const LAS bf16x8*)(k_ + (((4 + fq) ^ swz7) << 4)); f[2] = *(const LAS bf16x8*)(k_ + 2048 + (((0 + fq) ^ swz7) << 4)); f[3] = *(const LAS bf16x8*)(k_ + 2048 + (((4 + fq) ^ swz7) << 4)); \
    f[4] = *(const LAS bf16x8*)(d_); f[5] = *(const LAS bf16x8*)(d_ + 64); } while (0)
#define GLA_MMAO(f, ib, VC0, VC1) do { f32x4 o1_ = {0.f, 0.f, 0.f, 0.f}, o2_ = {0.f, 0.f, 0.f, 0.f}; \
    o1_ = GLA_MF(sf0, f[0], o1_, 0, 0, 0); o2_ = GLA_MF(sf2, f[2], o2_, 0, 0, 0); o1_ = GLA_MF(sf1, f[1], o1_, 0, 0, 0); o2_ = GLA_MF(sf3, f[3], o2_, 0, 0, 0); \
    o1_ = GLA_MF(VC0, f[4], o1_, 0, 0, 0); o2_ = GLA_MF(VC1, f[5], o2_, 0, 0, 0); *(f32x4*)(outp + ro_ + (size_t)(ib) * 16 * 1024) = o1_ + o2_; } while (0)
#define GLA_MMAS(f, Sa, Sb, VC0, VC1) do { Sa = Sa * __builtin_bit_cast(f32x4, f[4]); Sb = Sb * __builtin_bit_cast(f32x4, f[5]); \
    Sa = GLA_MF(f[0], VC0, Sa, 0, 0, 0); Sb = GLA_MF(f[2], VC0, Sb, 0, 0, 0); Sa = GLA_MF(f[1], VC1, Sa, 0, 0, 0); Sb = GLA_MF(f[3], VC1, Sb, 0, 0, 0); } while (0)
#define GLA_STEP(n, SC, SL, VC0, VC1, VL0, VL1) do { \
    GLA_T0(2); GLA_VLOAD(VL0, VL1, (n) + 2); GLA_DMA((n) + 2, SL); GLA_T1(2); GLA_T0(3); \
    const LAS unsigned char* sb_ = L + (SC) * SLOT; \
    const bf16x8 sf0 = GLA_PK(S0, S1), sf1 = GLA_PK(S2, S3), sf2 = GLA_PK(S4, S5), sf3 = GLA_PK(S6, S7); \
    const size_t ro_ = ((size_t)GLA_CH(n) * 64 + fr) * 1024; \
    bf16x8 fa_[6], fb_[6]; \
    GLA_RDQ(fa_, sb_, 0); GLA_SCHED; \
    GLA_RDQ(fb_, sb_, 1); GLA_SCHED; GLA_MMAO(fa_, 0, VC0, VC1); GLA_SCHED; \
    GLA_RDQ(fa_, sb_, 2); GLA_SCHED; GLA_MMAO(fb_, 1, VC0, VC1); GLA_SCHED; \
    GLA_RDQ(fb_, sb_, 3); GLA_SCHED; GLA_MMAO(fa_, 2, VC0, VC1); GLA_SCHED; \
    GLA_RDK(fa_, sb_, 0); GLA_SCHED; GLA_MMAO(fb_, 3, VC0, VC1); GLA_SCHED; \
    GLA_RDK(fb_, sb_, 1); GLA_SCHED; GLA_MMAS(fa_, S0, S1, VC0, VC1); GLA_SCHED; \
    GLA_RDK(fa_, sb_, 2); GLA_SCHED; GLA_MMAS(fb_, S2, S3, VC0, VC1); GLA_SCHED; \
    GLA_RDK(fb_, sb_, 3); GLA_SCHED; GLA_MMAS(fa_, S4, S5, VC0, VC1); GLA_SCHED; \
    GLA_MMAS(fb_, S6, S7, VC0, VC1); \
    GLA_T1(3); GLA_T0(1); asm volatile("s_waitcnt vmcnt(16) lgkmcnt(0)" ::: "memory"); GLA_T1(1); GLA_T0(4); asm volatile("s_barrier" ::: "memory"); GLA_T1(4); } while (0)
    GLA_VLOAD(va0, va1, 0); GLA_DMA(0, 0); GLA_VLOAD(vb0, vb1, 1); GLA_DMA(1, 1);
    asm volatile("s_waitcnt vmcnt(8) lgkmcnt(0)\n\ts_barrier" ::: "memory");
#pragma nounroll
    for (int n = 0; n < 63; n += 3) {
        GLA_STEP(n, 0, 2, va0, va1, vc0, vc1);
        GLA_STEP(n + 1, 1, 0, vb0, vb1, va0, va1);
        GLA_STEP(n + 2, 2, 1, vc0, vc1, vb0, vb1);
    }
    GLA_STEP(63, 0, 2, va0, va1, vc0, vc1);
    asm volatile("s_waitcnt vmcnt(0) lgkmcnt(0)\n\ts_barrier" ::: "memory");
    asm volatile("" :: "v"(va0), "v"(va1), "v"(vb0), "v"(vb1), "v"(vc0), "v"(vc1));
    if (GLA_TP != 0 && tid_ == 0 && u == 0) *(volatile LAS unsigned long long*)(L + MISC_OFF + 64) = tw_;
#undef GLA_CH
#undef GLA_VLOAD
#undef GLA_G
#undef GLA_DMA
#undef GLA_PK
#undef GLA_SCHED
#undef GLA_MF
#undef GLA_RDQ
#undef GLA_RDK
#undef GLA_MMAO
#undef GLA_MMAS
#undef GLA_STEP
}
}
#ifndef MK_SPLIT
#define MK_SPLIT 0
#endif
constexpr int NPH_LAYER = 11, NPHASE = 1 + DEPTH * NPH_LAYER;
struct Args { const float* in[22]; float* out; unsigned char* ws; int ph_lo, ph_hi, li, pad; };

__global__ void __launch_bounds__(NTHR, 2) hybrid_fwd(Args args) {
    extern __shared__ __attribute__((aligned(16))) unsigned char lds_raw[];
    Ctx c; c.lds = (LAS unsigned char*)lds_raw; c.tid = threadIdx.x; c.lane = c.tid & 63; c.wave = __builtin_amdgcn_readfirstlane(c.tid >> 6);
    c.G = gridDim.x; { const int bx = blockIdx.x; c.vcu = (c.G % 8 == 0) ? (bx % 8) * (c.G / 8) + bx / 8 : bx; }
    typedef const Args __attribute__((address_space(4))) CArgs;
    CArgs* const ap0 = (CArgs*)__builtin_amdgcn_kernarg_segment_ptr();
    unsigned char* ws = ap0->ws;
    gu32* ctl = (gu32*)(ws + WS_CTL);
    volatile LAS unsigned* MISC = (volatile LAS unsigned*)(c.lds + MISC_OFF);
    for (int u = c.tid; u < (LDS_BYTES - RING_BYTES) / 4; u += NTHR) ((LAS unsigned*)(c.lds + RING_BYTES))[u] = 0u;
    __syncthreads();
    const int lo = ap0->ph_lo, hi = ap0->ph_hi;
    XcdBarrier bar; bar.bar = (unsigned*)(ctl + CW_BAR) + ap0->li * XCD_BAR_WORDS; bar.x = 0; bar.st = nullptr;
    if (hi - lo > 1) bar = xcd_barrier_post((unsigned*)(ctl + CW_BAR) + ap0->li * XCD_BAR_WORDS, MISC + 8);
#ifndef PHASE_MASK
#define PHASE_MASK 0xFFF
#endif
#define PHM(j) (((PHASE_MASK) >> (j)) & 1)
#ifndef DUP_PHASE
#define DUP_PHASE (-1)
#endif
#ifndef DUP_SUB
#define DUP_SUB 3
#endif
#ifndef DUP_PAR
#define DUP_PAR 2
#endif
#define NREP(k) ((DUP_PHASE == (k) && (DUP_PAR == 2 || DUP_PAR == (layer & 1))) ? 2 : 1)
#define IN(k) (lo <= (k) && (k) < hi)
#ifndef TPROBE
#define TPROBE 0
#endif
#ifndef TPROBE_SEAM
#define TPROBE_SEAM (-1)
#endif
#ifndef TPROBE_LAYER
#define TPROBE_LAYER 0
#endif
#ifndef TPROBE_BLOCK
#define TPROBE_BLOCK 0
#endif
    unsigned long long tpr_acc = 0ull, tpr_t0 = 0ull, tph0 = 0ull;
#define SEAM(k) do { if (TPROBE == 6 && (k) > 0 && ((k) - 1) % NPH_LAYER == TPROBE_SEAM && ((k) - 1) / NPH_LAYER == TPROBE_LAYER) tpr_acc += __builtin_amdgcn_s_memrealtime() - tph0; if (hi > (k) + 1) { const bool tp_ = (TPROBE == 5) && (TPROBE_SEAM < 0 || ((k) > 0 && ((k) - 1) % NPH_LAYER == TPROBE_SEAM) || ((k) == 0 && TPROBE_SEAM == 11)); \
    if (tp_) tpr_t0 = __builtin_amdgcn_s_memrealtime(); xcd_barrier(bar); if (tp_) tpr_acc += __builtin_amdgcn_s_memrealtime() - tpr_t0; } } while (0)

#define tabR ((f32x2*)(wsb + WS_ROPER))
#define tabG ((f32x2*)(wsb + WS_ROPEG))
#define aff ((float*)(wsb + WS_AFF))
#define idx ((int*)(wsb + WS_IDX))
#define gate ((float*)(wsb + WS_GATE))
#define slotmap ((unsigned short*)(wsb + WS_SLOT))
#define Win_t ((bf16_t*)(wsb + WS_WIN))
#define Wuq_t ((bf16_t*)(wsb + WS_WUQ))
#define Wukv_t ((bf16_t*)(wsb + WS_WUKV))
#define Wmo_t ((bf16_t*)(wsb + WS_WMO))
#define Wqkv_t ((bf16_t*)(wsb + WS_WQKV))
#define Wgo_t ((bf16_t*)(wsb + WS_WGO))
#define W13_t ((bf16_t*)(wsb + WS_W13))
#define W2_t ((bf16_t*)(wsb + WS_W2))
#define Xb ((bf16_t*)(wsb + WS_XB))
#define X1b ((bf16_t*)(wsb + WS_X1B))
#define X1f8 ((unsigned char*)(wsb + WS_X1))
#define W13f8 ((unsigned char*)(wsb + WS_W13))
#define W2f8 ((unsigned char*)(wsb + WS_W2))
#define hdn8 ((unsigned char*)(wsb + WS_HDN))
#define iota ((int*)(wsb + WS_IDX + 262144))
#define Ocat8 ((unsigned char*)(wsb + WS_OCAT))
#define Wmo8 ((unsigned char*)(wsb + WS_WMO))
#define Wgo8 ((unsigned char*)(wsb + WS_WGO))
#define H ((bf16_t*)(wsb + WS_H))
#define Qm ((bf16_t*)(wsb + WS_QM))
#define Km ((bf16_t*)(wsb + WS_KM))
#define Vm ((bf16_t*)(wsb + WS_VM))
#define Ocat ((bf16_t*)(wsb + WS_OCAT))
#define qin ((bf16_t*)(wsb + WS_QIN))
#define vT ((bf16_t*)(wsb + WS_VT))
#define of ((float*)(wsb + WS_OF))
#define ob ((float*)(wsb + WS_OB))
#define hdn ((bf16_t*)(wsb + WS_HDN))
#define Yb ((bf16_t*)(wsb + WS_Y))
#define Mb ((bf16_t*)(wsb + WS_OF))
#define X2 (apx->out)
#define WSB_OPAQUE() CArgs* apx = ap0; asm volatile("" : "+s"(apx)); unsigned char* wsb = apx->ws

    if (PHM(11) && IN(0)) for (int rep_ = 0; rep_ < ((DUP_PHASE == 11) ? 2 : 1); ++rep_) { WSB_OPAQUE();
        fill_rope(c, tabR, tabG);
        cvt_rows_bf16(c, apx->in[0], Xb);
        const int nl = (c.G == 256) ? 2 : DEPTH;
        transpose_batch_f8(c, apx->in[15], W13f8, DM, FF, nl * NEXP, (size_t)DM * FF, (size_t)2 * FF * DM, 2, 64.f);
        transpose_batch_f8(c, apx->in[16], W13f8, DM, FF, nl * NEXP, (size_t)DM * FF, (size_t)2 * FF * DM, 3, 512.f);
        transpose_batch_f8(c, apx->in[17], W2f8, FF, DM, (c.G == 256 ? 1 : nl) * NEXP, (size_t)FF * DM, (size_t)DM * FF, 0, 128.f);
        transpose_batch(c, apx->in[1], Win_t, DM, 3936, 2, (size_t)DM * 3936, (size_t)4096 * DM, 1);
        transpose_batch(c, apx->in[10], Wqkv_t, DM, 3072, 2, (size_t)DM * 3072, (size_t)3072 * DM, 0);
        transpose_batch_f8(c, apx->in[9], Wmo8, DM, DM, 2, (size_t)DM * DM, (size_t)DM * DM, 0, 128.f, -1, 0, 1024, 1024.f);
        transpose_batch_f8(c, apx->in[13], Wgo8, DM, DM, 2, (size_t)DM * DM, (size_t)DM * DM, 0, 128.f);
        transpose_batch(c, apx->in[3], Wuq_t, 512, 1536, 2, (size_t)512 * 1536, (size_t)1536 * 512, 0);
        transpose_batch(c, apx->in[5], Wukv_t, 256, 2048, 2, (size_t)256 * 2048, (size_t)2048 * 256, 0);
        { const long gt = (long)c.vcu * NTHR + c.tid, NT = (long)c.G * NTHR;
          for (long i = gt; i < 2L * 160 * DM / 8; i += NT) { const long l2 = i / (160 * DM / 8), rr = i % (160 * DM / 8); *(u32x4*)(Win_t + (size_t)l2 * 4096 * DM + (size_t)3936 * DM + rr * 8) = (u32x4){0u, 0u, 0u, 0u}; } }
        for (int i = c.vcu * NTHR + c.tid; i < BATCH * NEXP * CAP; i += c.G * NTHR) iota[i] = i;
        SEAM(0);
    }

    const Ctx c0 = c;
#ifndef TPROBE_BLOCK
#define TPROBE_BLOCK 0
#endif
#ifndef TPROBE_LAYER
#define TPROBE_LAYER 0
#endif
#define TP_BEGIN(id) do { if (TPROBE == (id) && layer == TPROBE_LAYER) tpr_t0 = __builtin_amdgcn_s_memrealtime(); } while (0)
#define TP_END(id) do { if (TPROBE == (id) && layer == TPROBE_LAYER) tpr_acc += __builtin_amdgcn_s_memrealtime() - tpr_t0; } while (0)
    for (int layer = 0; layer < DEPTH; ++layer) {
        const int pb = 1 + layer * NPH_LAYER, i2 = layer >> 1; const bool even = (layer & 1) == 0;
        if (PHM(0) && IN(pb + 0)) _Pragma("nounroll") for (int rep_ = 0; rep_ < NREP(0); ++rep_) { const Ctx c = opaque_ctx(c0); WSB_OPAQUE(); if (TPROBE == 6) tph0 = __builtin_amdgcn_s_memrealtime();
            const int N = even ? 4096 : 3072;
            pg8::Gemm g{Xb, even ? Win_t + (size_t)i2 * 4096 * DM : Wqkv_t + (size_t)i2 * 3072 * DM, DM, DM, DM, 0, 0, nullptr};
            pg8::StaticOrder S; S.init(M, N, c.G, (int)blockIdx.x);
            if (even) { pg8::EpiStoreBf16 E{H, N}; pg8::gemm_phase<pg8::EpiStoreBf16, false>(c.lds, g, S, E); }
            else { pg8::EpiQKNorm E{H, apx->in[11] + i2 * 128, apx->in[12] + i2 * 128, tabG, (LAS float*)(c.lds + RING_BYTES + 2048)};
                   pg8::gemm_phase<pg8::EpiQKNorm, false>(c.lds, g, S, E); }
            SEAM(pb + 0);
        }
        if (PHM(1) && IN(pb + 1) && even) _Pragma("nounroll") for (int rep_ = 0; rep_ < NREP(1); ++rep_) { const Ctx c = opaque_ctx(c0); WSB_OPAQUE(); if (TPROBE == 6) tph0 = __builtin_amdgcn_s_memrealtime();
            if (even) { if (rep_ == 0 || (DUP_SUB & 4)) mla_prep_rows(c, H, rep_ == 0 ? H : (bf16_t*)(ws + WS_HDN), Km, apx->in[2] + i2 * 512, apx->in[4] + i2 * 256, tabR);
                        if (rep_ == 0 || !(DUP_SUB & 4)) gla_prep(c, H, apx->in[6] + (size_t)i2 * 2 * 16 * 512, apx->in[7] + i2 * 2 * 512, (unsigned char*)qin  , vT); }
            SEAM(pb + 1);
        }
        if (PHM(2) && IN(pb + 2) && even) _Pragma("nounroll") for (int rep_ = 0; rep_ < NREP(2); ++rep_) { const Ctx c = opaque_ctx(c0); WSB_OPAQUE(); if (TPROBE == 6) tph0 = __builtin_amdgcn_s_memrealtime();
#ifndef SUBM
#define SUBM 0x1F
#endif
            if (SUBM & 1) { pg8::Gemm g{H + C_CQ, Wuq_t + (size_t)i2 * 1536 * 512, HW, 512, 512, 0, 0, nullptr}; pg8::StaticOrder S; S.init(M, 1536, c.G, (int)blockIdx.x);
              pg8::EpiQRope E{Qm, tabR}; pg8::gemm_phase<pg8::EpiQRope, false>(c.lds, g, S, E); }
            if (SUBM & 2) { pg8::Gemm g{H + C_CKV, Wukv_t + (size_t)i2 * 2048 * 256, HW, 256, 256, 0, 0, nullptr}; pg8::StaticOrder S; S.init(M, 2048, c.G, (int)blockIdx.x);
              pg8::EpiKV E{Km, Vm}; pg8::gemm_phase<pg8::EpiKV, false>(c.lds, g, S, E); }
            SEAM(pb + 2);
        }
        if (PHM(3) && IN(pb + 3)) _Pragma("nounroll") for (int rep_ = 0; rep_ < NREP(3); ++rep_) { const Ctx c = opaque_ctx(c0); WSB_OPAQUE(); if (TPROBE == 6) tph0 = __builtin_amdgcn_s_memrealtime();
            if (even) {
                TP_BEGIN(1); if ((SUBM & 4) && (rep_ == 0 || (DUP_SUB & 1))) for (int v4 = c.vcu; v4 < 256; v4 += c.G) if ((v4 & 3) == 0) gla::unit(c, v4 >> 2, (const unsigned char*)qin  , vT, of, ob); TP_END(1); TP_BEGIN(2);
                if ((SUBM & 8) && (rep_ == 0 || (DUP_SUB & 2))) for (int uid = c.vcu; uid < 512; uid += c.G) { const int b = uid >> 7, h = (uid >> 4) & 7, qb = uid & 15; const size_t r0 = (size_t)b * SEQ;
                    attn::attn_unit<192, 1536, 1536, 1024, 2048>(Qm + (r0 + qb * 256) * 1536 + h * 192, Km + r0 * 1536 + h * 192, Vm + r0 * 1024 + h * 128, Ocat8 + (r0 + qb * 256) * 2048 + h * 128, SEQ, (char*)lds_raw); }
                TP_END(2);
                if (rep_ == 0 && (c.vcu & 3) != 0 && c.G == 256) {
                    const int tl = (layer == 0) ? 2 : 3, rk = c.vcu - (c.vcu >> 2) - 1; const size_t lo_ = (size_t)tl * NEXP;
                    transpose_batch_f8(c, apx->in[15] + lo_ * DM * FF, W13f8 + lo_ * 2 * FF * DM, DM, FF, NEXP, (size_t)DM * FF, (size_t)2 * FF * DM, 2, 64.f, rk, 192);
                    transpose_batch_f8(c, apx->in[16] + lo_ * DM * FF, W13f8 + lo_ * 2 * FF * DM, DM, FF, NEXP, (size_t)DM * FF, (size_t)2 * FF * DM, 3, 512.f, rk, 192);
                    transpose_batch_f8(c, apx->in[17] + lo_ * FF * DM, W2f8 + lo_ * DM * FF, FF, DM, NEXP / 2, (size_t)FF * DM, (size_t)DM * FF, 0, 128.f, rk, 192);
                }
            } else {
                TP_BEGIN(3);
                if (SUBM & 16) for (int uid = c.vcu; uid < 1024; uid += c.G) { const int b = uid >> 8, kvh = (uid >> 6) & 3, gq = (uid >> 4) & 3, qb = uid & 15, h = kvh * 4 + gq; const size_t r0 = (size_t)b * SEQ;
                    attn::attn_unit<128, 3072, 3072, 3072, 2048>(H + (r0 + qb * 256) * 3072 + h * 128, H + r0 * 3072 + 2048 + kvh * 128, H + r0 * 3072 + 2560 + kvh * 128, Ocat8 + (r0 + qb * 256) * 2048 + h * 128, SEQ, (char*)lds_raw); }
                TP_END(3);
            }
            TP_BEGIN(4); SEAM(pb + 3); TP_END(4);
        }
        if (PHM(4) && IN(pb + 4) && even) _Pragma("nounroll") for (int rep_ = 0; rep_ < NREP(4); ++rep_) { const Ctx c = opaque_ctx(c0); WSB_OPAQUE(); if (TPROBE == 6) tph0 = __builtin_amdgcn_s_memrealtime(); gla_out_rows(c, of, ob, H, apx->in[8] + i2 * 1024, Ocat8); SEAM(pb + 4); }
        if (PHM(5) && IN(pb + 5)) _Pragma("nounroll") for (int rep_ = 0; rep_ < NREP(5); ++rep_) { const Ctx c = opaque_ctx(c0); WSB_OPAQUE(); if (TPROBE == 6) tph0 = __builtin_amdgcn_s_memrealtime();
            pg8::Gemm g{(const bf16_t*)Ocat8, (const bf16_t*)((even ? Wmo8 : Wgo8) + (size_t)i2 * DM * DM), DM / 2, DM / 2, DM / 2, 0, 0, iota};
            pg8::StaticOrder S; S.init(M, DM, c.G, (int)blockIdx.x);
            pg8::EpiStoreBf16 E{Mb, DM};
            pg8::gemm_phase<pg8::EpiStoreBf16, true, true, 0x78787878, 0x7A7A7A7A>(c.lds, g, S, E);
            SEAM(pb + 5);
        }
        if (PHM(6) && IN(pb + 6)) _Pragma("nounroll") for (int rep_ = 0; rep_ < NREP(6); ++rep_) { const Ctx c = opaque_ctx(c0); WSB_OPAQUE(); if (TPROBE == 6) tph0 = __builtin_amdgcn_s_memrealtime(); ln_router_rows(c, Xb, Mb, X1b, X1f8, apx->in[18] + layer * DM, apx->in[19] + layer * DM, apx->in[14] + (size_t)layer * DM * NEXP, aff); SEAM(pb + 6); }
        if (PHM(7) && IN(pb + 7)) _Pragma("nounroll") for (int rep_ = 0; rep_ < NREP(7); ++rep_) { const Ctx c = opaque_ctx(c0); WSB_OPAQUE(); if (TPROBE == 6) tph0 = __builtin_amdgcn_s_memrealtime(); topk_units(c, aff, idx, gate, slotmap);
            if (c.G == 256 && c.vcu >= 64) { const size_t m0 = (layer < 2) ? (size_t)NEXP + (size_t)layer * 8 : (size_t)layer * NEXP + 8;
                transpose_batch_f8(c, apx->in[17] + m0 * FF * DM, W2f8 + m0 * DM * FF, FF, DM, 8, (size_t)FF * DM, (size_t)DM * FF, 0, 128.f, c.vcu - 64, 192); }
            SEAM(pb + 7); }
        if (PHM(8) && IN(pb + 8)) _Pragma("nounroll") for (int rep_ = 0; rep_ < NREP(8); ++rep_) { const Ctx c = opaque_ctx(c0); WSB_OPAQUE(); if (TPROBE == 6) tph0 = __builtin_amdgcn_s_memrealtime();
            pg8::Gemm g{(const bf16_t*)X1f8, (const bf16_t*)(W13f8 + (size_t)layer * NEXP * 2 * FF * DM), DM / 2, DM / 2, DM / 2, 3, (size_t)FF * DM, idx};
            pg8::StaticOrder S; S.init(MX, 2 * FF, c.G, (int)blockIdx.x);
            pg8::EpiSwigluF8 E{hdn8};
            pg8::gemm_phase<pg8::EpiSwigluF8, true, true>(c.lds, g, S, E);
            SEAM(pb + 8);
        }
        if (PHM(9) && IN(pb + 9)) _Pragma("nounroll") for (int rep_ = 0; rep_ < NREP(9); ++rep_) { const Ctx c = opaque_ctx(c0); WSB_OPAQUE(); if (TPROBE == 6) tph0 = __builtin_amdgcn_s_memrealtime();
            pg8::Gemm g{(const bf16_t*)hdn8, (const bf16_t*)(W2f8 + (size_t)layer * NEXP * DM * FF), FF / 2, FF / 2, FF / 2, 3, (size_t)DM * FF / 2, iota};
            pg8::StaticOrder S; S.init(MX, DM, c.G, (int)blockIdx.x);
            pg8::EpiGate E{Yb, gate};
            pg8::gemm_phase<pg8::EpiGate, true, true, 0x78787878, 0x7C7C7C7C>(c.lds, g, S, E);
            SEAM(pb + 9);
        }
        if (PHM(10) && IN(pb + 10)) _Pragma("nounroll") for (int rep_ = 0; rep_ < NREP(10); ++rep_) { const Ctx c = opaque_ctx(c0); WSB_OPAQUE(); if (TPROBE == 6) tph0 = __builtin_amdgcn_s_memrealtime(); combine_ln_rows(c, X1b, Yb, slotmap, apx->in[20] + layer * DM, apx->in[21] + layer * DM, (layer == DEPTH - 1) ? X2 : (float*)nullptr, Xb); SEAM(pb + 10); }
    }
    if (TPROBE == 9 && threadIdx.x == 0) tpr_acc = *(volatile LAS unsigned long long*)(c.lds + MISC_OFF + 64);
    if (TPROBE != 0 && blockIdx.x == TPROBE_BLOCK) { const unsigned long long tgt = __builtin_amdgcn_s_memrealtime() + 16ull * tpr_acc; while (__builtin_amdgcn_s_memrealtime() < tgt) __builtin_amdgcn_s_sleep(20); }
#undef IN
#undef SEAM
#undef tabR
#undef tabG
#undef aff
#undef idx
#undef gate
#undef slotmap
#undef Win_t
#undef Wuq_t
#undef Wukv_t
#undef Wmo_t
#undef Wqkv_t
#undef Wgo_t
#undef W13_t
#undef W2_t
#undef Xb
#undef X1b
#undef X1f8
#undef W13f8
#undef W2f8
#undef hdn8
#undef iota
#undef Ocat8
#undef Wmo8
#undef Wgo8
#undef H
#undef Qm
#undef Km
#undef Vm
#undef Ocat
#undef qin
#undef vT
#undef of
#undef ob
#undef hdn
#undef Yb
#undef Mb
#undef X2
#undef WSB_OPAQUE
}

extern "C" void kernel_launch(void* const* d_in, const int* in_sizes, int n_in, void* d_out, int out_size, void* d_ws, size_t ws_size, hipStream_t stream) {
    static int grid = 0;
    if (grid == 0) {
        if (n_in != 22 || in_sizes[0] != M * DM || out_size != M * DM || ws_size < WS_END) { fprintf(stderr, "kernel_launch: unexpected shapes (n_in %d, in0 %d, out %d, ws %zu < %zu); nothing launched\n", n_in, n_in > 0 ? in_sizes[0] : -1, out_size, ws_size, (size_t)WS_END); grid = -1; return; }
        int dev = 0, cus = 0, per_cu = 0;
        if (hipGetDevice(&dev) != hipSuccess || hipDeviceGetAttribute(&cus, hipDeviceAttributeMultiprocessorCount, dev) != hipSuccess) { grid = -1; return; }
        if (hipFuncSetAttribute((const void*)hybrid_fwd, hipFuncAttributeMaxDynamicSharedMemorySize, LDS_BYTES) != hipSuccess) { fprintf(stderr, "kernel_launch: hipFuncSetAttribute failed\n"); grid = -1; return; }
        if (hipOccupancyMaxActiveBlocksPerMultiprocessor(&per_cu, (const void*)hybrid_fwd, NTHR, LDS_BYTES) != hipSuccess || per_cu < 1) fprintf(stderr, "kernel_launch: occupancy query reports %d\n", per_cu);
        (void)hipGetLastError();
        grid = cus;
    }
    if (grid < 0) return;
    if (hipMemsetAsync((char*)d_ws + WS_CTL, 0, CTL_ZERO_BYTES, stream) != hipSuccess) return;
    Args a{};
    for (int i = 0; i < 22; ++i) a.in[i] = (const float*)d_in[i];
    a.out = (float*)d_out; a.ws = (unsigned char*)d_ws; a.pad = 0;
#if MK_SPLIT
    for (int p = 0; p < NPHASE; ++p) {
        if (p > 0) { const int layer = (p - 1) / NPH_LAYER, k = (p - 1) % NPH_LAYER; if ((layer & 1) && (k == 2 || k == 4)) continue; }
        a.ph_lo = p; a.ph_hi = p + 1; a.li = 0;
        hipLaunchKernelGGL(hybrid_fwd, dim3(grid), dim3(NTHR), LDS_BYTES, stream, a);
    }
#elif defined(RELAUNCH_PHASE)
    a.ph_lo = 0; a.ph_hi = RELAUNCH_PHASE + 1; a.li = 0; hipLaunchKernelGGL(hybrid_fwd, dim3(grid), dim3(NTHR), LDS_BYTES, stream, a);
    a.ph_lo = RELAUNCH_PHASE; a.ph_hi = RELAUNCH_PHASE + 1; a.li = 1; hipLaunchKernelGGL(hybrid_fwd, dim3(grid), dim3(NTHR), LDS_BYTES, stream, a);
    a.ph_lo = RELAUNCH_PHASE + 1; a.ph_hi = NPHASE; a.li = 2; hipLaunchKernelGGL(hybrid_fwd, dim3(grid), dim3(NTHR), LDS_BYTES, stream, a);
#else
    a.ph_lo = 0; a.ph_hi = NPHASE; a.li = 0;
    hipLaunchKernelGGL(hybrid_fwd, dim3(grid), dim3(NTHR), LDS_BYTES, stream, a);
#endif
    const hipError_t le = hipPeekAtLastError();
    if (le != hipSuccess) fprintf(stderr, "kernel_launch: launch failed: %s\n", hipGetErrorName(le));
}
```

```cpp
#include <hip/hip_runtime.h>
#include <hip/hip_bf16.h>
#include <cstdio>
#include <cstdint>
#include <cmath>

#define GAS __attribute__((address_space(1)))
#define LAS __attribute__((address_space(3)))
typedef unsigned short bf16_t;
typedef short bf16x8 __attribute__((ext_vector_type(8)));
typedef short s16x4 __attribute__((ext_vector_type(4)));
typedef float f32x4 __attribute__((ext_vector_type(4)));
typedef float f32x2 __attribute__((ext_vector_type(2)));
typedef float f32x16 __attribute__((ext_vector_type(16)));
typedef unsigned u32x4 __attribute__((ext_vector_type(4)));
typedef unsigned u32x2 __attribute__((ext_vector_type(2)));
typedef GAS unsigned gu32;

__device__ __forceinline__ unsigned cvt_pk_bf16(float lo, float hi) { unsigned r; asm volatile("v_cvt_pk_bf16_f32 %0, %1, %2" : "=v"(r) : "v"(lo), "v"(hi)); return r; }
__device__ __forceinline__ float bf_lo(unsigned w) { return __uint_as_float(w << 16); }
__device__ __forceinline__ float bf_hi(unsigned w) { return __uint_as_float(w & 0xffff0000u); }
__device__ __forceinline__ float bf2f(bf16_t h) { return __uint_as_float(((unsigned)h) << 16); }
__device__ __forceinline__ bf16_t f2bf(float f) { return (bf16_t)(cvt_pk_bf16(f, 0.f) & 0xffffu); }

namespace pg8 {
constexpr int BM = 256, BK = 64, HALF = 128, HTB = HALF * BK * 2, STAGE_BYTES = 8 * HTB, NXCD = 8, WGM = 8;
__host__ __device__ __forceinline__ int lds_byte(int r, int c) { const int st = (r >> 4) * 2 + (c >> 5), rr = r & 15, cc = c & 31, ob = rr * 64 + cc * 2; return st * 1024 + (ob ^ (((ob >> 9) & 1) << 5)); }
__host__ __device__ __forceinline__ void stage_rc(int b, int& R, int& C) { const int st = b / 1024, sb = b % 1024, swz = sb ^ (((sb >> 9) & 1) << 5); R = (st >> 1) * 16 + swz / 64; C = (st & 1) * 32 + (swz % 64) / 2; }
__host__ __device__ __forceinline__ int perm32(int rho) { const int n = rho >> 4, i = rho & 15; return 8 * (i >> 2) + 4 * n + (i & 3); }

struct Unit { int pm, pn; };
struct Gemm { const bf16_t* A; const bf16_t* Bt; int lda, ldb, K, bshift; size_t bstride; const int* gather; };

struct StaticOrder {
    int nM, nN, nwg, G, c;
    __device__ void init(int M, int N, int G_, int c_) { nM = M / BM; nN = N / BM; nwg = nM * nN; G = G_; c = c_; }
    __device__ bool next(int i, Unit& u) const {
        const long L = (long)i * G + c; if (L >= nwg) return false;
        int wgid = (int)L; { const int q = nwg / NXCD, r = nwg % NXCD, xcd = wgid % NXCD, off = wgid / NXCD; wgid = (xcd < r ? xcd * (q + 1) : r * (q + 1) + (xcd - r) * q) + off; }
        const int nig = WGM * nN, gid = wgid / nig, fm = gid * WGM, gsz = (nM - fm) < WGM ? (nM - fm) : WGM;
        u.pm = fm + ((wgid % nig) % gsz); u.pn = (wgid % nig) / gsz; return true;
    }
};

typedef int v8i_t __attribute__((ext_vector_type(8)));
typedef short s16x16_t __attribute__((ext_vector_type(16)));
__device__ __forceinline__ v8i_t cat16(bf16x8 a, bf16x8 b) { const s16x16_t t = __builtin_shufflevector(a, b, 0, 1, 2, 3, 4, 5, 6, 7, 8, 9, 10, 11, 12, 13, 14, 15); return __builtin_bit_cast(v8i_t, t); }
template <class Epi, bool GATHER, bool F8 = false, int WSC = 0x79797979, int ASC = 0x7F7F7F7F>
__device__ __forceinline__ void gemm_phase(LAS unsigned char* lds, const Gemm g, const StaticOrder& S, const Epi& E) {
    int tid_ = threadIdx.x; asm volatile("" : "+v"(tid_));
    const int tid = tid_, wid = __builtin_amdgcn_readfirstlane(tid >> 6), lane = tid & 63, wr = wid >> 2, wc = wid & 3, fr = lane & 15, fq = lane >> 4;
    const int K = g.K, nt = K / BK;
    unsigned voffA[2], voffB[2]; int RA[2], CA[2];
#pragma unroll
    for (int i = 0; i < 2; ++i) { int R, C; stage_rc(tid * 16 + i * 8192, R, C); const int Rb = Epi::PERM ? ((R & ~31) + perm32(R & 31)) : R;
        RA[i] = R; CA[i] = C; voffA[i] = (unsigned)(R * g.lda + C) * 2u; voffB[i] = (unsigned)(Rb * g.ldb + C) * 2u; }
    const size_t kstep = (size_t)(BK * 2);
    const size_t hstepA = (size_t)HALF * g.lda * 2, hstepB = (size_t)HALF * g.ldb * 2;
    const size_t tstepA = 2 * hstepA, tstepB = 2 * hstepB;
    const unsigned ldsw = (unsigned)wid * 1024u;
    int aoffk[2], boffk[2];
#pragma unroll
    for (int k = 0; k < 2; ++k) { const int col = F8 ? ((fq >> 1) * 32 + (fq & 1) * 16 + 8 * k) : (k * 32 + fq * 8); aoffk[k] = lds_byte(wr * 64 + fr, col); boffk[k] = lds_byte(wc * 32 + fr, col); }
#define PG8_SA(b, h) (((b) * 2 + (h)) * HTB)
#define PG8_SB(b, h) ((4 + (b) * 2 + (h)) * HTB)
#define PG8_STAGE(bufoff, gbase, voff) do { const char* _gb = (const char*)(gbase); asm volatile("" : "+s"(_gb));     \
        _Pragma("unroll") for (int _i = 0; _i < 2; ++_i) \
        __builtin_amdgcn_global_load_lds((const unsigned*)(_gb + (voff)[_i]), (LAS unsigned*)(lds + (bufoff) + ldsw + _i * 8192), 16, 0, 0); } while (0)
#define PG8_STAGE_A(bufoff, gptr, h, vg) do { if constexpr (GATHER) { PG8_STAGE(bufoff, gptr, vg[h]); } else { PG8_STAGE(bufoff, (gptr) + (h) * hstepA, voffA); } } while (0)
#define PG8_LDA(dst, b, h) do { if constexpr (F8) { _Pragma("unroll") for (int m = 0; m < 4; ++m) dst##8[m] = *(const LAS v8i_t*)(lds + PG8_SA(b, h) + aoffk[0] + m * 2048); } \
    else { _Pragma("unroll") for (int m = 0; m < 4; ++m) _Pragma("unroll") for (int k = 0; k < 2; ++k) dst[m][k] = *(const LAS bf16x8*)(lds + PG8_SA(b, h) + aoffk[k] + m * 2048); } } while (0)
#define PG8_LDB(dst, b, h) do { if constexpr (F8) { _Pragma("unroll") for (int n = 0; n < 2; ++n) dst##8[n] = *(const LAS v8i_t*)(lds + PG8_SB(b, h) + boffk[0] + n * 2048); } \
    else { _Pragma("unroll") for (int n = 0; n < 2; ++n) _Pragma("unroll") for (int k = 0; k < 2; ++k) dst[n][k] = *(const LAS bf16x8*)(lds + PG8_SB(b, h) + boffk[k] + n * 2048); } } while (0)
#define PG8_MMA(ai, bj, At, Bt) do { __builtin_amdgcn_s_setprio(1); \
    if constexpr (F8) { _Pragma("unroll") for (int m = 0; m < 4; ++m) _Pragma("unroll") for (int n = 0; n < 2; ++n) \
        acc[ai][bj][m][n] = __builtin_amdgcn_mfma_scale_f32_16x16x128_f8f6f4(Bt##8[n], At##8[m], acc[ai][bj][m][n], 0, 0, 0, WSC, 0, ASC); } \
    else { _Pragma("unroll") for (int m = 0; m < 4; ++m) _Pragma("unroll") for (int n = 0; n < 2; ++n) _Pragma("unroll") for (int k = 0; k < 2; ++k) \
        acc[ai][bj][m][n] = __builtin_amdgcn_mfma_f32_16x16x32_bf16(Bt[n][k], At[m][k], acc[ai][bj][m][n], 0, 0, 0); } __builtin_amdgcn_s_setprio(0); } while (0)
#define PG8_WAIT_V(n) asm volatile("s_waitcnt vmcnt(" #n ")" ::: "memory")
#define PG8_WAIT_L(n) asm volatile("s_waitcnt lgkmcnt(" #n ")" ::: "memory")
#define PG8_BAR __builtin_amdgcn_s_barrier()
#define PG8_SCHED __builtin_amdgcn_sched_barrier(0)
    Unit cur, nxt; int ui = 0;
    if (!S.next(0, cur)) return;
    f32x4 acc[2][2][4][2];
#pragma unroll
    for (int a = 0; a < 2; ++a)
#pragma unroll
        for (int b = 0; b < 2; ++b)
#pragma unroll
            for (int m = 0; m < 4; ++m)
#pragma unroll
                for (int n = 0; n < 2; ++n) acc[a][b][m][n] = (f32x4){0.f, 0.f, 0.f, 0.f};
    bf16x8 At[4][2], B0[2][2], B1[2][2]; v8i_t At8[4], B08[2], B18[2];
    unsigned vgc[2][2], vgn[2][2];
    if constexpr (GATHER) {
#pragma unroll
        for (int h = 0; h < 2; ++h)
#pragma unroll
            for (int i = 0; i < 2; ++i) { const int gr = g.gather[cur.pm * BM + h * HALF + RA[i]]; vgc[h][i] = (unsigned)(gr * g.lda + CA[i]) * 2u; vgn[h][i] = vgc[h][i]; }
    }
    const char* cA = GATHER ? (const char*)g.A : (const char*)g.A + (size_t)cur.pm * tstepA;
    const char* cB = (const char*)g.Bt + (size_t)(cur.pm >> g.bshift) * g.bstride * 2 + (size_t)cur.pn * tstepB;
    PG8_STAGE(PG8_SB(0, 0), cB, voffB); PG8_STAGE(PG8_SB(0, 1), cB + hstepB, voffB); PG8_STAGE_A(PG8_SA(0, 0), cA, 0, vgc); PG8_STAGE_A(PG8_SA(0, 1), cA, 1, vgc);
    if (wr == 1) PG8_BAR;
    PG8_WAIT_V(2); PG8_BAR;
    PG8_STAGE(PG8_SB(1, 0), cB + kstep, voffB); PG8_STAGE_A(PG8_SA(1, 0), cA + kstep, 0, vgc); PG8_STAGE(PG8_SB(1, 1), cB + hstepB + kstep, voffB);
    PG8_WAIT_V(6); PG8_BAR;
    for (;;) {
        const bool has_next = S.next(ui + 1, nxt);
        if constexpr (GATHER) {
            if (has_next) { int t2 = tid; asm volatile("" : "+v"(t2));
#pragma unroll
                for (int i = 0; i < 2; ++i) { int R, C; stage_rc(t2 * 16 + i * 8192, R, C);
#pragma unroll
                    for (int h = 0; h < 2; ++h) { const int gr = g.gather[nxt.pm * BM + h * HALF + R]; vgn[h][i] = (unsigned)(gr * g.lda + C) * 2u; } }
            }
        }
        const char* nA = has_next ? (GATHER ? (const char*)g.A : (const char*)g.A + (size_t)nxt.pm * tstepA) : cA;
        const char* nB = has_next ? (const char*)g.Bt + (size_t)(nxt.pm >> g.bshift) * g.bstride * 2 + (size_t)nxt.pn * tstepB : cB;
#pragma nounroll
        for (int t = 0; t < nt; t += 2) {
            const bool last = (t == nt - 2);
            asm volatile("" : "+v"(voffB[0]), "+v"(voffB[1]));
            if constexpr (GATHER) asm volatile("" : "+v"(vgc[0][0]), "+v"(vgc[0][1]), "+v"(vgc[1][0]), "+v"(vgc[1][1]), "+v"(vgn[0][0]), "+v"(vgn[0][1]), "+v"(vgn[1][0]), "+v"(vgn[1][1]));
            else asm volatile("" : "+v"(voffA[0]), "+v"(voffA[1]));
            const char* a1 = cA + (size_t)(t + 1) * kstep;
            const char* a2 = last ? nA : cA + (size_t)(t + 2) * kstep; const char* b2 = last ? nB : cB + (size_t)(t + 2) * kstep;
            const char* a3 = a2 + kstep; const char* b3 = b2 + kstep;
            PG8_LDB(B0, 0, 0); PG8_LDB(B1, 0, 1); PG8_SCHED; PG8_LDA(At, 0, 0); PG8_STAGE_A(PG8_SA(1, 1), a1, 1, vgc);
            if constexpr (GATHER) { if (last && has_next) {
#pragma unroll
                for (int h = 0; h < 2; ++h)
#pragma unroll
                    for (int i = 0; i < 2; ++i) vgc[h][i] = vgn[h][i]; } }
            PG8_WAIT_V(8); PG8_WAIT_L(0); PG8_BAR; PG8_MMA(0, 0, At, B0); PG8_MMA(0, 1, At, B1); PG8_BAR; PG8_SCHED;
            PG8_LDA(At, 0, 1); PG8_STAGE(PG8_SB(0, 0), b2, voffB); PG8_STAGE(PG8_SB(0, 1), b2 + hstepB, voffB); PG8_STAGE_A(PG8_SA(0, 0), a2, 0, vgc);
            PG8_WAIT_V(8); PG8_WAIT_L(0); PG8_BAR; PG8_MMA(1, 0, At, B0); PG8_MMA(1, 1, At, B1); PG8_BAR; PG8_SCHED;
            PG8_LDB(B0, 1, 0); PG8_LDB(B1, 1, 1); PG8_SCHED; PG8_LDA(At, 1, 0); PG8_STAGE_A(PG8_SA(0, 1), a2, 1, vgc);
            PG8_WAIT_V(8); PG8_WAIT_L(0); PG8_BAR; PG8_MMA(0, 0, At, B0); PG8_MMA(0, 1, At, B1); PG8_BAR; PG8_SCHED;
            PG8_LDA(At, 1, 1); PG8_STAGE(PG8_SB(1, 0), b3, voffB); PG8_STAGE(PG8_SB(1, 1), b3 + hstepB, voffB); PG8_STAGE_A(PG8_SA(1, 0), a3, 0, vgc);
            PG8_WAIT_V(8); PG8_WAIT_L(0); PG8_BAR; PG8_MMA(1, 0, At, B0); PG8_MMA(1, 1, At, B1); PG8_BAR; PG8_SCHED;
        }
        if (wr == 0) PG8_BAR;
        { int te = threadIdx.x; asm volatile("" : "+v"(te)); E(acc, cur, wr, wc, te & 15, (te >> 4) & 3); }
        if (!has_next) break;
#pragma unroll
        for (int a = 0; a < 2; ++a)
#pragma unroll
            for (int b = 0; b < 2; ++b)
#pragma unroll
                for (int m = 0; m < 4; ++m)
#pragma unroll
                    for (int n = 0; n < 2; ++n) acc[a][b][m][n] = (f32x4){0.f, 0.f, 0.f, 0.f};
        cur = nxt; cA = nA; cB = nB; ++ui;
        if (wr == 1) PG8_BAR;
    }
    PG8_WAIT_V(0);
    PG8_BAR;
#undef PG8_SA
#undef PG8_SB
#undef PG8_STAGE
#undef PG8_STAGE_A
#undef PG8_LDA
#undef PG8_LDB
#undef PG8_MMA
#undef PG8_WAIT_V
#undef PG8_WAIT_L
#undef PG8_BAR
#undef PG8_SCHED
}
}
namespace pg8 {
struct EpiStoreBf16 {
    static constexpr bool PERM = true;
    bf16_t* O; int ldc;
    __device__ __forceinline__ void operator()(const f32x4 (&acc)[2][2][4][2], const Unit& u, int wr, int wc, int fr, int fq) const {
        const int row0 = u.pm * BM + wr * 64 + fr, col0 = u.pn * BM + wc * 32 + 8 * fq;
#pragma unroll
        for (int ai = 0; ai < 2; ++ai)
#pragma unroll
            for (int m = 0; m < 4; ++m) { bf16_t* rowp = O + (size_t)(row0 + ai * HALF + m * 16) * ldc + col0;
#pragma unroll
                for (int bj = 0; bj < 2; ++bj) { const f32x4 v0 = acc[ai][bj][m][0], v1 = acc[ai][bj][m][1];
                    u32x4 w; w.x = cvt_pk_bf16(v0[0], v0[1]); w.y = cvt_pk_bf16(v0[2], v0[3]); w.z = cvt_pk_bf16(v1[0], v1[1]); w.w = cvt_pk_bf16(v1[2], v1[3]);
                    *(u32x4*)(rowp + bj * HALF) = w; } }
    }
};
struct EpiQRope {
    static constexpr bool PERM = true;
    bf16_t* O; const f32x2* tab;
    __device__ __forceinline__ void operator()(const f32x4 (&acc)[2][2][4][2], const Unit& u, int wr, int wc, int fr, int fq) const {
        const int row0 = u.pm * BM + wr * 64 + fr, col0 = u.pn * BM + wc * 32 + 8 * fq;
#pragma unroll
        for (int bj = 0; bj < 2; ++bj) {
            const int col = col0 + bj * HALF, within = col % 192;
            const bool pe = within >= 128; const int p0 = (within - 128) >> 1;
#pragma unroll
            for (int ai = 0; ai < 2; ++ai)
#pragma unroll
                for (int m = 0; m < 4; ++m) { const int row = row0 + ai * HALF + m * 16;
                    f32x4 v0 = acc[ai][bj][m][0], v1 = acc[ai][bj][m][1];
                    if (pe) { const f32x2* tp = tab + (size_t)(row & 4095) * 32 + p0; const f32x4 t01 = *(const f32x4*)tp, t23 = *(const f32x4*)(tp + 2);
                        const f32x4 a = v0, b = v1;
                        v0[0] = a[0] * t01[0] - a[1] * t01[1]; v0[1] = a[0] * t01[1] + a[1] * t01[0]; v0[2] = a[2] * t01[2] - a[3] * t01[3]; v0[3] = a[2] * t01[3] + a[3] * t01[2];
                        v1[0] = b[0] * t23[0] - b[1] * t23[1]; v1[1] = b[0] * t23[1] + b[1] * t23[0]; v1[2] = b[2] * t23[2] - b[3] * t23[3]; v1[3] = b[2] * t23[3] + b[3] * t23[2]; }
                    u32x4 w; w.x = cvt_pk_bf16(v0[0], v0[1]); w.y = cvt_pk_bf16(v0[2], v0[3]); w.z = cvt_pk_bf16(v1[0], v1[1]); w.w = cvt_pk_bf16(v1[2], v1[3]);
                    *(u32x4*)(O + (size_t)row * 1536 + col) = w; asm volatile("" ::: "memory"); }
        }
    }
};
struct EpiKV {
    static constexpr bool PERM = true;
    bf16_t* Km; bf16_t* Vm;
    __device__ __forceinline__ void operator()(const f32x4 (&acc)[2][2][4][2], const Unit& u, int wr, int wc, int fr, int fq) const {
        const int row0 = u.pm * BM + wr * 64 + fr, c = wc * 32 + 8 * fq;
#pragma unroll
        for (int ai = 0; ai < 2; ++ai)
#pragma unroll
            for (int m = 0; m < 4; ++m) { const size_t row = (size_t)(row0 + ai * HALF + m * 16);
#pragma unroll
                for (int bj = 0; bj < 2; ++bj) { const f32x4 v0 = acc[ai][bj][m][0], v1 = acc[ai][bj][m][1];
                    u32x4 w; w.x = cvt_pk_bf16(v0[0], v0[1]); w.y = cvt_pk_bf16(v0[2], v0[3]); w.z = cvt_pk_bf16(v1[0], v1[1]); w.w = cvt_pk_bf16(v1[2], v1[3]);
                    if (bj == 0) *(u32x4*)(Km + row * 1536 + u.pn * 192 + c) = w; else *(u32x4*)(Vm + row * 1024 + u.pn * 128 + c) = w; }
                asm volatile("" ::: "memory"); }
    }
};
struct EpiResid {
    static constexpr bool PERM = false;
    const float* X; float* Y; float alpha;
    __device__ __forceinline__ void operator()(const f32x4 (&acc)[2][2][4][2], const Unit& u, int wr, int wc, int fr, int fq) const {
        const int row0 = u.pm * BM + wr * 64 + fr, col0 = u.pn * BM + wc * 32 + 4 * fq;
#pragma unroll
        for (int ai = 0; ai < 2; ++ai)
#pragma unroll
            for (int m = 0; m < 4; ++m) { const size_t off = (size_t)(row0 + ai * HALF + m * 16) * 2048 + col0;
#pragma unroll
                for (int bj = 0; bj < 2; ++bj)
#pragma unroll
                    for (int n = 0; n < 2; ++n) { const f32x4 xv = *(const f32x4*)(X + off + bj * HALF + n * 16); *(f32x4*)(Y + off + bj * HALF + n * 16) = xv * alpha + acc[ai][bj][m][n]; }
                if (m & 1) asm volatile("" ::: "memory"); }
    }
};
struct EpiSwiglu {
    static constexpr bool PERM = true;
    bf16_t* O;
    __device__ __forceinline__ void operator()(const f32x4 (&acc)[2][2][4][2], const Unit& u, int wr, int wc, int fr, int fq) const {
        const int row0 = u.pm * BM + wr * 64 + fr, col0 = u.pn * HALF + wc * 32 + 8 * fq;
#pragma unroll
        for (int ai = 0; ai < 2; ++ai)
#pragma unroll
            for (int m = 0; m < 4; ++m) { float h[8];
#pragma unroll
                for (int n = 0; n < 2; ++n)
#pragma unroll
                    for (int j = 0; j < 4; ++j) { const float a = acc[ai][0][m][n][j], b = acc[ai][1][m][n][j]; h[n * 4 + j] = a * __builtin_amdgcn_rcpf(1.f + __expf(-a)) * b; }
                u32x4 w; w.x = cvt_pk_bf16(h[0], h[1]); w.y = cvt_pk_bf16(h[2], h[3]); w.z = cvt_pk_bf16(h[4], h[5]); w.w = cvt_pk_bf16(h[6], h[7]);
                *(u32x4*)(O + (size_t)(row0 + ai * HALF + m * 16) * 1536 + col0) = w; }
    }
};
struct EpiSwigluF8 {
    static constexpr bool PERM = true;
    unsigned char* O;
    __device__ __forceinline__ void operator()(const f32x4 (&acc)[2][2][4][2], const Unit& u, int wr, int wc, int fr, int fq) const {
        const int row0 = u.pm * BM + wr * 64 + fr, col0 = u.pn * HALF + wc * 32 + 8 * fq;
#pragma unroll
        for (int ai = 0; ai < 2; ++ai)
#pragma unroll
            for (int m = 0; m < 4; ++m) { float h[8];
#pragma unroll
                for (int n = 0; n < 2; ++n)
#pragma unroll
                    for (int j = 0; j < 4; ++j) { const float a = acc[ai][0][m][n][j], b = acc[ai][1][m][n][j]; h[n * 4 + j] = a * __builtin_amdgcn_rcpf(1.f + __expf(-a)) * b; }
                int w0 = __builtin_amdgcn_cvt_pk_fp8_f32(h[0], h[1], 0, false); w0 = __builtin_amdgcn_cvt_pk_fp8_f32(h[2], h[3], w0, true);
                int w1 = __builtin_amdgcn_cvt_pk_fp8_f32(h[4], h[5], 0, false); w1 = __builtin_amdgcn_cvt_pk_fp8_f32(h[6], h[7], w1, true);
                u32x2 w; w.x = (unsigned)w0; w.y = (unsigned)w1;
                *(u32x2*)(O + (size_t)(row0 + ai * HALF + m * 16) * 1536 + col0) = w; }
    }
};
struct EpiGate {
    static constexpr bool PERM = true;
    bf16_t* O; const float* gate;
    __device__ __forceinline__ void operator()(const f32x4 (&acc)[2][2][4][2], const Unit& u, int wr, int wc, int fr, int fq) const {
        const int row0 = u.pm * BM + wr * 64 + fr, col0 = u.pn * BM + wc * 32 + 8 * fq;
#pragma unroll
        for (int ai = 0; ai < 2; ++ai)
#pragma unroll
            for (int m = 0; m < 4; ++m) { const int row = row0 + ai * HALF + m * 16; const float gt = gate[row]; bf16_t* rowp = O + (size_t)row * 2048 + col0;
#pragma unroll
                for (int bj = 0; bj < 2; ++bj) { const f32x4 v0 = acc[ai][bj][m][0] * gt, v1 = acc[ai][bj][m][1] * gt;
                    u32x4 w; w.x = cvt_pk_bf16(v0[0], v0[1]); w.y = cvt_pk_bf16(v0[2], v0[3]); w.z = cvt_pk_bf16(v1[0], v1[1]); w.w = cvt_pk_bf16(v1[2], v1[3]);
                    *(u32x4*)(rowp + bj * HALF) = w; } }
    }
};
}
namespace attn {
constexpr int NW = 8, QBLK = 32, KVBLK = 64, DV = 128;
#define SBAR() __builtin_amdgcn_sched_barrier(0)
__device__ __forceinline__ int crow(int r, int hi) { return (r & 3) + 8 * (r >> 2) + 4 * hi; }
template <int DQK> __device__ __forceinline__ int kswz(int row, int colB) {
    if constexpr (DQK == 128) return row * 256 + (colB ^ ((row & 15) << 4));
    else return row * (DQK * 2) + (colB ^ (((row >> 1) & 7) << 4));
}
template <int DQK> struct Shm { static constexpr int V = KVBLK * DV * 2, K = KVBLK * DQK * 2, TOTAL = 3 * V + 3 * K + NW * 64 * 4; };

template <float const& CREF> struct Dummy {};
__device__ __forceinline__ void partialSM(f32x16& p0, f32x16& p1, float& m_reg, float& mn, float& alpha, const float C, const float thr) {
  float pmax = p0[0];
#pragma unroll
  for (int r = 1; r < 16; ++r) pmax = fmaxf(pmax, p0[r]);
#pragma unroll
  for (int r = 0; r < 16; ++r) pmax = fmaxf(pmax, p1[r]);
  { auto rr = __builtin_amdgcn_permlane32_swap(__float_as_uint(pmax), __float_as_uint(pmax), false, false);
    pmax = fmaxf(__uint_as_float(rr[0]), __uint_as_float(rr[1])); }
  if (__builtin_expect(__all(pmax - m_reg <= thr), 1)) { mn = m_reg; alpha = 1.f; }
  else { mn = fmaxf(m_reg, pmax); alpha = __builtin_amdgcn_exp2f((m_reg - mn) * C); m_reg = mn; }
  float mnC = -mn * C;
#pragma unroll
  for (int r = 0; r < 16; ++r) p0[r] = fmaf(p0[r], C, mnC);
#pragma unroll
  for (int r = 0; r < 16; ++r) p1[r] = fmaf(p1[r], C, mnC);
#pragma unroll
  for (int r = 0; r < 16; ++r) p0[r] = __builtin_amdgcn_exp2f(p0[r]);
}
__device__ __forceinline__ void finishSM(f32x16& p0, f32x16& p1, float alpha, float& l_reg, bf16x8& pa0, bf16x8& pa1, bf16x8& pa2, bf16x8& pa3) {
#pragma unroll
  for (int r = 0; r < 16; ++r) p1[r] = __builtin_amdgcn_exp2f(p1[r]);
  float ps = 0;
#pragma unroll
  for (int r = 0; r < 16; ++r) ps += p0[r];
#pragma unroll
  for (int r = 0; r < 16; ++r) ps += p1[r];
  { auto rr = __builtin_amdgcn_permlane32_swap(__float_as_uint(ps), __float_as_uint(ps), false, false);
    ps = __uint_as_float(rr[0]) + __uint_as_float(rr[1]); }
  l_reg = l_reg * alpha + ps;
#define PK4(P, BASE, OUT) do { unsigned a0 = cvt_pk_bf16(P[BASE + 0], P[BASE + 1]), a1 = cvt_pk_bf16(P[BASE + 2], P[BASE + 3]);   \
    unsigned b0 = cvt_pk_bf16(P[BASE + 4], P[BASE + 5]), b1 = cvt_pk_bf16(P[BASE + 6], P[BASE + 7]);                              \
    auto r0 = __builtin_amdgcn_permlane32_swap(a0, b0, false, false); auto r1 = __builtin_amdgcn_permlane32_swap(a1, b1, false, false); \
    u32x4 w = {r0[0], r1[0], r0[1], r1[1]}; OUT = *reinterpret_cast<bf16x8*>(&w); } while (0)
  PK4(p0, 0, pa0); PK4(p0, 8, pa1); PK4(p1, 0, pa2); PK4(p1, 8, pa3);
#undef PK4
}
template <int DQK>
__device__ __forceinline__ void qkt(f32x16& p0, f32x16& p1, const char* Ks, const bf16x8* qr, int r32, int hi) {
  p0 = f32x16{}; p1 = f32x16{};
#pragma unroll
  for (int d0 = 0; d0 < DQK / 16; ++d0) { int cb = (d0 * 16 + hi * 8) * 2;
    bf16x8 b0 = *reinterpret_cast<const bf16x8*>(Ks + kswz<DQK>(r32, cb));
    bf16x8 b1 = *reinterpret_cast<const bf16x8*>(Ks + kswz<DQK>(32 + r32, cb));
    p0 = __builtin_amdgcn_mfma_f32_32x32x16_bf16(b0, qr[d0], p0, 0, 0, 0);
    p1 = __builtin_amdgcn_mfma_f32_32x32x16_bf16(b1, qr[d0], p1, 0, 0, 0); }
}
__device__ __forceinline__ int v_st(int k, int c) { const int kk = (k & ~0xC) | ((k & 4) << 1) | ((k & 8) >> 1); return ((kk >> 3) * 4 + (c >> 5)) * 512 + ((kk & 7) * 32 + (c & 31)) * 2; }
__device__ __forceinline__ int v_rd_base(int lane) { return ((lane & 3) << 3) | (((lane >> 2) & 3) << 6) | (((lane >> 4) & 1) << 5) | (((lane >> 5) & 1) << 8); }
constexpr int v_rd_off(int d0, int ks, int half) { return d0 * 512 + ks * 4096 + half * 2048; }
template <int OFF> __device__ __forceinline__ s16x4 tr_read(int vb) {
  s16x4 r; asm volatile("ds_read_b64_tr_b16 %0, %1 offset:%2" : "=&v"(r) : "v"(vb), "i"(OFF) : "memory"); return r;
}
template <int D0> __device__ __forceinline__ void pv_one(f32x16& od, int vb, bf16x8 pa0, bf16x8 pa1, bf16x8 pa2, bf16x8 pa3) {
  const s16x4 l0 = tr_read<v_rd_off(D0, 0, 0)>(vb), h0 = tr_read<v_rd_off(D0, 0, 1)>(vb), l1 = tr_read<v_rd_off(D0, 1, 0)>(vb), h1 = tr_read<v_rd_off(D0, 1, 1)>(vb);
  const s16x4 l2 = tr_read<v_rd_off(D0, 2, 0)>(vb), h2 = tr_read<v_rd_off(D0, 2, 1)>(vb), l3 = tr_read<v_rd_off(D0, 3, 0)>(vb), h3 = tr_read<v_rd_off(D0, 3, 1)>(vb);
  asm volatile("s_waitcnt lgkmcnt(0)" ::: "memory"); SBAR();
#define PK(L, H) (bf16x8){L[0], L[1], L[2], L[3], H[0], H[1], H[2], H[3]}
  od = __builtin_amdgcn_mfma_f32_32x32x16_bf16(pa0, PK(l0, h0), od, 0, 0, 0);
  od = __builtin_amdgcn_mfma_f32_32x32x16_bf16(pa1, PK(l1, h1), od, 0, 0, 0);
  od = __builtin_amdgcn_mfma_f32_32x32x16_bf16(pa2, PK(l2, h2), od, 0, 0, 0);
  od = __builtin_amdgcn_mfma_f32_32x32x16_bf16(pa3, PK(l3, h3), od, 0, 0, 0);
#undef PK
}
__device__ __forceinline__ void pv_d0(f32x16* o, int vb, bf16x8 pa0, bf16x8 pa1, bf16x8 pa2, bf16x8 pa3) {
  pv_one<0>(o[0], vb, pa0, pa1, pa2, pa3); pv_one<1>(o[1], vb, pa0, pa1, pa2, pa3); pv_one<2>(o[2], vb, pa0, pa1, pa2, pa3); pv_one<3>(o[3], vb, pa0, pa1, pa2, pa3);
}

__device__ __forceinline__ void glds16(const void* gsrc, unsigned lds_dst) { unsigned keep;
  asm volatile("s_mov_b32 %0, m0\n\ts_mov_b32 m0, %2\n\ts_nop 0\n\tglobal_load_lds_dwordx4 %1, off\n\ts_mov_b32 m0, %0" : "=&s"(keep) : "v"(gsrc), "s"(lds_dst) : "memory"); }
#define ATT_WAIT_BAR(N) asm volatile("s_waitcnt vmcnt(" #N ") lgkmcnt(0)\n\ts_barrier" ::: "memory")
__device__ __forceinline__ int nx3(int s) { return s == 2 ? 0 : s + 1; }
template <int DQK, int LDQ, int LDK, int LDV, int LDO>
__device__ __forceinline__ void attn_unit(const bf16_t* __restrict__ Qb, const bf16_t* __restrict__ Kh, const bf16_t* __restrict__ Vh, unsigned char* __restrict__ Ob, int seq, char* lds) {
  constexpr float scale = (DQK == 128) ? 0.08838834764831845f : 0.07216878364870323f;
  constexpr int SHM_V = KVBLK * DV * 2, SHM_K = KVBLK * DQK * 2, NQ = DQK / 16, NKP = SHM_K / 8192;
  constexpr int KRING = 0, VRING = 3 * SHM_K, WSOFF = 3 * SHM_K + 3 * SHM_V;
  constexpr float C = scale * 1.4426950408889634f, thr = 8.f / scale;
  int tid_ = threadIdx.x; asm volatile("" : "+v"(tid_));
  const int tid = tid_, lane = tid & 63, r32 = lane & 31, hi = lane >> 5; const int wid = __builtin_amdgcn_readfirstlane(tid >> 6);
  const unsigned lds0 = (unsigned)(uintptr_t)lds;
  float* ws = (float*)(lds + WSOFF) + wid * 64; float* li_l = ws; float* al_l = ws + 32;
  float m_reg = -1e30f, l_reg = 0; f32x16 o[4] = {}; bf16x8 qr[NQ];
  const bf16_t* Qw = Qb + (long)(wid * QBLK + r32) * LDQ + hi * 8;
#pragma unroll
  for (int d0 = 0; d0 < NQ; ++d0) qr[d0] = *reinterpret_cast<const bf16x8*>(Qw + d0 * 16);
  int koff[NKP], voff[2];
#pragma unroll
  for (int p = 0; p < NKP; ++p) { const int P = (p * 8 + wid) * 1024 + lane * 16, row = P / (DQK * 2), cs = P % (DQK * 2);
    const int colB = (DQK == 128) ? (cs ^ ((row & 15) << 4)) : (cs ^ (((row >> 1) & 7) << 4)); koff[p] = row * LDK + (colB >> 1); }
#pragma unroll
  for (int p = 0; p < 2; ++p) { const int P = (p * 8 + wid) * 1024 + lane * 16, sub = P >> 9, w5 = P & 511, kk = (sub >> 2) * 8 + (w5 >> 6), c = (sub & 3) * 32 + ((w5 & 63) >> 1);
    const int k = (kk & ~0xC) | ((kk & 4) << 1) | ((kk & 8) >> 1); voff[p] = k * LDV + c; }
#define DMA_K(t, slot) do { _Pragma("unroll") for (int p = 0; p < NKP; ++p) glds16(Kh + (long)(t) * KVBLK * LDK + koff[p], (unsigned)__builtin_amdgcn_readfirstlane((int)(lds0 + KRING + (slot) * SHM_K + (p * 8 + wid) * 1024))); } while (0)
#define DMA_V(t, slot) do { _Pragma("unroll") for (int p = 0; p < 2; ++p) glds16(Vh + (long)(t) * KVBLK * LDV + voff[p], (unsigned)__builtin_amdgcn_readfirstlane((int)(lds0 + VRING + (slot) * SHM_V + (p * 8 + wid) * 1024))); } while (0)
#define RESC(a) do { if (__any((a) < 1.f)) { if (hi == 0) al_l[r32] = (a); asm volatile("s_waitcnt lgkmcnt(0)" ::: "memory"); \
    _Pragma("unroll") for (int d = 0; d < 4; ++d) _Pragma("unroll") for (int r = 0; r < 16; ++r) o[d][r] *= al_l[crow(r, hi)]; } } while (0)
#define CLOSE(t) do { if ((t) + 2 < NT) { if constexpr (NKP == 2) ATT_WAIT_BAR(4); else ATT_WAIT_BAR(5); } else ATT_WAIT_BAR(0); } while (0)
  const int vb0 = (int)(lds0 + VRING) + v_rd_base(lane);
  const char* Kr = lds + KRING;
  f32x16 pA0, pA1, pB0, pB1; float mnA, mnB, alA, alB; bf16x8 pa0, pa1, pa2, pa3; const int NT = seq / KVBLK;
  DMA_K(0, 0); DMA_V(0, 0); DMA_K(1, 1);
  if constexpr (NKP == 2) ATT_WAIT_BAR(2); else ATT_WAIT_BAR(3);
  DMA_K(2, 2); DMA_V(1, 1);
  qkt<DQK>(pA0, pA1, Kr, qr, r32, hi); partialSM(pA0, pA1, m_reg, mnA, alA, C, thr);
  CLOSE(0);
  int sk = 1;
  for (int j = 1; j + 1 < NT; j += 2) {
    { const int s1 = nx3(sk), s2 = nx3(s1);
      if (j + 2 < NT) DMA_K(j + 2, s2); DMA_V(j + 1, s1);
      SBAR(); qkt<DQK>(pB0, pB1, Kr + sk * SHM_K, qr, r32, hi);
      finishSM(pA0, pA1, alA, l_reg, pa0, pa1, pa2, pa3); SBAR();
      pv_d0(o, vb0 + s2 * SHM_V, pa0, pa1, pa2, pa3); partialSM(pB0, pB1, m_reg, mnB, alB, C, thr);
      RESC(alB); CLOSE(j); sk = s1; }
    { const int s1 = nx3(sk), s2 = nx3(s1);
      if (j + 3 < NT) DMA_K(j + 3, s2); if (j + 2 < NT) DMA_V(j + 2, s1);
      SBAR(); qkt<DQK>(pA0, pA1, Kr + sk * SHM_K, qr, r32, hi);
      finishSM(pB0, pB1, alB, l_reg, pa0, pa1, pa2, pa3); SBAR();
      pv_d0(o, vb0 + s2 * SHM_V, pa0, pa1, pa2, pa3); partialSM(pA0, pA1, m_reg, mnA, alA, C, thr);
      RESC(alA); CLOSE(j + 1); sk = s1; }
  }
  { const int s1 = nx3(sk), s2 = nx3(s1);
    SBAR(); qkt<DQK>(pB0, pB1, Kr + sk * SHM_K, qr, r32, hi);
    finishSM(pA0, pA1, alA, l_reg, pa0, pa1, pa2, pa3); SBAR();
    pv_d0(o, vb0 + s2 * SHM_V, pa0, pa1, pa2, pa3); partialSM(pB0, pB1, m_reg, mnB, alB, C, thr);
    RESC(alB);
    finishSM(pB0, pB1, alB, l_reg, pa0, pa1, pa2, pa3); SBAR();
    pv_d0(o, vb0 + sk * SHM_V, pa0, pa1, pa2, pa3); (void)s1; }
  if (hi == 0) li_l[r32] = l_reg; asm volatile("s_waitcnt lgkmcnt(0)" ::: "memory");
  float rli[16];
#pragma unroll
  for (int r = 0; r < 16; ++r) rli[r] = __builtin_amdgcn_rcpf(li_l[crow(r, hi)]);
  unsigned char* Ow = Ob + (long)(wid * QBLK) * LDO;
#pragma unroll
  for (int r = 0; r < 16; ++r) { int orow = crow(r, hi); const float sc = rli[r] * 32.f;
#pragma unroll
    for (int d0 = 0; d0 < 4; ++d0) { const float v = o[d0][r] * sc; Ow[(long)orow * LDO + d0 * 32 + r32] = (unsigned char)__builtin_amdgcn_cvt_pk_fp8_f32(v, v, 0, false); } }
  ATT_WAIT_BAR(0);
#undef DMA_K
#undef DMA_V
#undef RESC
#undef CLOSE
}
}
constexpr int BATCH = 4, SEQ = 4096, DM = 2048, M = BATCH * SEQ, DEPTH = 4;
constexpr int NEXP = 16, FF = 1536, CAP = 512, MX = NEXP * BATCH * CAP;
constexpr int HW = 4096;
constexpr int C_CQ = 0, C_CKV = 512, C_GQ = 768, C_GK = 1280, C_GV = 1792, C_GR = 2816, C_KR = 3840, C_LAT = 3904;
constexpr float LN_EPS = 1e-5f, RMS_EPS = 1e-6f;
constexpr float DN_ALPHA = 1.681792830507429f;
constexpr float MLA_SCALE = 0.07216878364870323f;
constexpr float GQA_SCALE = 0.08838834764831845f;

constexpr size_t MiB = 1u << 20;
constexpr size_t WS_CTL = 0, CTL_ZERO_BYTES = 1 * MiB;
constexpr size_t WS_ROPER = 1 * MiB, WS_ROPEG = 2 * MiB, WS_AFF = 4 * MiB, WS_IDX = 5 * MiB, WS_GATE = 5 * MiB + 512 * 1024, WS_SLOT = 6 * MiB, WS_DECAY = 7 * MiB;
constexpr size_t WS_WIN = 8 * MiB, WS_WUQ = 40 * MiB, WS_WUKV = 43 * MiB, WS_WMO = 48 * MiB, WS_WQKV = 64 * MiB, WS_WGO = 88 * MiB, WS_W13 = 104 * MiB, WS_W2 = 872 * MiB;
constexpr size_t WS_XB = 1256 * MiB, WS_X1 = 1320 * MiB, WS_X1B = 1448 * MiB, WS_H = 1512 * MiB, WS_QM = 1640 * MiB, WS_KM = 1688 * MiB, WS_VM = 1736 * MiB, WS_OCAT = 1768 * MiB;
constexpr size_t WS_QIN = 1832 * MiB, WS_KIN = 1864 * MiB, WS_KST = 1896 * MiB, WS_VT = 1928 * MiB, WS_OF = 1960 * MiB, WS_OB = 2024 * MiB, WS_HDN = 2088 * MiB, WS_Y = 2184 * MiB, WS_END = 2312 * MiB;
constexpr int CW_TMO = 0, CW_DBG = 2, CW_BAR = 4096;

constexpr int RING_BYTES = 131072, MISC_OFF = RING_BYTES + 320, LDS_BYTES = 147456;
constexpr int NWAVES = 8, NTHR = 512;

#define RLX_AGENT __ATOMIC_RELAXED, __HIP_MEMORY_SCOPE_AGENT
#define LDS_WAIT() asm volatile("s_waitcnt lgkmcnt(0)" ::: "memory")
#define VM_WAIT() asm volatile("s_waitcnt vmcnt(0)" ::: "memory")

#define XB_TMO      128
#define XB_XCNT(j)  (256  + 64 * (j))
#define XB_XSUB(j)  (1280 + 64 * (j))
#define XB_XGEN(j)  (2304 + 64 * (j))
#define XB_TOP      3328
#define XB_TOPGEN   3392
#define XCD_BAR_WORDS 3456
#define XB_SPIN_CAP (1u << 22)
__device__ __forceinline__ unsigned xb_ld(unsigned* p)              { return __hip_atomic_load(p, __ATOMIC_RELAXED, __HIP_MEMORY_SCOPE_AGENT); }
__device__ __forceinline__ unsigned xb_add(unsigned* p, unsigned v) { return __hip_atomic_fetch_add(p, v, __ATOMIC_RELAXED, __HIP_MEMORY_SCOPE_AGENT); }
__device__ __forceinline__ unsigned xb_xcc_id() { return (unsigned)__builtin_amdgcn_s_getreg((3 << 11) | 20) & 0xFu; }
#define XB_SPIN(cond, bar) do { unsigned _sp = 0; while (cond) { __builtin_amdgcn_s_sleep(1); \
    if ((++_sp & 255u) == 0u) { if (xb_ld(&(bar)[XB_TMO])) break; if (_sp > XB_SPIN_CAP) { atomicAdd(&(bar)[XB_TMO], 1u); break; } } } } while (0)
struct XcdBarrier { unsigned* bar; unsigned x; volatile LAS unsigned* st; };
__device__ __forceinline__ XcdBarrier xcd_barrier_post(unsigned* bar, volatile LAS unsigned* st) {
    XcdBarrier b; b.bar = bar; b.x = xb_xcc_id(); b.st = st;
    if (threadIdx.x == 0) (void)xb_add(&bar[XB_XCNT(b.x)], 1u);
    return b;
}
__device__ __forceinline__ void xcd_barrier_complete(unsigned* bar, unsigned x, unsigned& nloc, unsigned& nx) {
    const unsigned G = gridDim.x * gridDim.y * gridDim.z;
    unsigned sum, cnt, mine, sp = 0u;
    for (;;) {
        sum = 0u; cnt = 0u; mine = 0u;
#pragma unroll
        for (unsigned j = 0; j < 16; ++j) { const unsigned c = xb_ld(&bar[XB_XCNT(j)]); sum += c; cnt += (c > 0u) ? 1u : 0u; mine = (j == x) ? c : mine; }
        if (sum == G) break;
        __builtin_amdgcn_s_sleep(1);
        if ((++sp & 255u) == 0u) { if (xb_ld(&bar[XB_TMO])) break; if (sp > XB_SPIN_CAP) { atomicAdd(&bar[XB_TMO], 1u); break; } }
    }
    nloc = mine > 0u ? mine : 1u; nx = cnt > 0u ? cnt : 1u;
}
__device__ __forceinline__ void xcd_barrier(const XcdBarrier& b) {
    asm volatile("s_waitcnt vmcnt(0)" ::: "memory");
    __syncthreads();
    if (threadIdx.x == 0) {
        unsigned* bar = b.bar;
        __builtin_amdgcn_s_waitcnt(0);
        unsigned nloc = b.st[0], nx = b.st[1];
        if (nloc == 0u) { xcd_barrier_complete(bar, b.x, nloc, nx); b.st[0] = nloc; b.st[1] = nx; }
        const unsigned old = xb_add(&bar[XB_XSUB(b.x)], 1u);
        const unsigned gen = old / nloc;
        if (old + 1u == (gen + 1u) * nloc) {
            __builtin_amdgcn_fence(__ATOMIC_RELEASE, "agent");
            asm volatile("s_waitcnt vmcnt(0)" ::: "memory");
            const unsigned og = xb_add(&bar[XB_TOP], 1u);
            const unsigned tg = og / nx;
            if (og + 1u == (tg + 1u) * nx) xb_add(&bar[XB_TOPGEN], 1u);
            else XB_SPIN(xb_ld(&bar[XB_TOPGEN]) == tg, bar);
            __builtin_amdgcn_fence(__ATOMIC_ACQUIRE, "agent");
            xb_add(&bar[XB_XGEN(b.x)], 1u);
            asm volatile("s_waitcnt vmcnt(0)" ::: "memory");
        } else {
            XB_SPIN(xb_ld(&bar[XB_XGEN(b.x)]) == gen, bar);
            __builtin_amdgcn_fence(__ATOMIC_ACQUIRE, "agent");
            asm volatile("s_waitcnt vmcnt(0)" ::: "memory");
        }
    }
    __syncthreads();
}

template <int CTRL, int ROWMASK> __device__ __forceinline__ float dpp_addf(float x) { return x + __int_as_float(__builtin_amdgcn_update_dpp(0, __float_as_int(x), CTRL, ROWMASK, 0xF, true)); }
template <int CTRL, int ROWMASK> __device__ __forceinline__ int dpp_addi(int x) { return x + __builtin_amdgcn_update_dpp(0, x, CTRL, ROWMASK, 0xF, true); }
__device__ __forceinline__ float row16_sum(float v) { v = dpp_addf<0xB1, 0xF>(v); v = dpp_addf<0x4E, 0xF>(v); v = dpp_addf<0x141, 0xF>(v); v = dpp_addf<0x140, 0xF>(v); return v; }
__device__ __forceinline__ float wave_sum(float v) {
    v = row16_sum(v); v = dpp_addf<0x142, 0xA>(v); v = dpp_addf<0x143, 0xC>(v);
    return __int_as_float(__builtin_amdgcn_readlane(__float_as_int(v), 63));
}
__device__ __forceinline__ int wave_sum_i(int v) {
    v = dpp_addi<0xB1, 0xF>(v); v = dpp_addi<0x4E, 0xF>(v); v = dpp_addi<0x141, 0xF>(v); v = dpp_addi<0x140, 0xF>(v); v = dpp_addi<0x142, 0xA>(v); v = dpp_addi<0x143, 0xC>(v);
    return __builtin_amdgcn_readlane(v, 63);
}
#define WG_BAR() do { asm volatile("s_waitcnt lgkmcnt(0)" ::: "memory"); __builtin_amdgcn_s_barrier(); asm volatile("" ::: "memory"); } while (0)

struct Ctx { LAS unsigned char* lds; int tid, lane, wave, vcu, G; };
__device__ __forceinline__ Ctx opaque_ctx(const Ctx& c) { Ctx d = c; asm volatile("" : "+v"(d.tid)); d.lane = d.tid & 63; d.wave = __builtin_amdgcn_readfirstlane(d.tid >> 6); return d; }

__device__ __forceinline__ void transpose_item(const float* W, int K, int N, bf16_t* WT, int dst_row0, int k0, int n0, LAS unsigned* scr, int lane) {
    const int r2 = lane >> 4, c4 = lane & 15; const bool ok = (n0 + 4 * c4) < N;
    const float* src = W + (size_t)(k0 + 2 * r2) * N + n0 + 4 * c4;
#pragma unroll
    for (int i = 0; i < 8; ++i) { f32x4 a = {0.f, 0.f, 0.f, 0.f}, b = {0.f, 0.f, 0.f, 0.f};
        if (ok) { a = __builtin_nontemporal_load((const f32x4*)(src + (size_t)(8 * i) * N)); b = __builtin_nontemporal_load((const f32x4*)(src + (size_t)(8 * i + 1) * N)); }
        const int p = 4 * i + r2;
#pragma unroll
        for (int j = 0; j < 4; ++j) scr[(4 * c4 + j) * 33 + p] = cvt_pk_bf16(a[j], b[j]); }
    LDS_WAIT(); asm volatile("" ::: "memory");
    const int nvalid = (N - n0) < 64 ? (N - n0) : 64;
#pragma unroll
    for (int q = 0; q < 8; ++q) { const int ci = lane + 64 * q, n = ci >> 3, ch = ci & 7; const LAS unsigned* s = scr + n * 33 + ch * 4;
        const u32x4 o = {s[0], s[1], s[2], s[3]};
        if (n < nvalid) __builtin_nontemporal_store(o, (u32x4*)(WT + (size_t)(dst_row0 + n) * K + k0 + 8 * ch)); }
    LDS_WAIT(); asm volatile("" ::: "memory");
}
__device__ __forceinline__ int map_row(int map, int n0) {
    if (map == 1) return (n0 < 768) ? n0 : (n0 < 832 ? n0 + 3072 : (n0 < 3904 ? n0 - 64 : n0));
    if (map == 2) return (n0 >> 7) * 256 + (n0 & 127);
    if (map == 3) return (n0 >> 7) * 256 + 128 + (n0 & 127);
    return n0;
}
__device__ __forceinline__ void transpose_batch(const Ctx& c, const float* src, bf16_t* dst, int K, int N, int nmat, size_t src_ms, size_t dst_ms, int map, int wg_rank = -1, int wg_count = 0) {
    LAS unsigned* scr = (LAS unsigned*)(c.lds + c.wave * 16384);
    const int gw = (wg_rank < 0 ? c.vcu : wg_rank) * NWAVES + c.wave, NGW = (wg_rank < 0 ? c.G : wg_count) * NWAVES;
    const int nblk = (N + 63) / 64, per = (K / 64) * nblk; const long total = (long)per * nmat;
    for (long it = gw; it < total; it += NGW) {
        const int mat = (int)(it / per), r = (int)(it % per), kb = r / nblk, nb = r % nblk;
        transpose_item(src + (size_t)mat * src_ms, K, N, dst + (size_t)mat * dst_ms, map_row(map, nb * 64), kb * 64, nb * 64, scr, c.lane);
    }
}

__device__ __forceinline__ void transpose_item_f8(const float* W, int K, int N, unsigned char* WT, int dst_row0, int k0, int n0, float mul, LAS unsigned* scr, int lane) {
    const int r2 = lane >> 4, c4 = lane & 15;
    const float* src = W + (size_t)(k0 + 4 * r2) * N + n0 + 4 * c4;
#pragma unroll
    for (int i = 0; i < 4; ++i) { const float* s_ = src + (size_t)(16 * i) * N;
        const f32x4 a = __builtin_nontemporal_load((const f32x4*)s_), b = __builtin_nontemporal_load((const f32x4*)(s_ + N)), cc = __builtin_nontemporal_load((const f32x4*)(s_ + 2 * (size_t)N)), d = __builtin_nontemporal_load((const f32x4*)(s_ + 3 * (size_t)N));
        const int p = 4 * i + r2;
#pragma unroll
        for (int j = 0; j < 4; ++j) { int w = __builtin_amdgcn_cvt_pk_fp8_f32(a[j] * mul, b[j] * mul, 0, false); w = __builtin_amdgcn_cvt_pk_fp8_f32(cc[j] * mul, d[j] * mul, w, true); scr[(4 * c4 + j) * 17 + p] = (unsigned)w; } }
    LDS_WAIT(); asm volatile("" ::: "memory");
#pragma unroll
    for (int q = 0; q < 4; ++q) { const int ci = lane + 64 * q, n = ci >> 2, ch = ci & 3; const LAS unsigned* s = scr + n * 17 + ch * 4;
        const u32x4 o = {s[0], s[1], s[2], s[3]};
        __builtin_nontemporal_store(o, (u32x4*)(WT + (size_t)(dst_row0 + n) * K + k0 + 16 * ch)); }
    LDS_WAIT(); asm volatile("" ::: "memory");
}
__device__ __forceinline__ void transpose_batch_f8(const Ctx& c, const float* src, unsigned char* dst, int K, int N, int nmat, size_t src_ms, size_t dst_ms, int map, float mul, int wg_rank = -1, int wg_count = 0, int ksplit = 1 << 30, float mul_hi = 0.f) {
    LAS unsigned* scr = (LAS unsigned*)(c.lds + c.wave * 16384);
    const int gw = (wg_rank < 0 ? c.vcu : wg_rank) * NWAVES + c.wave, NGW = (wg_rank < 0 ? c.G : wg_count) * NWAVES;
    const int nblk = N / 64, per = (K / 64) * nblk; const long total = (long)per * nmat;
    for (long it = gw; it < total; it += NGW) {
        const int mat = (int)(it / per), r = (int)(it % per), kb = r / nblk, nb = r % nblk;
        transpose_item_f8(src + (size_t)mat * src_ms, K, N, dst + (size_t)mat * dst_ms, map_row(map, nb * 64), kb * 64, nb * 64, (kb * 64 >= ksplit) ? mul_hi : mul, scr, c.lane);
    }
}

__device__ __forceinline__ void fill_rope(const Ctx& c, f32x2* tabR, f32x2* tabG) {
    const int gt = (c.vcu * NTHR + c.tid), NT = c.G * NTHR;
    for (int i = gt; i < SEQ * 32; i += NT) { const int t = i >> 5, p = i & 31, j = p & 15; const float inv = exp2f(-(float)(2 * j) * (13.287712379549449f / 32.f));
        const float pos = (float)(p < 16 ? (t >> 6) : (t & 63)); const float a = pos * inv; tabR[i] = (f32x2){cosf(a), sinf(a)}; }
    for (int i = gt; i < SEQ * 64; i += NT) { const int t = i >> 6, p = i & 63, j = p & 31; const float inv = exp2f(-(float)(2 * j) * (13.287712379549449f / 64.f));
        const float pos = (float)(p < 32 ? (t >> 6) : (t & 63)); const float a = pos * inv; tabG[i] = (f32x2){cosf(a), sinf(a)}; }
}
__device__ __forceinline__ void cvt_rows_bf16(const Ctx& c, const float* x, bf16_t* xb) {
    const long gt = (long)c.vcu * NTHR + c.tid, NT = (long)c.G * NTHR, n8 = (long)M * DM / 8;
    for (long i = gt; i < n8; i += NT) { const f32x4 a = *(const f32x4*)(x + i * 8), b = *(const f32x4*)(x + i * 8 + 4);
        u32x4 w; w.x = cvt_pk_bf16(a[0], a[1]); w.y = cvt_pk_bf16(a[2], a[3]); w.z = cvt_pk_bf16(b[0], b[1]); w.w = cvt_pk_bf16(b[2], b[3]); *(u32x4*)(xb + i * 8) = w; }
}

__device__ __forceinline__ void mla_prep_rows(const Ctx& c, bf16_t* H, bf16_t* Hd, bf16_t* Km, const float* qn, const float* kvn, const f32x2* tabR) {
    const int gw = c.vcu * NWAVES + c.wave, NGW = c.G * NWAVES, lane = c.lane;
    for (int r = gw; r < M; r += NGW) {
        bf16_t* h = H + (size_t)r * HW; bf16_t* hd = Hd + (size_t)r * HW;
        { u32x4 w = *(const u32x4*)(h + C_CQ + lane * 8); float f[8] = {bf_lo(w.x), bf_hi(w.x), bf_lo(w.y), bf_hi(w.y), bf_lo(w.z), bf_hi(w.z), bf_lo(w.w), bf_hi(w.w)};
          float s = 0.f;
#pragma unroll
          for (int i = 0; i < 8; ++i) s += f[i] * f[i];
          const float rs = rsqrtf(wave_sum(s) * (1.f / 512.f) + RMS_EPS);
          const f32x4 g0 = *(const f32x4*)(qn + lane * 8), g1 = *(const f32x4*)(qn + lane * 8 + 4);
          u32x4 o; o.x = cvt_pk_bf16(f[0] * rs * g0[0], f[1] * rs * g0[1]); o.y = cvt_pk_bf16(f[2] * rs * g0[2], f[3] * rs * g0[3]);
          o.z = cvt_pk_bf16(f[4] * rs * g1[0], f[5] * rs * g1[1]); o.w = cvt_pk_bf16(f[6] * rs * g1[2], f[7] * rs * g1[3]);
          *(u32x4*)(hd + C_CQ + lane * 8) = o; }
        { u32x2 w = *(const u32x2*)(h + C_CKV + lane * 4); float f[4] = {bf_lo(w.x), bf_hi(w.x), bf_lo(w.y), bf_hi(w.y)};
          const float s = f[0] * f[0] + f[1] * f[1] + f[2] * f[2] + f[3] * f[3];
          const float rs = rsqrtf(wave_sum(s) * (1.f / 256.f) + RMS_EPS);
          const f32x4 g0 = *(const f32x4*)(kvn + lane * 4);
          u32x2 o; o.x = cvt_pk_bf16(f[0] * rs * g0[0], f[1] * rs * g0[1]); o.y = cvt_pk_bf16(f[2] * rs * g0[2], f[3] * rs * g0[3]);
          *(u32x2*)(hd + C_CKV + lane * 4) = o; }
        if (lane < 32) { const unsigned w = *(const unsigned*)(h + C_KR + 2 * lane); const float x1 = bf_lo(w), x2 = bf_hi(w); const f32x2 cs = tabR[(size_t)(r & (SEQ - 1)) * 32 + lane];
          const unsigned o = cvt_pk_bf16(x1 * cs.x - x2 * cs.y, x1 * cs.y + x2 * cs.x);
#pragma unroll
          for (int hh = 0; hh < 8; ++hh) *(unsigned*)(Km + (size_t)r * 1536 + hh * 192 + 128 + 2 * lane) = o; }
    }
}

__device__ __forceinline__ float log_sigmoid(float z) { const float e = __expf(-fabsf(z)); return fminf(z, 0.f) - __logf(1.f + e); }
constexpr int GREC_QT = 0, GREC_AT = 16384, GREC_KT = 24576, GREC_DT = 40960, GREC_BYTES = 41984;
__device__ __forceinline__ void gla_prep(const Ctx& c, const bf16_t* H, const float* w2  , const float* gb  , unsigned char* rec, bf16_t* vT) {
    constexpr int TP = 66, QP = 136;
    LAS float* cum = (LAS float*)c.lds;
    LAS bf16_t* vt_l = (LAS bf16_t*)c.lds;
    LAS bf16_t* kst_l = (LAS bf16_t*)(c.lds + 32768);
    LAS bf16_t* Ql = (LAS bf16_t*)(c.lds + 49664);
    LAS bf16_t* Kl = (LAS bf16_t*)(c.lds + 67072);
    LAS float* tot = (LAS float*)(c.lds + 84480);
    LAS bf16_t* qg = (LAS bf16_t*)(c.lds + 86528);
    LAS bf16_t* kg = (LAS bf16_t*)(c.lds + 102912);
    LAS bf16_t* latl = (LAS bf16_t*)(c.lds + 119296);
    const int tid = c.tid, qtr = tid >> 7, dk = tid & 127, lane = c.lane, w = c.wave, fr = lane & 15, fq = lane >> 4;
    for (int item = c.vcu; item < BATCH * 64 * 4; item += c.G) {
        const int hh = item & 3, bc = item >> 2;
        const size_t row0 = (size_t)bc * 64;
        const int col = hh * 128 + dk;
        u32x4 qv[2], kv[2], vv[4], lv;
#pragma unroll
        for (int q2 = 0; q2 < 2; ++q2) { const int ci = tid + 512 * q2, t = ci >> 4, ch = ci & 15; const bf16_t* hp = H + (row0 + t) * HW + hh * 128 + ch * 8;
            qv[q2] = *(const u32x4*)(hp + C_GQ); kv[q2] = *(const u32x4*)(hp + C_GK); }
#pragma unroll
        for (int q4 = 0; q4 < 4; ++q4) { const int ci = tid + 512 * q4, t = ci >> 5, ch = ci & 31; vv[q4] = *(const u32x4*)(H + (row0 + t) * HW + C_GV + hh * 256 + ch * 8); }
        if (tid < 256) lv = *(const u32x4*)(H + (row0 + (tid >> 2)) * HW + C_LAT + (tid & 3) * 8);
#pragma unroll
        for (int q2 = 0; q2 < 2; ++q2) { const int ci = tid + 512 * q2; *(LAS u32x4*)(qg + ci * 8) = qv[q2]; *(LAS u32x4*)(kg + ci * 8) = kv[q2]; }
        if (tid < 256) *(LAS u32x4*)(latl + tid * 8) = lv;
        WG_BAR();
#pragma nounroll
        for (int dir = 0; dir < 2; ++dir) {
            unsigned char* rp = rec + ((((size_t)dir * 256 + bc) * 4 + hh) * GREC_BYTES);
            float wv[16];
#pragma unroll
            for (int j = 0; j < 16; ++j) wv[j] = w2[(dir * 16 + j) * 512 + col];
            const float bias = gb[dir * 512 + col];
            float run = 0.f;
#pragma unroll 4
            for (int i = 0; i < 16; ++i) { const int t = qtr * 16 + (dir ? 15 - i : i); const LAS bf16_t* lp = latl + t * 32 + dir * 16;
                const u32x4 a = *(const LAS u32x4*)lp, b = *(const LAS u32x4*)(lp + 8);
                float z = bias;
                z += bf_lo(a.x) * wv[0] + bf_hi(a.x) * wv[1] + bf_lo(a.y) * wv[2] + bf_hi(a.y) * wv[3] + bf_lo(a.z) * wv[4] + bf_hi(a.z) * wv[5] + bf_lo(a.w) * wv[6] + bf_hi(a.w) * wv[7];
                z += bf_lo(b.x) * wv[8] + bf_hi(b.x) * wv[9] + bf_lo(b.y) * wv[10] + bf_hi(b.y) * wv[11] + bf_lo(b.z) * wv[12] + bf_hi(b.z) * wv[13] + bf_lo(b.w) * wv[14] + bf_hi(b.w) * wv[15];
                run += log_sigmoid(z) * (1.f / 16.f); cum[t * 128 + dk] = run; }
            tot[dk * 4 + qtr] = run;
            WG_BAR();
            const f32x4 tq = *(const LAS f32x4*)(tot + dk * 4);
            const float blast = (tq[0] + tq[1]) + (tq[2] + tq[3]);
            float off = 0.f;
#pragma unroll
            for (int q = 0; q < 4; ++q) off += ((dir == 0) ? (q < qtr) : (q > qtr)) ? tq[q] : 0.f;
#pragma unroll 4
            for (int i = 0; i < 16; ++i) { const int t = qtr * 16 + i;
                const float bcum = cum[t * 128 + dk] + off;
                const float q = bf2f(qg[t * 128 + dk]) * 0.08838834764831845f, k = bf2f(kg[t * 128 + dk]);
                const bf16_t qb = f2bf(q * __expf(bcum));
                { const int r5 = dk & 31, chq = 4 * (dk >> 5) + ((r5 & 15) >> 2), e8 = (r5 & 3) + ((r5 >> 4) << 2);
                  *(bf16_t*)(rp + GREC_QT + t * 256 + (((chq ^ (t & 15)) << 4) | (e8 * 2))) = qb; } Ql[t * QP + dk] = qb;
                Kl[t * QP + dk] = f2bf(k * __expf(-bcum));
                kst_l[dk * TP + t] = f2bf(k * __expf(blast - bcum)); }
            if (qtr == 0) *(float*)(rp + GREC_DT + dk * 4) = __expf(blast);
            WG_BAR();
            { const int ib = w >> 1, par = w & 1;
              const LAS bf16_t* qp = Ql + (ib * 16 + fr) * QP + 8 * fq; const LAS bf16_t* kp = Kl + (2 * par * 16 + fr) * QP + 8 * fq;
              f32x4 a0 = {0.f, 0.f, 0.f, 0.f}, a1 = {0.f, 0.f, 0.f, 0.f};
#pragma unroll
              for (int kk = 0; kk < 4; ++kk) { const bf16x8 qf = *(const LAS bf16x8*)(qp + kk * 32), k0 = *(const LAS bf16x8*)(kp + kk * 32), k1 = *(const LAS bf16x8*)(kp + 16 * QP + kk * 32);
                  a0 = __builtin_amdgcn_mfma_f32_16x16x32_bf16(k0, qf, a0, 0, 0, 0); a1 = __builtin_amdgcn_mfma_f32_16x16x32_bf16(k1, qf, a1, 0, 0, 0); }
              const int i = ib * 16 + fr, j0 = 2 * par * 16 + 4 * fq;
#pragma unroll
              for (int r = 0; r < 4; ++r) { const int j = j0 + r; a0[r] = (dir ? (j >= i) : (j <= i)) ? a0[r] : 0.f; a1[r] = (dir ? (j + 16 >= i) : (j + 16 <= i)) ? a1[r] : 0.f; }
              u32x2 w0, w1; w0.x = cvt_pk_bf16(a0[0], a0[1]); w0.y = cvt_pk_bf16(a0[2], a0[3]); w1.x = cvt_pk_bf16(a1[0], a1[1]); w1.y = cvt_pk_bf16(a1[2], a1[3]);
              unsigned char* ap = rp + GREC_AT + i * 128; const int sw = (i >> 1) & 7;
              *(u32x2*)(ap + ((((j0 >> 3) ^ sw) << 4) | ((j0 & 7) * 2))) = w0; *(u32x2*)(ap + (((((j0 + 16) >> 3) ^ sw) << 4) | ((j0 & 7) * 2))) = w1; }
#pragma unroll
            for (int q2 = 0; q2 < 2; ++q2) { const int ci = tid + 512 * q2, rowid = ci >> 3, ch = ci & 7; const LAS unsigned* sp = (const LAS unsigned*)(kst_l + rowid * TP + ch * 8);
                const u32x4 wd = {sp[0], sp[1], sp[2], sp[3]};
                *(u32x4*)(rp + GREC_KT + rowid * 128 + ((ch ^ ((rowid >> 1) & 7)) << 4)) = wd; }
            WG_BAR();
        }
#pragma unroll
        for (int q4 = 0; q4 < 4; ++q4) { const int ci = tid + 512 * q4, t = ci >> 5, d0 = (ci & 31) * 8; const u32x4 x = vv[q4];
            vt_l[(d0 + 0) * TP + t] = (bf16_t)(x.x & 0xffffu); vt_l[(d0 + 1) * TP + t] = (bf16_t)(x.x >> 16); vt_l[(d0 + 2) * TP + t] = (bf16_t)(x.y & 0xffffu); vt_l[(d0 + 3) * TP + t] = (bf16_t)(x.y >> 16);
            vt_l[(d0 + 4) * TP + t] = (bf16_t)(x.z & 0xffffu); vt_l[(d0 + 5) * TP + t] = (bf16_t)(x.z >> 16); vt_l[(d0 + 6) * TP + t] = (bf16_t)(x.w & 0xffffu); vt_l[(d0 + 7) * TP + t] = (bf16_t)(x.w >> 16); }
        WG_BAR();
#pragma unroll
        for (int q4 = 0; q4 < 4; ++q4) { const int ci = tid + 512 * q4, rowid = ci >> 3, ch = ci & 7; const LAS unsigned* sp = (const LAS unsigned*)(vt_l + rowid * TP + ch * 8);
            const u32x4 wd = {sp[0], sp[1], sp[2], sp[3]};
            *(u32x4*)(vT + ((((size_t)bc * 4 + hh) * 256 + rowid) * 64 + ch * 8)) = wd; }
        WG_BAR();
    }
}

namespace pg8 {
struct EpiQKNorm {
    static constexpr bool PERM = true;
    bf16_t* O; const float* qn; const float* kn; const f32x2* tab; LAS float* P;
    __device__ __forceinline__ void operator()(const f32x4 (&acc)[2][2][4][2], const Unit& u, int wr, int wc, int fr, int fq) const {
        const int rl0 = wr * 64 + fr, row0 = u.pm * BM + rl0, colh = wc * 32 + 8 * fq;
        const bool nrm = u.pn < 10;
        float rs[2][4][2];
        if (nrm) {
#pragma unroll
            for (int ai = 0; ai < 2; ++ai)
#pragma unroll
                for (int m = 0; m < 4; ++m)
#pragma unroll
                    for (int bj = 0; bj < 2; ++bj) { const f32x4 v0 = acc[ai][bj][m][0], v1 = acc[ai][bj][m][1];
                        float ss = (v0[0] * v0[0] + v0[1] * v0[1]) + (v0[2] * v0[2] + v0[3] * v0[3]) + (v1[0] * v1[0] + v1[1] * v1[1]) + (v1[2] * v1[2] + v1[3] * v1[3]);
                        ss += __shfl_xor(ss, 16); ss += __shfl_xor(ss, 32);
                        if (fq == 0) P[((rl0 + ai * HALF + m * 16) * 2 + bj) * 4 + wc] = ss; }
            asm volatile("s_waitcnt lgkmcnt(0)\n\ts_barrier" ::: "memory");
#pragma unroll
            for (int ai = 0; ai < 2; ++ai)
#pragma unroll
                for (int m = 0; m < 4; ++m)
#pragma unroll
                    for (int bj = 0; bj < 2; ++bj) { const f32x4 p = *(const LAS f32x4*)(P + ((rl0 + ai * HALF + m * 16) * 2 + bj) * 4); rs[ai][m][bj] = rsqrtf(((p[0] + p[1]) + (p[2] + p[3])) * (1.f / 128.f) + RMS_EPS); }
        }
        const float* gp = (u.pn < 8 ? qn : kn) + colh; f32x4 g0 = {1.f, 1.f, 1.f, 1.f}, g1 = g0; if (nrm) { g0 = *(const f32x4*)gp; g1 = *(const f32x4*)(gp + 4); }
#pragma unroll
        for (int ai = 0; ai < 2; ++ai)
#pragma unroll
            for (int m = 0; m < 4; ++m) { const int row = row0 + ai * HALF + m * 16; bf16_t* rowp = O + (size_t)row * 3072 + u.pn * BM + colh;
                f32x4 t01 = {1.f, 0.f, 1.f, 0.f}, t23 = t01; if (nrm) { const f32x2* tp = tab + (size_t)(row & (SEQ - 1)) * 64 + (colh >> 1); t01 = *(const f32x4*)tp; t23 = *(const f32x4*)(tp + 2); }
#pragma unroll
                for (int bj = 0; bj < 2; ++bj) { const f32x4 v0 = acc[ai][bj][m][0], v1 = acc[ai][bj][m][1]; u32x4 o;
                    if (nrm) { const float r_ = rs[ai][m][bj];
                        const float y0 = v0[0] * r_ * g0[0], y1 = v0[1] * r_ * g0[1], y2 = v0[2] * r_ * g0[2], y3 = v0[3] * r_ * g0[3], y4 = v1[0] * r_ * g1[0], y5 = v1[1] * r_ * g1[1], y6 = v1[2] * r_ * g1[2], y7 = v1[3] * r_ * g1[3];
                        o.x = cvt_pk_bf16(y0 * t01[0] - y1 * t01[1], y0 * t01[1] + y1 * t01[0]); o.y = cvt_pk_bf16(y2 * t01[2] - y3 * t01[3], y2 * t01[3] + y3 * t01[2]);
                        o.z = cvt_pk_bf16(y4 * t23[0] - y5 * t23[1], y4 * t23[1] + y5 * t23[0]); o.w = cvt_pk_bf16(y6 * t23[2] - y7 * t23[3], y6 * t23[3] + y7 * t23[2]); }
                    else { o.x = cvt_pk_bf16(v0[0], v0[1]); o.y = cvt_pk_bf16(v0[2], v0[3]); o.z = cvt_pk_bf16(v1[0], v1[1]); o.w = cvt_pk_bf16(v1[2], v1[3]); }
                    *(u32x4*)(rowp + bj * HALF) = o; } }
    }
};
}
__device__ __forceinline__ void gla_out_rows(const Ctx& c, const bf16_t* of, const bf16_t* ob, const bf16_t* H, const float* gn, unsigned char* Ocat) {
    const int gw = c.vcu * NWAVES + c.wave, NGW = c.G * NWAVES, lane = c.lane;
    for (int r = gw; r < M; r += NGW) {
#pragma unroll
        for (int hh = 0; hh < 4; ++hh) { const int j0 = hh * 256 + lane * 4;
            const u32x2 aw = *(const u32x2*)(of + (size_t)r * 1024 + j0), bw = *(const u32x2*)(ob + (size_t)r * 1024 + j0); const f32x4 s = (f32x4){bf_lo(aw.x), bf_hi(aw.x), bf_lo(aw.y), bf_hi(aw.y)} + (f32x4){bf_lo(bw.x), bf_hi(bw.x), bf_lo(bw.y), bf_hi(bw.y)};
            const float ss = s[0] * s[0] + s[1] * s[1] + s[2] * s[2] + s[3] * s[3];
            const float rs = rsqrtf(wave_sum(ss) * (1.f / 256.f) + RMS_EPS);
            const f32x4 g = *(const f32x4*)(gn + j0); const u32x2 gw2 = *(const u32x2*)(H + (size_t)r * HW + C_GR + j0);
            const float gr[4] = {bf_lo(gw2.x), bf_hi(gw2.x), bf_lo(gw2.y), bf_hi(gw2.y)}; float o[4];
#pragma unroll
            for (int i = 0; i < 4; ++i) { const float sg = gr[i] * __builtin_amdgcn_rcpf(1.f + __expf(-gr[i])); o[i] = s[i] * rs * g[i] * sg; }
            int w = __builtin_amdgcn_cvt_pk_fp8_f32(o[0] * 4.f, o[1] * 4.f, 0, false); w = __builtin_amdgcn_cvt_pk_fp8_f32(o[2] * 4.f, o[3] * 4.f, w, true);
            *(unsigned*)(Ocat + (size_t)r * 2048 + 1024 + j0) = (unsigned)w; }
    }
}

__device__ __forceinline__ void gqa_qknorm_rows(const Ctx& c, bf16_t* H, bf16_t* Hd, const float* qn, const float* kn, const f32x2* tabG) {
    const int gw = c.vcu * NWAVES + c.wave, NGW = c.G * NWAVES, lane = c.lane, l16 = lane & 15, hg = lane >> 4;
    const f32x4 q0 = *(const f32x4*)(qn + l16 * 8), q1 = *(const f32x4*)(qn + l16 * 8 + 4), k0 = *(const f32x4*)(kn + l16 * 8), k1 = *(const f32x4*)(kn + l16 * 8 + 4);
    for (int r = gw; r < M; r += NGW) {
        const bf16_t* h = H + (size_t)r * 3072; bf16_t* hd = Hd + (size_t)r * 3072;
        const f32x2* tp = tabG + (size_t)(r & (SEQ - 1)) * 64 + l16 * 4; const f32x4 t01 = *(const f32x4*)tp, t23 = *(const f32x4*)(tp + 2);
        u32x4 wv[5];
#pragma unroll
        for (int p = 0; p < 5; ++p) wv[p] = *(const u32x4*)(h + (p * 4 + hg) * 128 + l16 * 8);
#pragma unroll
        for (int p = 0; p < 5; ++p) { const u32x4 w = wv[p];
            float f[8] = {bf_lo(w.x), bf_hi(w.x), bf_lo(w.y), bf_hi(w.y), bf_lo(w.z), bf_hi(w.z), bf_lo(w.w), bf_hi(w.w)};
            float ss = 0.f;
#pragma unroll
            for (int i = 0; i < 8; ++i) ss += f[i] * f[i];
            ss = row16_sum(ss);
            const float rs = rsqrtf(ss * (1.f / 128.f) + RMS_EPS);
            const bool isq = (p < 4);
            const f32x4 g0 = isq ? q0 : k0, g1 = isq ? q1 : k1;
            const float y0 = f[0] * rs * g0[0], y1 = f[1] * rs * g0[1], y2 = f[2] * rs * g0[2], y3 = f[3] * rs * g0[3], y4 = f[4] * rs * g1[0], y5 = f[5] * rs * g1[1], y6 = f[6] * rs * g1[2], y7 = f[7] * rs * g1[3];
            u32x4 o; o.x = cvt_pk_bf16(y0 * t01[0] - y1 * t01[1], y0 * t01[1] + y1 * t01[0]); o.y = cvt_pk_bf16(y2 * t01[2] - y3 * t01[3], y2 * t01[3] + y3 * t01[2]);
            o.z = cvt_pk_bf16(y4 * t23[0] - y5 * t23[1], y4 * t23[1] + y5 * t23[0]); o.w = cvt_pk_bf16(y6 * t23[2] - y7 * t23[3], y6 * t23[3] + y7 * t23[2]);
            *(u32x4*)(hd + (p * 4 + hg) * 128 + l16 * 8) = o; }
    }
}

__device__ __forceinline__ void ln_router_rows(const Ctx& c, const bf16_t* Xres, const bf16_t* Mb, bf16_t* X1b, unsigned char* X1f8, const float* g, const float* bb, const float* wr  , float* aff) {
    LAS float* Wl = (LAS float*)c.lds;
#pragma unroll
    for (int it = 0; it < 16; ++it) { const int i = c.tid + it * NTHR; const f32x4 w = *(const f32x4*)(wr + (size_t)i * 4); const int k = i >> 2, e0 = (i & 3) * 4;
        Wl[(e0 + 0) * 2048 + k] = w[0]; Wl[(e0 + 1) * 2048 + k] = w[1]; Wl[(e0 + 2) * 2048 + k] = w[2]; Wl[(e0 + 3) * 2048 + k] = w[3]; }
    WG_BAR();
    const int gw = c.vcu * NWAVES + c.wave, NGW = c.G * NWAVES, lane = c.lane;
    u32x2 xr[2][8];
#define M1_LOAD(r0_) do { const int a0_ = (r0_), a1_ = ((r0_) + NGW < M) ? (r0_) + NGW : (r0_); \
    _Pragma("unroll") for (int j = 0; j < 8; ++j) { xr[0][j] = *(const u32x2*)(Xres + (size_t)a0_ * DM + j * 256 + lane * 4); xr[1][j] = *(const u32x2*)(Xres + (size_t)a1_ * DM + j * 256 + lane * 4); } } while (0)
    if (gw < M) M1_LOAD(gw);
    for (int rr = gw; rr < M; rr += 2 * NGW) {
        const int rw[2] = {rr, (rr + NGW < M) ? rr + NGW : rr};
        f32x4 v[2][8];
#pragma unroll
        for (int q = 0; q < 2; ++q)
#pragma unroll
            for (int j = 0; j < 8; ++j) { const u32x2 mw = *(const u32x2*)(Mb + (size_t)rw[q] * DM + j * 256 + lane * 4);
                v[q][j] = (f32x4){bf_lo(xr[q][j].x), bf_hi(xr[q][j].x), bf_lo(xr[q][j].y), bf_hi(xr[q][j].y)} * DN_ALPHA + (f32x4){bf_lo(mw.x), bf_hi(mw.x), bf_lo(mw.y), bf_hi(mw.y)}; }
        __builtin_amdgcn_sched_barrier(0);
        if (rr + 2 * NGW < M) M1_LOAD(rr + 2 * NGW);
        __builtin_amdgcn_sched_barrier(0);
#pragma unroll
        for (int q = 0; q < 2; ++q) { float s = 0.f;
#pragma unroll
            for (int j = 0; j < 8; ++j) s += (v[q][j][0] + v[q][j][1]) + (v[q][j][2] + v[q][j][3]);
            const float mean = wave_sum(s) * (1.f / DM); float s2 = 0.f;
#pragma unroll
            for (int j = 0; j < 8; ++j) { v[q][j] = v[q][j] - mean; s2 += (v[q][j][0] * v[q][j][0] + v[q][j][1] * v[q][j][1]) + (v[q][j][2] * v[q][j][2] + v[q][j][3] * v[q][j][3]); }
            const float rstd = rsqrtf(wave_sum(s2) * (1.f / DM) + LN_EPS);
#pragma unroll
            for (int j = 0; j < 8; ++j) { const f32x4 gg = *(const f32x4*)(g + j * 256 + lane * 4), b4 = *(const f32x4*)(bb + j * 256 + lane * 4);
                v[q][j] = v[q][j] * rstd * gg + b4;
                if (q == 0 || rw[1] != rw[0]) { u32x2 w; w.x = cvt_pk_bf16(v[q][j][0], v[q][j][1]); w.y = cvt_pk_bf16(v[q][j][2], v[q][j][3]); *(u32x2*)(X1b + (size_t)rw[q] * DM + j * 256 + lane * 4) = w;
                    int w8 = __builtin_amdgcn_cvt_pk_fp8_f32(v[q][j][0], v[q][j][1], 0, false); w8 = __builtin_amdgcn_cvt_pk_fp8_f32(v[q][j][2], v[q][j][3], w8, true); *(int*)(X1f8 + (size_t)rw[q] * DM + j * 256 + lane * 4) = w8; } } }
        float lg[2][16];
#pragma unroll
        for (int e = 0; e < 16; ++e) { f32x2 p0 = {0.f, 0.f}, p1 = {0.f, 0.f};
#pragma unroll
            for (int j = 0; j < 8; ++j) { const f32x4 w = *(const LAS f32x4*)(Wl + e * 2048 + j * 256 + lane * 4); const f32x2 wl = {w[0], w[1]}, wh = {w[2], w[3]};
                p0 = (f32x2){v[0][j][0], v[0][j][1]} * wl + p0; p0 = (f32x2){v[0][j][2], v[0][j][3]} * wh + p0; p1 = (f32x2){v[1][j][0], v[1][j][1]} * wl + p1; p1 = (f32x2){v[1][j][2], v[1][j][3]} * wh + p1; }
            lg[0][e] = wave_sum(p0.x + p0.y); lg[1][e] = wave_sum(p1.x + p1.y); }
#pragma unroll
        for (int q = 0; q < 2; ++q) { float mx = lg[q][0];
#pragma unroll
            for (int e = 1; e < 16; ++e) mx = fmaxf(mx, lg[q][e]);
            float den = 0.f;
#pragma unroll
            for (int e = 0; e < 16; ++e) { lg[q][e] = __expf(lg[q][e] - mx); den += lg[q][e]; }
            const float inv = 1.f / den; float mine = 0.f;
#pragma unroll
            for (int e = 0; e < 16; ++e) mine = (lane == e) ? lg[q][e] * inv : mine;
            if (lane < 16 && (q == 0 || rw[1] != rw[0])) aff[((size_t)(rw[q] >> 12) * 16 + lane) * SEQ + (rw[q] & (SEQ - 1))] = mine; }
    }
#undef M1_LOAD
    WG_BAR();
}

__device__ __forceinline__ void topk_units(const Ctx& c, const float* aff, int* idx, float* gate, unsigned short* slotmap) {
    LAS unsigned* sm = (LAS unsigned*)c.lds;
    const int tid = c.tid, lane = c.lane, wid = c.wave;
    for (int be = c.vcu; be < BATCH * NEXP; be += c.G) {
        const int b = be >> 4, e = be & 15;
        const float* a = aff + (size_t)be * SEQ + tid * 8;
        const u32x4 k0 = *(const u32x4*)a, k1 = *(const u32x4*)(a + 4);
        const unsigned key[8] = {k0.x, k0.y, k0.z, k0.w, k1.x, k1.y, k1.z, k1.w};
        unsigned prefix = 0u; int par = 0;
        for (int bit = 30; bit >= 0; --bit) {
            const unsigned cand = prefix | (1u << bit); int cnt = 0;
#pragma unroll
            for (int i = 0; i < 8; ++i) cnt += (key[i] >= cand) ? 1 : 0;
            cnt = wave_sum_i(cnt);
            if (lane == 0) sm[par * 8 + wid] = (unsigned)cnt;
            WG_BAR();
            unsigned total = 0u;
#pragma unroll
            for (int w = 0; w < 8; ++w) total += sm[par * 8 + w];
            if (total >= (unsigned)CAP) prefix = cand;
            par ^= 1;
        }
        const unsigned T = prefix;
        int cgt = 0, ceq = 0;
#pragma unroll
        for (int i = 0; i < 8; ++i) { cgt += (key[i] > T) ? 1 : 0; ceq += (key[i] == T) ? 1 : 0; }
        unsigned pk = (unsigned)cgt | ((unsigned)ceq << 16), inc = pk;
#pragma unroll
        for (int o = 1; o < 64; o <<= 1) { const unsigned nb = __shfl_up(inc, o); if (lane >= o) inc += nb; }
        if (lane == 63) sm[32 + wid] = inc;
        WG_BAR();
        unsigned wpre = 0u, gtot = 0u;
#pragma unroll
        for (int w = 0; w < 8; ++w) { const unsigned v = sm[32 + w]; if (w < wid) wpre += v; gtot += v; }
        const unsigned ex = wpre + inc - pk;
        int pre_gt = (int)(ex & 0xffffu), pre_eq = (int)(ex >> 16);
        const int need_eq = CAP - (int)(gtot & 0xffffu);
        const size_t obase = ((size_t)e * BATCH + b) * CAP;
#pragma unroll
        for (int i = 0; i < 8; ++i) { const int t = tid * 8 + i; const bool gt = key[i] > T, eq = key[i] == T; const bool sel = gt || (eq && pre_eq < need_eq);
            const int slot = pre_gt + (pre_eq < need_eq ? pre_eq : need_eq);
            if (sel) { idx[obase + slot] = b * SEQ + t; gate[obase + slot] = __uint_as_float(key[i]); }
            slotmap[((size_t)b * SEQ + t) * 16 + e] = sel ? (unsigned short)slot : (unsigned short)0xFFFF;
            pre_gt += gt ? 1 : 0; pre_eq += eq ? 1 : 0; }
        WG_BAR();
    }
}

__device__ __forceinline__ void combine_ln_rows(const Ctx& c, const bf16_t* X1b, const bf16_t* Y, const unsigned short* slotmap, const float* g, const float* bb, float* outf, bf16_t* Xb) {
    const int gw = c.vcu * NWAVES + c.wave, NGW = c.G * NWAVES, lane = c.lane;
    for (int rr = gw; rr < M; rr += 2 * NGW) {
        const int rw[2] = {rr, (rr + NGW < M) ? rr + NGW : rr};
        f32x4 v[2][8]; int slotv[2]; unsigned msk[2];
#pragma unroll
        for (int q = 0; q < 2; ++q) { slotv[q] = (lane < 16) ? (int)slotmap[(size_t)rw[q] * 16 + lane] : 0xFFFF;
#pragma unroll
            for (int j = 0; j < 8; ++j) { const u32x2 xw = *(const u32x2*)(X1b + (size_t)rw[q] * DM + j * 256 + lane * 4); v[q][j] = (f32x4){bf_lo(xw.x), bf_hi(xw.x), bf_lo(xw.y), bf_hi(xw.y)} * DN_ALPHA; } }
#pragma unroll
        for (int q = 0; q < 2; ++q) msk[q] = (unsigned)__builtin_amdgcn_readfirstlane((int)(unsigned)(__ballot(slotv[q] != 0xFFFF) & 0xFFFFull));
        while (msk[0] | msk[1]) {
            u32x2 t[4][8]; bool ok[4];
#pragma unroll
            for (int k = 0; k < 4; ++k) { const int q = k >> 1; ok[k] = msk[q] != 0u;
                if (ok[k]) { const int e = __builtin_ctz(msk[q]); msk[q] &= msk[q] - 1u; const unsigned sl = (unsigned)__builtin_amdgcn_readlane(slotv[q], e);
                    const bf16_t* yr = Y + (((size_t)e * BATCH + (rw[q] >> 12)) * CAP + sl) * DM + lane * 4;
#pragma unroll
                    for (int j = 0; j < 8; ++j) t[k][j] = *(const u32x2*)(yr + j * 256); } }
#pragma unroll
            for (int k = 0; k < 4; ++k) { const int q = k >> 1;
                if (ok[k]) {
#pragma unroll
                    for (int j = 0; j < 8; ++j) { v[q][j][0] += bf_lo(t[k][j].x); v[q][j][1] += bf_hi(t[k][j].x); v[q][j][2] += bf_lo(t[k][j].y); v[q][j][3] += bf_hi(t[k][j].y); } } }
        }
#pragma unroll
        for (int q = 0; q < 2; ++q) { float s = 0.f;
#pragma unroll
            for (int j = 0; j < 8; ++j) s += (v[q][j][0] + v[q][j][1]) + (v[q][j][2] + v[q][j][3]);
            const float mean = wave_sum(s) * (1.f / DM); float s2 = 0.f;
#pragma unroll
            for (int j = 0; j < 8; ++j) { v[q][j] = v[q][j] - mean; s2 += (v[q][j][0] * v[q][j][0] + v[q][j][1] * v[q][j][1]) + (v[q][j][2] * v[q][j][2] + v[q][j][3] * v[q][j][3]); }
            const float rstd = rsqrtf(wave_sum(s2) * (1.f / DM) + LN_EPS);
            if (q == 0 || rw[1] != rw[0]) {
#pragma unroll
                for (int j = 0; j < 8; ++j) { const f32x4 gg = *(const f32x4*)(g + j * 256 + lane * 4), b4 = *(const f32x4*)(bb + j * 256 + lane * 4);
                    const f32x4 o = v[q][j] * rstd * gg + b4; if (outf) { *(f32x4*)(outf + (size_t)rw[q] * DM + j * 256 + lane * 4) = o; continue; }
                    u32x2 w; w.x = cvt_pk_bf16(o[0], o[1]); w.y = cvt_pk_bf16(o[2], o[3]); *(u32x2*)(Xb + (size_t)rw[q] * DM + j * 256 + lane * 4) = w; } } }
    }
}
namespace gla {
constexpr int QT = 0, AT = 16384, KT = 24576, DT = 40960, SLOT = 41984, NSLOT = 3;
__device__ __forceinline__ void unit(const Ctx& c, int u, const unsigned char* rec, const bf16_t* vT, bf16_t* of, bf16_t* ob) {
    const int half = u & 1, dir = (u >> 1) & 1, hh = (u >> 2) & 3, b = u >> 4;
    int tid_ = c.tid; asm volatile("" : "+v"(tid_));
    const int w = __builtin_amdgcn_readfirstlane(tid_ >> 6), lane = tid_ & 63, fr = lane & 15, fq = lane >> 4;
    LAS unsigned char* L = c.lds;
    bf16_t* outp = (dir ? ob : of) + hh * 256 + half * 128 + w * 16 + 4 * fq;
    const int qrd = QT + fr * 256;
    const int swz7 = (fr >> 1) & 7;
    const int ard = AT + fr * 128;
    const int krd = KT + fr * 128;
    const int drd = DT + fq * 16;
    f32x4 S0 = {0.f, 0.f, 0.f, 0.f}, S1 = S0, S2 = S0, S3 = S0, S4 = S0, S5 = S0, S6 = S0, S7 = S0;
#ifndef GLA_TP
#define GLA_TP 0
#endif
    unsigned long long tw_ = 0ull, ta_ = 0ull;
#define GLA_T0(id) do { if (GLA_TP == (id)) ta_ = __builtin_amdgcn_s_memrealtime(); } while (0)
#define GLA_T1(id) do { if (GLA_TP == (id)) tw_ += __builtin_amdgcn_s_memrealtime() - ta_; } while (0)
    bf16x8 va0, va1, vb0, vb1, vc0, vc1;
#define GLA_CH(n) (b * 64 + (dir ? 63 - ((n) < 64 ? (n) : 63) : ((n) < 64 ? (n) : 63)))
#define GLA_VLOAD(V0, V1, n) do { const bf16_t* vp_ = vT + (((size_t)GLA_CH(n) * 4 + hh) * 256 + half * 128 + w * 16 + fr) * 64 + 8 * fq; \
    asm volatile("global_load_dwordx4 %0, %1, off" : "=&v"(V0) : "v"(vp_) : "memory"); asm volatile("global_load_dwordx4 %0, %1, off offset:64" : "=&v"(V1) : "v"(vp_) : "memory"); } while (0)
#define GLA_G(gp, off) __builtin_amdgcn_global_load_lds((const unsigned*)(gp), (LAS unsigned*)(L + (off)), 16, 0, 0)
#define GLA_DMA(n, SL) do { const unsigned char* rp_ = rec + ((((size_t)dir * 256 + GLA_CH(n)) * 4 + hh) * SLOT) + lane * 16;     \
    GLA_G(rp_ + (w) * 1024, (SL) * SLOT + (w) * 1024); GLA_G(rp_ + (w + 8) * 1024, (SL) * SLOT + (w + 8) * 1024); GLA_G(rp_ + (w + 16) * 1024, (SL) * SLOT + (w + 16) * 1024); \
    GLA_G(rp_ + (w + 24) * 1024, (SL) * SLOT + (w + 24) * 1024); GLA_G(rp_ + (w + 32) * 1024, (SL) * SLOT + (w + 32) * 1024); \
    GLA_G(rp_ + 40 * 1024, (w == 0) ? (SL) * SLOT + 40 * 1024 : NSLOT * SLOT); } while (0)
#define GLA_PK(a, bq) __builtin_bit_cast(bf16x8, (u32x4){cvt_pk_bf16(a[0], a[1]), cvt_pk_bf16(a[2], a[3]), cvt_pk_bf16(bq[0], bq[1]), cvt_pk_bf16(bq[2], bq[3])})
#define GLA_SCHED __builtin_amdgcn_sched_barrier(0)
#define GLA_MF __builtin_amdgcn_mfma_f32_16x16x32_bf16
#define GLA_RDQ(f, sb, ib) do { const LAS unsigned char* q_ = (sb) + qrd + (ib) * 4096; const LAS unsigned char* a_ = (sb) + ard + (ib) * 2048; \
    f[0] = *(const LAS bf16x8*)(q_ + (((0 + fq) ^ fr) << 4)); f[1] = *(const LAS bf16x8*)(q_ + (((4 + fq) ^ fr) << 4)); f[2] = *(const LAS bf16x8*)(q_ + (((8 + fq) ^ fr) << 4)); f[3] = *(const LAS bf16x8*)(q_ + (((12 + fq) ^ fr) << 4)); \
    f[4] = *(const LAS bf16x8*)(a_ + (((0 + fq) ^ swz7) << 4)); f[5] = *(const LAS bf16x8*)(a_ + (((4 + fq) ^ swz7) << 4)); } while (0)
#define GLA_RDK(f, sb, p) do { const LAS unsigned char* k_ = (sb) + krd + (p) * 4096; const LAS unsigned char* d_ = (sb) + drd + (p) * 128; \
    f[0] = *(const LAS bf16x8*)(k_ + (((0 + fq) ^ swz7) << 4)); f[1] = *(const LAS bf16x8*)(k_ + (((4 + fq) ^ swz7) << 4)); f[2] = *(const LAS bf16x8*)(k_ + 2048 + (((0 + fq) ^ swz7) << 4)); f[3] = *(const LAS bf16x8*)(k_ + 2048 + (((4 + fq) ^ swz7) << 4)); \
    f[4] = *(const LAS bf16x8*)(d_); f[5] = *(const LAS bf16x8*)(d_ + 64); } while (0)
#define GLA_MMAO(f, ib, VC0, VC1) do { f32x4 o1_ = {0.f, 0.f, 0.f, 0.f}, o2_ = {0.f, 0.f, 0.f, 0.f}; \
    o1_ = GLA_MF(sf0, f[0], o1_, 0, 0, 0); o2_ = GLA_MF(sf2, f[2], o2_, 0, 0, 0); o1_ = GLA_MF(sf1, f[1], o1_, 0, 0, 0); o2_ = GLA_MF(sf3, f[3], o2_, 0, 0, 0); \
    o1_ = GLA_MF(VC0, f[4], o1_, 0, 0, 0); o2_ = GLA_MF(VC1, f[5], o2_, 0, 0, 0); { const f32x4 os_ = o1_ + o2_; u32x2 ow_; ow_.x = cvt_pk_bf16(os_[0], os_[1]); ow_.y = cvt_pk_bf16(os_[2], os_[3]); *(u32x2*)(outp + ro_ + (size_t)(ib) * 16 * 1024) = ow_; } } while (0)
#define GLA_MMAS(f, Sa, Sb, VC0, VC1) do { Sa = Sa * __builtin_bit_cast(f32x4, f[4]); Sb = Sb * __builtin_bit_cast(f32x4, f[5]); \
    Sa = GLA_MF(f[0], VC0, Sa, 0, 0, 0); Sb = GLA_MF(f[2], VC0, Sb, 0, 0, 0); Sa = GLA_MF(f[1], VC1, Sa, 0, 0, 0); Sb = GLA_MF(f[3], VC1, Sb, 0, 0, 0); } while (0)
#define GLA_STEP(n, SC, SL, VC0, VC1, VL0, VL1) do { \
    GLA_T0(2); GLA_VLOAD(VL0, VL1, (n) + 2); GLA_DMA((n) + 2, SL); GLA_T1(2); GLA_T0(3); \
    const LAS unsigned char* sb_ = L + (SC) * SLOT; \
    const bf16x8 sf0 = GLA_PK(S0, S1), sf1 = GLA_PK(S2, S3), sf2 = GLA_PK(S4, S5), sf3 = GLA_PK(S6, S7); \
    const size_t ro_ = ((size_t)GLA_CH(n) * 64 + fr) * 1024; \
    bf16x8 fa_[6], fb_[6]; \
    GLA_RDQ(fa_, sb_, 0); GLA_SCHED; \
    GLA_RDQ(fb_, sb_, 1); GLA_SCHED; GLA_MMAO(fa_, 0, VC0, VC1); GLA_SCHED; \
    GLA_RDQ(fa_, sb_, 2); GLA_SCHED; GLA_MMAO(fb_, 1, VC0, VC1); GLA_SCHED; \
    GLA_RDQ(fb_, sb_, 3); GLA_SCHED; GLA_MMAO(fa_, 2, VC0, VC1); GLA_SCHED; \
    GLA_RDK(fa_, sb_, 0); GLA_SCHED; GLA_MMAO(fb_, 3, VC0, VC1); GLA_SCHED; \
    GLA_RDK(fb_, sb_, 1); GLA_SCHED; GLA_MMAS(fa_, S0, S1, VC0, VC1); GLA_SCHED; \
    GLA_RDK(fa_, sb_, 2); GLA_SCHED; GLA_MMAS(fb_, S2, S3, VC0, VC1); GLA_SCHED; \
    GLA_RDK(fb_, sb_, 3); GLA_SCHED; GLA_MMAS(fa_, S4, S5, VC0, VC1); GLA_SCHED; \
    GLA_MMAS(fb_, S6, S7, VC0, VC1); \
    GLA_T1(3); GLA_T0(1); asm volatile("s_waitcnt vmcnt(16) lgkmcnt(0)" ::: "memory"); GLA_T1(1); GLA_T0(4); asm volatile("s_barrier" ::: "memory"); GLA_T1(4); } while (0)
    GLA_VLOAD(va0, va1, 0); GLA_DMA(0, 0); GLA_VLOAD(vb0, vb1, 1); GLA_DMA(1, 1);
    asm volatile("s_waitcnt vmcnt(8) lgkmcnt(0)\n\ts_barrier" ::: "memory");
#pragma nounroll
    for (int n = 0; n < 63; n += 3) {
        GLA_STEP(n, 0, 2, va0, va1, vc0, vc1);
        GLA_STEP(n + 1, 1, 0, vb0, vb1, va0, va1);
        GLA_STEP(n + 2, 2, 1, vc0, vc1, vb0, vb1);
    }
    GLA_STEP(63, 0, 2, va0, va1, vc0, vc1);
    asm volatile("s_waitcnt vmcnt(0) lgkmcnt(0)\n\ts_barrier" ::: "memory");
    asm volatile("" :: "v"(va0), "v"(va1), "v"(vb0), "v"(vb1), "v"(vc0), "v"(vc1));
    if (GLA_TP != 0 && tid_ == 0 && u == 0) *(volatile LAS unsigned long long*)(L + MISC_OFF + 64) = tw_;
#undef GLA_CH
#undef GLA_VLOAD
#undef GLA_G
#undef GLA_DMA
#undef GLA_PK
#undef GLA_SCHED
#undef GLA_MF
#undef GLA_RDQ
#undef GLA_RDK
#undef GLA_MMAO
#undef GLA_MMAS
#undef GLA_STEP
}
}
#ifndef MK_SPLIT
#define MK_SPLIT 0
#endif
constexpr int NPH_LAYER = 11, NPHASE = 1 + DEPTH * NPH_LAYER;
struct Args { const float* in[22]; float* out; unsigned char* ws; int ph_lo, ph_hi, li, pad; };

__global__ void __launch_bounds__(NTHR, 2) hybrid_fwd(Args args) {
    extern __shared__ __attribute__((aligned(16))) unsigned char lds_raw[];
    Ctx c; c.lds = (LAS unsigned char*)lds_raw; c.tid = threadIdx.x; c.lane = c.tid & 63; c.wave = __builtin_amdgcn_readfirstlane(c.tid >> 6);
    c.G = gridDim.x; { const int bx = blockIdx.x; c.vcu = (c.G % 8 == 0) ? (bx % 8) * (c.G / 8) + bx / 8 : bx; }
    typedef const Args __attribute__((address_space(4))) CArgs;
    CArgs* const ap0 = (CArgs*)__builtin_amdgcn_kernarg_segment_ptr();
    unsigned char* ws = ap0->ws;
    gu32* ctl = (gu32*)(ws + WS_CTL);
    volatile LAS unsigned* MISC = (volatile LAS unsigned*)(c.lds + MISC_OFF);
    for (int u = c.tid; u < (LDS_BYTES - RING_BYTES) / 4; u += NTHR) ((LAS unsigned*)(c.lds + RING_BYTES))[u] = 0u;
    __syncthreads();
    const int lo = ap0->ph_lo, hi = ap0->ph_hi;
    XcdBarrier bar; bar.bar = (unsigned*)(ctl + CW_BAR) + ap0->li * XCD_BAR_WORDS; bar.x = 0; bar.st = nullptr;
    if (hi - lo > 1) bar = xcd_barrier_post((unsigned*)(ctl + CW_BAR) + ap0->li * XCD_BAR_WORDS, MISC + 8);
#ifndef PHASE_MASK
#define PHASE_MASK 0xFFF
#endif
#define PHM(j) (((PHASE_MASK) >> (j)) & 1)
#ifndef DUP_PHASE
#define DUP_PHASE (-1)
#endif
#ifndef DUP_SUB
#define DUP_SUB 3
#endif
#ifndef DUP_PAR
#define DUP_PAR 2
#endif
#define NREP(k) ((DUP_PHASE == (k) && (DUP_PAR == 2 || DUP_PAR == (layer & 1))) ? 2 : 1)
#define IN(k) (lo <= (k) && (k) < hi)
#ifndef TPROBE
#define TPROBE 0
#endif
#ifndef TPROBE_SEAM
#define TPROBE_SEAM (-1)
#endif
#ifndef TPROBE_LAYER
#define TPROBE_LAYER 0
#endif
#ifndef TPROBE_BLOCK
#define TPROBE_BLOCK 0
#endif
    unsigned long long tpr_acc = 0ull, tpr_t0 = 0ull, tph0 = 0ull;
#define SEAM(k) do { if (TPROBE == 6 && (k) > 0 && ((k) - 1) % NPH_LAYER == TPROBE_SEAM && ((k) - 1) / NPH_LAYER == TPROBE_LAYER) tpr_acc += __builtin_amdgcn_s_memrealtime() - tph0; if (hi > (k) + 1) { const bool tp_ = (TPROBE == 5) && (TPROBE_SEAM < 0 || ((k) > 0 && ((k) - 1) % NPH_LAYER == TPROBE_SEAM) || ((k) == 0 && TPROBE_SEAM == 11)); \
    if (tp_) tpr_t0 = __builtin_amdgcn_s_memrealtime(); xcd_barrier(bar); if (tp_) tpr_acc += __builtin_amdgcn_s_memrealtime() - tpr_t0; } } while (0)

#define tabR ((f32x2*)(wsb + WS_ROPER))
#define tabG ((f32x2*)(wsb + WS_ROPEG))
#define aff ((float*)(wsb + WS_AFF))
#define idx ((int*)(wsb + WS_IDX))
#define gate ((float*)(wsb + WS_GATE))
#define slotmap ((unsigned short*)(wsb + WS_SLOT))
#define Win_t ((bf16_t*)(wsb + WS_WIN))
#define Wuq_t ((bf16_t*)(wsb + WS_WUQ))
#define Wukv_t ((bf16_t*)(wsb + WS_WUKV))
#define Wmo_t ((bf16_t*)(wsb + WS_WMO))
#define Wqkv_t ((bf16_t*)(wsb + WS_WQKV))
#define Wgo_t ((bf16_t*)(wsb + WS_WGO))
#define W13_t ((bf16_t*)(wsb + WS_W13))
#define W2_t ((bf16_t*)(wsb + WS_W2))
#define Xb ((bf16_t*)(wsb + WS_XB))
#define X1b ((bf16_t*)(wsb + WS_X1B))
#define X1f8 ((unsigned char*)(wsb + WS_X1))
#define W13f8 ((unsigned char*)(wsb + WS_W13))
#define W2f8 ((unsigned char*)(wsb + WS_W2))
#define hdn8 ((unsigned char*)(wsb + WS_HDN))
#define iota ((int*)(wsb + WS_IDX + 262144))
#define Ocat8 ((unsigned char*)(wsb + WS_OCAT))
#define Wmo8 ((unsigned char*)(wsb + WS_WMO))
#define Wgo8 ((unsigned char*)(wsb + WS_WGO))
#define H ((bf16_t*)(wsb + WS_H))
#define Qm ((bf16_t*)(wsb + WS_QM))
#define Km ((bf16_t*)(wsb + WS_KM))
#define Vm ((bf16_t*)(wsb + WS_VM))
#define Ocat ((bf16_t*)(wsb + WS_OCAT))
#define qin ((bf16_t*)(wsb + WS_QIN))
#define vT ((bf16_t*)(wsb + WS_VT))
#define of ((bf16_t*)(wsb + WS_OF))
#define ob ((bf16_t*)(wsb + WS_OB))
#define hdn ((bf16_t*)(wsb + WS_HDN))
#define Yb ((bf16_t*)(wsb + WS_Y))
#define Mb ((bf16_t*)(wsb + WS_OF))
#define X2 (apx->out)
#define WSB_OPAQUE() CArgs* apx = ap0; asm volatile("" : "+s"(apx)); unsigned char* wsb = apx->ws

    if (PHM(11) && IN(0)) for (int rep_ = 0; rep_ < ((DUP_PHASE == 11) ? 2 : 1); ++rep_) { WSB_OPAQUE();
        fill_rope(c, tabR, tabG);
        cvt_rows_bf16(c, apx->in[0], Xb);
        const int nl = (c.G == 256) ? 2 : DEPTH;
        transpose_batch_f8(c, apx->in[15], W13f8, DM, FF, nl * NEXP, (size_t)DM * FF, (size_t)2 * FF * DM, 2, 64.f);
        transpose_batch_f8(c, apx->in[16], W13f8, DM, FF, nl * NEXP, (size_t)DM * FF, (size_t)2 * FF * DM, 3, 512.f);
        transpose_batch_f8(c, apx->in[17], W2f8, FF, DM, (c.G == 256 ? 1 : nl) * NEXP, (size_t)FF * DM, (size_t)DM * FF, 0, 128.f);
        transpose_batch(c, apx->in[1], Win_t, DM, 3936, 2, (size_t)DM * 3936, (size_t)4096 * DM, 1);
        transpose_batch(c, apx->in[10], Wqkv_t, DM, 3072, 2, (size_t)DM * 3072, (size_t)3072 * DM, 0);
        transpose_batch_f8(c, apx->in[9], Wmo8, DM, DM, 2, (size_t)DM * DM, (size_t)DM * DM, 0, 128.f, -1, 0, 1024, 1024.f);
        transpose_batch_f8(c, apx->in[13], Wgo8, DM, DM, 2, (size_t)DM * DM, (size_t)DM * DM, 0, 128.f);
        transpose_batch(c, apx->in[3], Wuq_t, 512, 1536, 2, (size_t)512 * 1536, (size_t)1536 * 512, 0);
        transpose_batch(c, apx->in[5], Wukv_t, 256, 2048, 2, (size_t)256 * 2048, (size_t)2048 * 256, 0);
        { const long gt = (long)c.vcu * NTHR + c.tid, NT = (long)c.G * NTHR;
          for (long i = gt; i < 2L * 160 * DM / 8; i += NT) { const long l2 = i / (160 * DM / 8), rr = i % (160 * DM / 8); *(u32x4*)(Win_t + (size_t)l2 * 4096 * DM + (size_t)3936 * DM + rr * 8) = (u32x4){0u, 0u, 0u, 0u}; } }
        for (int i = c.vcu * NTHR + c.tid; i < BATCH * NEXP * CAP; i += c.G * NTHR) iota[i] = i;
        SEAM(0);
    }

    const Ctx c0 = c;
#ifndef TPROBE_BLOCK
#define TPROBE_BLOCK 0
#endif
#ifndef TPROBE_LAYER
#define TPROBE_LAYER 0
#endif
#define TP_BEGIN(id) do { if (TPROBE == (id) && layer == TPROBE_LAYER) tpr_t0 = __builtin_amdgcn_s_memrealtime(); } while (0)
#define TP_END(id) do { if (TPROBE == (id) && layer == TPROBE_LAYER) tpr_acc += __builtin_amdgcn_s_memrealtime() - tpr_t0; } while (0)
    for (int layer = 0; layer < DEPTH; ++layer) {
        const int pb = 1 + layer * NPH_LAYER, i2 = layer >> 1; const bool even = (layer & 1) == 0;
        if (PHM(0) && IN(pb + 0)) _Pragma("nounroll") for (int rep_ = 0; rep_ < NREP(0); ++rep_) { const Ctx c = opaque_ctx(c0); WSB_OPAQUE(); if (TPROBE == 6) tph0 = __builtin_amdgcn_s_memrealtime();
            const int N = even ? 4096 : 3072;
            pg8::Gemm g{Xb, even ? Win_t + (size_t)i2 * 4096 * DM : Wqkv_t + (size_t)i2 * 3072 * DM, DM, DM, DM, 0, 0, nullptr};
            pg8::StaticOrder S; S.init(M, N, c.G, (int)blockIdx.x);
            if (even) { pg8::EpiStoreBf16 E{H, N}; pg8::gemm_phase<pg8::EpiStoreBf16, false>(c.lds, g, S, E); }
            else { pg8::EpiQKNorm E{H, apx->in[11] + i2 * 128, apx->in[12] + i2 * 128, tabG, (LAS float*)(c.lds + RING_BYTES + 2048)};
                   pg8::gemm_phase<pg8::EpiQKNorm, false>(c.lds, g, S, E); }
            SEAM(pb + 0);
        }
        if (PHM(1) && IN(pb + 1) && even) _Pragma("nounroll") for (int rep_ = 0; rep_ < NREP(1); ++rep_) { const Ctx c = opaque_ctx(c0); WSB_OPAQUE(); if (TPROBE == 6) tph0 = __builtin_amdgcn_s_memrealtime();
            if (even) { if (rep_ == 0 || (DUP_SUB & 4)) mla_prep_rows(c, H, rep_ == 0 ? H : (bf16_t*)(ws + WS_HDN), Km, apx->in[2] + i2 * 512, apx->in[4] + i2 * 256, tabR);
                        if (rep_ == 0 || !(DUP_SUB & 4)) gla_prep(c, H, apx->in[6] + (size_t)i2 * 2 * 16 * 512, apx->in[7] + i2 * 2 * 512, (unsigned char*)qin  , vT); }
            SEAM(pb + 1);
        }
        if (PHM(2) && IN(pb + 2) && even) _Pragma("nounroll") for (int rep_ = 0; rep_ < NREP(2); ++rep_) { const Ctx c = opaque_ctx(c0); WSB_OPAQUE(); if (TPROBE == 6) tph0 = __builtin_amdgcn_s_memrealtime();
#ifndef SUBM
#define SUBM 0x1F
#endif
            if (SUBM & 1) { pg8::Gemm g{H + C_CQ, Wuq_t + (size_t)i2 * 1536 * 512, HW, 512, 512, 0, 0, nullptr}; pg8::StaticOrder S; S.init(M, 1536, c.G, (int)blockIdx.x);
              pg8::EpiQRope E{Qm, tabR}; pg8::gemm_phase<pg8::EpiQRope, false>(c.lds, g, S, E); }
            if (SUBM & 2) { pg8::Gemm g{H + C_CKV, Wukv_t + (size_t)i2 * 2048 * 256, HW, 256, 256, 0, 0, nullptr}; pg8::StaticOrder S; S.init(M, 2048, c.G, (int)blockIdx.x);
              pg8::EpiKV E{Km, Vm}; pg8::gemm_phase<pg8::EpiKV, false>(c.lds, g, S, E); }
            SEAM(pb + 2);
        }
        if (PHM(3) && IN(pb + 3)) _Pragma("nounroll") for (int rep_ = 0; rep_ < NREP(3); ++rep_) { const Ctx c = opaque_ctx(c0); WSB_OPAQUE(); if (TPROBE == 6) tph0 = __builtin_amdgcn_s_memrealtime();
            if (even) {
                TP_BEGIN(1); if ((SUBM & 4) && (rep_ == 0 || (DUP_SUB & 1))) for (int v4 = c.vcu; v4 < 256; v4 += c.G) if ((v4 & 3) == 0) gla::unit(c, v4 >> 2, (const unsigned char*)qin  , vT, of, ob); TP_END(1); TP_BEGIN(2);
                if ((SUBM & 8) && (rep_ == 0 || (DUP_SUB & 2))) for (int uid = c.vcu; uid < 512; uid += c.G) { const int b = uid >> 7, h = (uid >> 4) & 7, qb = uid & 15; const size_t r0 = (size_t)b * SEQ;
                    attn::attn_unit<192, 1536, 1536, 1024, 2048>(Qm + (r0 + qb * 256) * 1536 + h * 192, Km + r0 * 1536 + h * 192, Vm + r0 * 1024 + h * 128, Ocat8 + (r0 + qb * 256) * 2048 + h * 128, SEQ, (char*)lds_raw); }
                TP_END(2);
                if (rep_ == 0 && (c.vcu & 3) != 0 && c.G == 256) {
                    const int tl = (layer == 0) ? 2 : 3, rk = c.vcu - (c.vcu >> 2) - 1; const size_t lo_ = (size_t)tl * NEXP;
                    transpose_batch_f8(c, apx->in[15] + lo_ * DM * FF, W13f8 + lo_ * 2 * FF * DM, DM, FF, NEXP, (size_t)DM * FF, (size_t)2 * FF * DM, 2, 64.f, rk, 192);
                    transpose_batch_f8(c, apx->in[16] + lo_ * DM * FF, W13f8 + lo_ * 2 * FF * DM, DM, FF, NEXP, (size_t)DM * FF, (size_t)2 * FF * DM, 3, 512.f, rk, 192);
                    transpose_batch_f8(c, apx->in[17] + lo_ * FF * DM, W2f8 + lo_ * DM * FF, FF, DM, NEXP / 2, (size_t)FF * DM, (size_t)DM * FF, 0, 128.f, rk, 192);
                }
            } else {
                TP_BEGIN(3);
                if (SUBM & 16) for (int uid = c.vcu; uid < 1024; uid += c.G) { const int b = uid >> 8, kvh = (uid >> 6) & 3, gq = (uid >> 4) & 3, qb = uid & 15, h = kvh * 4 + gq; const size_t r0 = (size_t)b * SEQ;
                    attn::attn_unit<128, 3072, 3072, 3072, 2048>(H + (r0 + qb * 256) * 3072 + h * 128, H + r0 * 3072 + 2048 + kvh * 128, H + r0 * 3072 + 2560 + kvh * 128, Ocat8 + (r0 + qb * 256) * 2048 + h * 128, SEQ, (char*)lds_raw); }
                TP_END(3);
            }
            TP_BEGIN(4); SEAM(pb + 3); TP_END(4);
        }
        if (PHM(4) && IN(pb + 4) && even) _Pragma("nounroll") for (int rep_ = 0; rep_ < NREP(4); ++rep_) { const Ctx c = opaque_ctx(c0); WSB_OPAQUE(); if (TPROBE == 6) tph0 = __builtin_amdgcn_s_memrealtime(); gla_out_rows(c, of, ob, H, apx->in[8] + i2 * 1024, Ocat8); SEAM(pb + 4); }
        if (PHM(5) && IN(pb + 5)) _Pragma("nounroll") for (int rep_ = 0; rep_ < NREP(5); ++rep_) { const Ctx c = opaque_ctx(c0); WSB_OPAQUE(); if (TPROBE == 6) tph0 = __builtin_amdgcn_s_memrealtime();
            pg8::Gemm g{(const bf16_t*)Ocat8, (const bf16_t*)((even ? Wmo8 : Wgo8) + (size_t)i2 * DM * DM), DM / 2, DM / 2, DM / 2, 0, 0, iota};
            pg8::StaticOrder S; S.init(M, DM, c.G, (int)blockIdx.x);
            pg8::EpiStoreBf16 E{Mb, DM};
            pg8::gemm_phase<pg8::EpiStoreBf16, true, true, 0x78787878, 0x7A7A7A7A>(c.lds, g, S, E);
            SEAM(pb + 5);
        }
        if (PHM(6) && IN(pb + 6)) _Pragma("nounroll") for (int rep_ = 0; rep_ < NREP(6); ++rep_) { const Ctx c = opaque_ctx(c0); WSB_OPAQUE(); if (TPROBE == 6) tph0 = __builtin_amdgcn_s_memrealtime(); ln_router_rows(c, Xb, Mb, X1b, X1f8, apx->in[18] + layer * DM, apx->in[19] + layer * DM, apx->in[14] + (size_t)layer * DM * NEXP, aff); SEAM(pb + 6); }
        if (PHM(7) && IN(pb + 7)) _Pragma("nounroll") for (int rep_ = 0; rep_ < NREP(7); ++rep_) { const Ctx c = opaque_ctx(c0); WSB_OPAQUE(); if (TPROBE == 6) tph0 = __builtin_amdgcn_s_memrealtime(); topk_units(c, aff, idx, gate, slotmap);
            if (c.G == 256 && c.vcu >= 64) { const size_t m0 = (layer < 2) ? (size_t)NEXP + (size_t)layer * 8 : (size_t)layer * NEXP + 8;
                transpose_batch_f8(c, apx->in[17] + m0 * FF * DM, W2f8 + m0 * DM * FF, FF, DM, 8, (size_t)FF * DM, (size_t)DM * FF, 0, 128.f, c.vcu - 64, 192); }
            SEAM(pb + 7); }
        if (PHM(8) && IN(pb + 8)) _Pragma("nounroll") for (int rep_ = 0; rep_ < NREP(8); ++rep_) { const Ctx c = opaque_ctx(c0); WSB_OPAQUE(); if (TPROBE == 6) tph0 = __builtin_amdgcn_s_memrealtime();
            pg8::Gemm g{(const bf16_t*)X1f8, (const bf16_t*)(W13f8 + (size_t)layer * NEXP * 2 * FF * DM), DM / 2, DM / 2, DM / 2, 3, (size_t)FF * DM, idx};
            pg8::StaticOrder S; S.init(MX, 2 * FF, c.G, (int)blockIdx.x);
            pg8::EpiSwigluF8 E{hdn8};
            pg8::gemm_phase<pg8::EpiSwigluF8, true, true>(c.lds, g, S, E);
            SEAM(pb + 8);
        }
        if (PHM(9) && IN(pb + 9)) _Pragma("nounroll") for (int rep_ = 0; rep_ < NREP(9); ++rep_) { const Ctx c = opaque_ctx(c0); WSB_OPAQUE(); if (TPROBE == 6) tph0 = __builtin_amdgcn_s_memrealtime();
            pg8::Gemm g{(const bf16_t*)hdn8, (const bf16_t*)(W2f8 + (size_t)layer * NEXP * DM * FF), FF / 2, FF / 2, FF / 2, 3, (size_t)DM * FF / 2, iota};
            pg8::StaticOrder S; S.init(MX, DM, c.G, (int)blockIdx.x);
            pg8::EpiGate E{Yb, gate};
            pg8::gemm_phase<pg8::EpiGate, true, true, 0x78787878, 0x7C7C7C7C>(c.lds, g, S, E);
            SEAM(pb + 9);
        }
        if (PHM(10) && IN(pb + 10)) _Pragma("nounroll") for (int rep_ = 0; rep_ < NREP(10); ++rep_) { const Ctx c = opaque_ctx(c0); WSB_OPAQUE(); if (TPROBE == 6) tph0 = __builtin_amdgcn_s_memrealtime(); combine_ln_rows(c, X1b, Yb, slotmap, apx->in[20] + layer * DM, apx->in[21] + layer * DM, (layer == DEPTH - 1) ? X2 : (float*)nullptr, Xb); SEAM(pb + 10); }
    }
    if (TPROBE == 9 && threadIdx.x == 0) tpr_acc = *(volatile LAS unsigned long long*)(c.lds + MISC_OFF + 64);
    if (TPROBE != 0 && blockIdx.x == TPROBE_BLOCK) { const unsigned long long tgt = __builtin_amdgcn_s_memrealtime() + 16ull * tpr_acc; while (__builtin_amdgcn_s_memrealtime() < tgt) __builtin_amdgcn_s_sleep(20); }
#undef IN
#undef SEAM
#undef tabR
#undef tabG
#undef aff
#undef idx
#undef gate
#undef slotmap
#undef Win_t
#undef Wuq_t
#undef Wukv_t
#undef Wmo_t
#undef Wqkv_t
#undef Wgo_t
#undef W13_t
#undef W2_t
#undef Xb
#undef X1b
#undef X1f8
#undef W13f8
#undef W2f8
#undef hdn8
#undef iota
#undef Ocat8
#undef Wmo8
#undef Wgo8
#undef H
#undef Qm
#undef Km
#undef Vm
#undef Ocat
#undef qin
#undef vT
#undef of
#undef ob
#undef hdn
#undef Yb
#undef Mb
#undef X2
#undef WSB_OPAQUE
}

extern "C" void kernel_launch(void* const* d_in, const int* in_sizes, int n_in, void* d_out, int out_size, void* d_ws, size_t ws_size, hipStream_t stream) {
    static int grid = 0;
    if (grid == 0) {
        if (n_in != 22 || in_sizes[0] != M * DM || out_size != M * DM || ws_size < WS_END) { fprintf(stderr, "kernel_launch: unexpected shapes (n_in %d, in0 %d, out %d, ws %zu < %zu); nothing launched\n", n_in, n_in > 0 ? in_sizes[0] : -1, out_size, ws_size, (size_t)WS_END); grid = -1; return; }
        int dev = 0, cus = 0, per_cu = 0;
        if (hipGetDevice(&dev) != hipSuccess || hipDeviceGetAttribute(&cus, hipDeviceAttributeMultiprocessorCount, dev) != hipSuccess) { grid = -1; return; }
        if (hipFuncSetAttribute((const void*)hybrid_fwd, hipFuncAttributeMaxDynamicSharedMemorySize, LDS_BYTES) != hipSuccess) { fprintf(stderr, "kernel_launch: hipFuncSetAttribute failed\n"); grid = -1; return; }
        if (hipOccupancyMaxActiveBlocksPerMultiprocessor(&per_cu, (const void*)hybrid_fwd, NTHR, LDS_BYTES) != hipSuccess || per_cu < 1) fprintf(stderr, "kernel_launch: occupancy query reports %d\n", per_cu);
        (void)hipGetLastError();
        grid = cus;
    }
    if (grid < 0) return;
    if (hipMemsetAsync((char*)d_ws + WS_CTL, 0, CTL_ZERO_BYTES, stream) != hipSuccess) return;
    Args a{};
    for (int i = 0; i < 22; ++i) a.in[i] = (const float*)d_in[i];
    a.out = (float*)d_out; a.ws = (unsigned char*)d_ws; a.pad = 0;
#if MK_SPLIT
    for (int p = 0; p < NPHASE; ++p) {
        if (p > 0) { const int layer = (p - 1) / NPH_LAYER, k = (p - 1) % NPH_LAYER; if ((layer & 1) && (k == 2 || k == 4)) continue; }
        a.ph_lo = p; a.ph_hi = p + 1; a.li = 0;
        hipLaunchKernelGGL(hybrid_fwd, dim3(grid), dim3(NTHR), LDS_BYTES, stream, a);
    }
#elif defined(RELAUNCH_PHASE)
    a.ph_lo = 0; a.ph_hi = RELAUNCH_PHASE + 1; a.li = 0; hipLaunchKernelGGL(hybrid_fwd, dim3(grid), dim3(NTHR), LDS_BYTES, stream, a);
    a.ph_lo = RELAUNCH_PHASE; a.ph_hi = RELAUNCH_PHASE + 1; a.li = 1; hipLaunchKernelGGL(hybrid_fwd, dim3(grid), dim3(NTHR), LDS_BYTES, stream, a);
    a.ph_lo = RELAUNCH_PHASE + 1; a.ph_hi = NPHASE; a.li = 2; hipLaunchKernelGGL(hybrid_fwd, dim3(grid), dim3(NTHR), LDS_BYTES, stream, a);
#else
    a.ph_lo = 0; a.ph_hi = NPHASE; a.li = 0;
    hipLaunchKernelGGL(hybrid_fwd, dim3(grid), dim3(NTHR), LDS_BYTES, stream, a);
#endif
    const hipError_t le = hipPeekAtLastError();
    if (le != hipSuccess) fprintf(stderr, "kernel_launch: launch failed: %s\n", hipGetErrorName(le));
}
```
